# Optimizing an MI355X kernel written in HIP

```python
import jax, jax.numpy as jnp
from jax import lax
import numpy as np

D_MODEL = 2048
BATCH = 1
SEQ = 16384
DEPTH = 2

N_A = DEPTH // 2
N_B = DEPTH - N_A

MIX = D_MODEL
MEM_LEN = 256
MEM_HEADS = 4
MEM_W = MIX // 4
MEM_HD = MEM_W // MEM_HEADS
MAIN_W = MIX - MEM_W

ML_HEADS = 4
ML_DV = MAIN_W // ML_HEADS
ML_DQK = ML_DV // 2
ML_CHUNK = 64

NSA_HEADS = 12
NSA_HD = MAIN_W // NSA_HEADS
NSA_KV = 2
NSA_GROUP = NSA_HEADS // NSA_KV
CMP_LEN = 32
CMP_STRIDE = 16
CMP_HIDDEN = 256
SLC_LEN = 64
SLC_TOPK = 16
WIN = 512
Q_BLOCK = 128

D_FF = 5632
FFN_RES = 0.5
ROPE_THETA = 10000.0
EPS = 1e-6
NEG = -1e30
BIG = 1e30

A_IN = 2 * ML_HEADS * ML_DQK + 2 * MAIN_W + 2 * ML_HEADS + MEM_W
B_IN = MAIN_W + 3 * NSA_HEADS + MEM_W
KV_W = 6 * NSA_KV * NSA_HD

kernel_name = "yoco_mlstm_nsa_macaron_hybrid"


def rmsnorm(x, g):
    xf = x.astype(jnp.float32)
    y = xf * lax.rsqrt(jnp.mean(xf * xf, axis=-1, keepdims=True) + EPS)
    return (y * g.astype(jnp.float32)).astype(x.dtype)


def swiglu(x, w_gate, w_up, w_down):
    return (jax.nn.silu(x @ w_gate) * (x @ w_up)) @ w_down


def half_ffn(x, g_pre, g_post, w_gate, w_up, w_down):
    return x + FFN_RES * rmsnorm(swiglu(rmsnorm(x, g_pre), w_gate, w_up, w_down), g_post)


def split_cols(a, sizes):
    return jnp.split(a, [int(o) for o in np.cumsum(sizes)[:-1]], axis=-1)


def rope_tables(seq, dim):
    inv = ROPE_THETA ** (-jnp.arange(0, dim, 2, dtype=jnp.float32) / dim)
    ang = jnp.arange(seq, dtype=jnp.float32)[:, None] * inv[None, :]
    return jnp.cos(ang), jnp.sin(ang)


def apply_rope(x, cos, sin):
    half = x.shape[-1] // 2
    x1, x2 = x[..., :half], x[..., half:]
    c = cos[None, :, None, :].astype(x.dtype)
    s = sin[None, :, None, :].astype(x.dtype)
    return jnp.concatenate([x1 * c - x2 * s, x2 * c + x1 * s], axis=-1)


def mem_attention(mq, mem_k, mem_v):
    s = jnp.einsum('bshd,bmhd->bhsm', mq, mem_k).astype(jnp.float32) * MEM_HD ** -0.5
    p = jax.nn.softmax(s, axis=-1).astype(mem_v.dtype)
    o = jnp.einsum('bhsm,bmhd->bshd', p, mem_v)
    return o.reshape(o.shape[0], o.shape[1], MEM_W)


def mlstm_chunkwise(q, k, v, i_pre, log_f):
    b_, h_, s_, dqk = q.shape
    dv = v.shape[-1]
    nc = s_ // ML_CHUNK

    def chunks(a):
        return jnp.moveaxis(a.reshape((b_, h_, nc, ML_CHUNK) + a.shape[3:]), 2, 0)

    causal = jnp.tril(jnp.ones((ML_CHUNK, ML_CHUNK), dtype=bool))

    def step(carry, inp):
        c_prev, n_prev, m_prev = carry
        qc, kc, vc, ic, fc = inp
        b = jnp.cumsum(fc, axis=-1)
        dmat = b[..., :, None] - b[..., None, :] + ic[..., None, :]
        dmat = jnp.where(causal, dmat, -jnp.inf)
        m_inter = b + m_prev[..., None]
        m_vec = jnp.maximum(jnp.max(dmat, axis=-1), m_inter)
        smat = jnp.einsum('bhld,bhsd->bhls', qc, kc) * jnp.exp(dmat - m_vec[..., None])
        inter = jnp.exp(m_inter - m_vec)
        num = jnp.einsum('bhls,bhsv->bhlv', smat, vc) + inter[..., None] * jnp.einsum('bhld,bhdv->bhlv', qc, c_prev)
        den = jnp.sum(smat, axis=-1) + inter * jnp.einsum('bhld,bhd->bhl', qc, n_prev)
        h = num / jnp.maximum(jnp.abs(den), jnp.exp(-m_vec))[..., None]
        m_last = m_vec[..., -1]
        w = jnp.exp(b[..., -1:] - b + ic - m_last[..., None])
        decay = jnp.exp(b[..., -1] + m_prev - m_last)
        c_new = decay[..., None, None] * c_prev + jnp.einsum('bhs,bhsd,bhsv->bhdv', w, kc, vc)
        n_new = decay[..., None] * n_prev + jnp.einsum('bhs,bhsd->bhd', w, kc)
        return (c_new, n_new, m_last), h

    f32 = jnp.float32
    init = (jnp.zeros((b_, h_, dqk, dv), f32), jnp.zeros((b_, h_, dqk), f32), jnp.zeros((b_, h_), f32))
    _, hs = lax.scan(step, init, (chunks(q), chunks(k), chunks(v), chunks(i_pre), chunks(log_f)))
    return jnp.moveaxis(hs, 0, 2).reshape(b_, h_, s_, dv)


def mlstm_mixer(xn, w_in, gate_bias, head_norm, mem_k, mem_v):
    b_, s_, _ = xn.shape
    q, k, v, o, gates, mq = split_cols(xn @ w_in, [ML_HEADS * ML_DQK, ML_HEADS * ML_DQK, MAIN_W, MAIN_W,
                                                  2 * ML_HEADS, MEM_W])
    f32 = jnp.float32

    def heads_first(a, d):
        return a.reshape(b_, s_, ML_HEADS, d).transpose(0, 2, 1, 3).astype(f32)

    qh = heads_first(q, ML_DQK)
    kh = heads_first(k, ML_DQK) * ML_DQK ** -0.5
    vh = heads_first(v, ML_DV)
    gp = (gates + gate_bias).astype(f32).reshape(b_, s_, 2, ML_HEADS).transpose(2, 0, 3, 1)
    h = mlstm_chunkwise(qh, kh, vh, gp[0], jax.nn.log_sigmoid(gp[1]))
    h = h.transpose(0, 2, 1, 3).astype(xn.dtype)
    h = rmsnorm(h, head_norm) * jax.nn.sigmoid(o).reshape(b_, s_, ML_HEADS, ML_DV)
    mo = mem_attention(mq.reshape(b_, s_, MEM_HEADS, MEM_HD), mem_k, mem_v)
    return jnp.concatenate([h.reshape(b_, s_, MAIN_W), mo], axis=-1)


def compress_blocks(kv, pos, w1, w2):
    b_, s_, g_, d_ = kv.shape
    n_seg = s_ // CMP_STRIDE
    per = CMP_LEN // CMP_STRIDE
    n_cmp = n_seg - per + 1
    segs = kv.reshape(b_, n_seg, CMP_STRIDE, g_, d_)
    blocks = jnp.concatenate([segs[:, i:i + n_cmp] for i in range(per)], axis=2)
    blocks = blocks + pos[None, None, :, None, :]
    flat = jnp.transpose(blocks, (0, 1, 3, 2, 4)).reshape(b_, n_cmp, g_, CMP_LEN * d_)
    return jax.nn.gelu(flat @ w1) @ w2


def shared_kv(x, kv_norm, w_kv, cmp_pos, cmp_w1, cmp_w2, cos, sin):
    b_, s_, _ = x.shape
    kv = (rmsnorm(x, kv_norm) @ w_kv).reshape(b_, s_, 6, NSA_KV, NSA_HD)
    k_cmp = compress_blocks(kv[:, :, 0], cmp_pos[0], cmp_w1[0], cmp_w2[0])
    v_cmp = compress_blocks(kv[:, :, 1], cmp_pos[1], cmp_w1[1], cmp_w2[1])
    n_sel = s_ // SLC_LEN

    def sel_blocks(a):
        return a.reshape(b_, n_sel, SLC_LEN, NSA_KV, NSA_HD).transpose(0, 3, 1, 2, 4)

    k_slc = sel_blocks(apply_rope(kv[:, :, 2], cos, sin))
    v_slc = sel_blocks(kv[:, :, 3])
    pad = ((0, 0), (WIN, 0), (0, 0), (0, 0))
    k_win = jnp.pad(apply_rope(kv[:, :, 4], cos, sin), pad)
    v_win = jnp.pad(kv[:, :, 5], pad)
    return (k_cmp, v_cmp, k_slc, v_slc, k_win, v_win)


def selection_scores(imp, n_sel):
    r = SLC_LEN // CMP_STRIDE
    c = CMP_LEN // CMP_STRIDE
    n_cmp = imp.shape[-1]
    padded = jnp.pad(imp, [(0, 0)] * (imp.ndim - 1) + [(c - 1, r * n_sel - n_cmp)])
    out = None
    for m in range(r):
        for n in range(c):
            start = m - n + c - 1
            term = lax.slice_in_dim(padded, start, start + r * (n_sel - 1) + 1, stride=r, axis=-1)
            out = term if out is None else out + term
    return out


def nsa_attention(q, q_rot, gates, k_cmp, v_cmp, k_slc, v_slc, k_win, v_win):
    b_, s_, g_, j_, d_ = q.shape
    n_cmp = k_cmp.shape[1]
    n_sel = k_slc.shape[2]
    top = min(SLC_TOPK, n_sel)
    scale = d_ ** -0.5
    cmp_end = jnp.arange(n_cmp) * CMP_STRIDE + (CMP_LEN - 1)
    blk = jnp.arange(n_sel)
    bi = jnp.arange(b_)[:, None, None, None]
    gi = jnp.arange(g_)[None, :, None, None]

    def block(qi):
        t0 = qi * Q_BLOCK
        t = t0 + jnp.arange(Q_BLOCK)
        qb = lax.dynamic_slice_in_dim(q, t0, Q_BLOCK, axis=1)
        qr = lax.dynamic_slice_in_dim(q_rot, t0, Q_BLOCK, axis=1)
        gb = lax.dynamic_slice_in_dim(gates, t0, Q_BLOCK, axis=1)
        valid_c = cmp_end[None, :] <= t[:, None]
        s_c = jnp.einsum('bqgjd,bngd->bgjqn', qb, k_cmp).astype(jnp.float32) * scale
        p_c = jnp.where(valid_c, jax.nn.softmax(jnp.where(valid_c, s_c, NEG), axis=-1), 0.0)
        o_cmp = jnp.einsum('bgjqn,bngd->bqgjd', p_c.astype(v_cmp.dtype), v_cmp)
        p_slc = selection_scores(jnp.sum(p_c, axis=2), n_sel)
        cur = t // SLC_LEN
        forced = (blk[None, :] == 0) | (blk[None, :] == cur[:, None]) | (blk[None, :] == cur[:, None] - 1)
        score = jnp.where(blk[None, :] > cur[:, None], NEG, jnp.where(forced, BIG, p_slc))
        _, idx = lax.top_k(score, top)
        ks = k_slc[bi, gi, idx]
        vs = v_slc[bi, gi, idx]
        kpos = idx[..., None] * SLC_LEN + jnp.arange(SLC_LEN)
        valid_s = kpos <= t[None, None, :, None, None]
        s_s = jnp.einsum('bqgjd,bgqnld->bgjqnl', qr, ks).astype(jnp.float32) * scale
        s_s = jnp.where(valid_s[:, :, None], s_s, NEG).reshape(b_, g_, j_, Q_BLOCK, top * SLC_LEN)
        p_s = jax.nn.softmax(s_s, axis=-1).reshape(b_, g_, j_, Q_BLOCK, top, SLC_LEN)
        o_slc = jnp.einsum('bgjqnl,bgqnld->bqgjd', p_s.astype(vs.dtype), vs)
        kw = lax.dynamic_slice_in_dim(k_win, t0, Q_BLOCK + WIN, axis=1)
        vw = lax.dynamic_slice_in_dim(v_win, t0, Q_BLOCK + WIN, axis=1)
        spos = t0 - WIN + jnp.arange(Q_BLOCK + WIN)
        valid_w = (spos[None, :] <= t[:, None]) & (spos[None, :] > t[:, None] - WIN) & (spos[None, :] >= 0)
        s_w = jnp.einsum('bqgjd,bkgd->bgjqk', qr, kw).astype(jnp.float32) * scale
        p_w = jax.nn.softmax(jnp.where(valid_w, s_w, NEG), axis=-1)
        o_win = jnp.einsum('bgjqk,bkgd->bqgjd', p_w.astype(vw.dtype), vw)
        return gb[..., 0:1] * o_cmp + gb[..., 1:2] * o_slc + gb[..., 2:3] * o_win

    out = lax.map(block, jnp.arange(s_ // Q_BLOCK))
    return jnp.moveaxis(out, 0, 1).reshape(b_, s_, g_ * j_ * d_)


def nsa_mixer(xn, w_in, gate_bias, shared, cos, sin, mem_k, mem_v):
    b_, s_, _ = xn.shape
    k_cmp, v_cmp, k_slc, v_slc, k_win, v_win = shared
    q, gl, mq = split_cols(xn @ w_in, [MAIN_W, 3 * NSA_HEADS, MEM_W])
    q = q.reshape(b_, s_, NSA_HEADS, NSA_HD)
    q_rot = apply_rope(q, cos, sin)
    gates = jax.nn.sigmoid(gl + gate_bias).reshape(b_, s_, NSA_KV, NSA_GROUP, 3)
    shp = (b_, s_, NSA_KV, NSA_GROUP, NSA_HD)
    o = nsa_attention(q.reshape(shp), q_rot.reshape(shp), gates, k_cmp, v_cmp, k_slc, v_slc, k_win, v_win)
    mo = mem_attention(mq.reshape(b_, s_, MEM_HEADS, MEM_HD), mem_k, mem_v)
    return jnp.concatenate([o, mo], axis=-1)


def setup_inputs(seed: int = 0) -> dict:
    key = jax.random.key(seed)
    ks = jax.random.split(key, 24)
    f32 = jnp.float32

    def nrm(k, shape, scale):
        return scale * jax.random.normal(k, shape, f32)

    def gain(k, shape):
        return 1.0 + 0.02 * jax.random.normal(k, shape, f32)

    ig_bias = nrm(ks[10], (N_A, ML_HEADS), 0.1)
    fg_bias = jnp.linspace(3.0, 6.0, ML_HEADS, dtype=f32)[None, :] + nrm(ks[11], (N_A, ML_HEADS), 0.1)
    return {
        "x": nrm(ks[0], (BATCH, SEQ, D_MODEL), 1.0),
        "mem": nrm(ks[1], (BATCH, MEM_LEN, D_MODEL), 1.0),
        "norm_gains": gain(ks[2], (DEPTH, 6, D_MODEL)),
        "ffn_w_gate": nrm(ks[3], (DEPTH, 2, D_MODEL, D_FF), D_MODEL ** -0.5),
        "ffn_w_up": nrm(ks[4], (DEPTH, 2, D_MODEL, D_FF), D_MODEL ** -0.5),
        "ffn_w_down": nrm(ks[5], (DEPTH, 2, D_FF, D_MODEL), D_FF ** -0.5),
        "mem_norm": gain(ks[6], (DEPTH, D_MODEL)),
        "mem_w_kv": nrm(ks[7], (DEPTH, D_MODEL, 2 * MEM_W), D_MODEL ** -0.5),
        "w_out": nrm(ks[8], (DEPTH, MIX, D_MODEL), MIX ** -0.5),
        "a_w_in": nrm(ks[9], (N_A, D_MODEL, A_IN), D_MODEL ** -0.5),
        "a_gate_bias": jnp.concatenate([ig_bias, fg_bias], axis=-1),
        "a_head_norm": gain(ks[12], (N_A, ML_HEADS, ML_DV)),
        "kv_norm": gain(ks[13], (D_MODEL,)),
        "w_kv": nrm(ks[14], (D_MODEL, KV_W), D_MODEL ** -0.5),
        "cmp_pos": nrm(ks[15], (2, CMP_LEN, NSA_HD), 0.02),
        "cmp_w1": nrm(ks[16], (2, CMP_LEN * NSA_HD, CMP_HIDDEN), (CMP_LEN * NSA_HD) ** -0.5),
        "cmp_w2": nrm(ks[17], (2, CMP_HIDDEN, NSA_HD), CMP_HIDDEN ** -0.5),
        "b_w_in": nrm(ks[18], (N_B, D_MODEL, B_IN), D_MODEL ** -0.5),
        "b_gate_bias": nrm(ks[19], (N_B, 3 * NSA_HEADS), 0.1),
    }


def reference(x, mem, norm_gains, ffn_w_gate, ffn_w_up, ffn_w_down, mem_norm, mem_w_kv, w_out,
              a_w_in, a_gate_bias, a_head_norm, kv_norm, w_kv, cmp_pos, cmp_w1, cmp_w2,
              b_w_in, b_gate_bias):
    b_, s_, _ = x.shape
    m_len = mem.shape[1]
    cos, sin = rope_tables(s_, NSA_HD)
    shared = None
    for layer in range(DEPTH):
        if layer == N_A:
            shared = shared_kv(x, kv_norm, w_kv, cmp_pos, cmp_w1, cmp_w2, cos, sin)
        g = norm_gains[layer]
        x = half_ffn(x, g[0], g[1], ffn_w_gate[layer, 0], ffn_w_up[layer, 0], ffn_w_down[layer, 0])
        xn = rmsnorm(x, g[2])
        mem_k, mem_v = jnp.split((rmsnorm(mem, mem_norm[layer]) @ mem_w_kv[layer]).reshape(
            b_, m_len, 2, MEM_HEADS, MEM_HD), 2, axis=2)
        mem_k, mem_v = mem_k[:, :, 0], mem_v[:, :, 0]
        if layer < N_A:
            heads = mlstm_mixer(xn, a_w_in[layer], a_gate_bias[layer], a_head_norm[layer], mem_k, mem_v)
        else:
            lb = layer - N_A
            heads = nsa_mixer(xn, b_w_in[lb], b_gate_bias[lb], shared, cos, sin, mem_k, mem_v)
        x = x + rmsnorm(heads @ w_out[layer], g[3])
        x = half_ffn(x, g[4], g[5], ffn_w_gate[layer, 1], ffn_w_up[layer, 1], ffn_w_down[layer, 1])
    return x
```

```cpp
#include <hip/hip_runtime.h>
#include <cstdio>
#include <cstdint>

#ifndef MK_PER_PHASE
#define MK_PER_PHASE 0
#endif

#define LAS __attribute__((address_space(3)))
#define GAS __attribute__((address_space(1)))
typedef unsigned short u16;
typedef _Float16 f16;
typedef _Float16 h8 __attribute__((ext_vector_type(8)));
typedef _Float16 h4 __attribute__((ext_vector_type(4)));
typedef _Float16 h2 __attribute__((ext_vector_type(2)));
typedef float f32x4 __attribute__((ext_vector_type(4)));
typedef float f32x2 __attribute__((ext_vector_type(2)));
typedef unsigned u32x4 __attribute__((ext_vector_type(4)));
typedef unsigned u32x2 __attribute__((ext_vector_type(2)));

__device__ __forceinline__ unsigned pkh(float a, float b) { h2 v = __builtin_convertvector((f32x2){a, b}, h2); return __builtin_bit_cast(unsigned, v); }

namespace pg8 {
#define PG8_LAS __attribute__((address_space(3)))
constexpr int BM = 256, BK = 64, HALF = 128, HTB = HALF * BK * 2, STAGE_BYTES = 8 * HTB, NXCD = 8, WGM = 8;
__host__ __device__ __forceinline__ int lds_byte(int r, int c) { const int st = (r >> 4) * 2 + (c >> 5), rr = r & 15, cc = c & 31, ob = rr * 64 + cc * 2; return st * 1024 + (ob ^ (((ob >> 9) & 1) << 5)); }
__host__ __device__ __forceinline__ void stage_rc(int b, int& R, int& C) { const int st = b / 1024, sb = b % 1024, swz = sb ^ (((sb >> 9) & 1) << 5); R = (st >> 1) * 16 + swz / 64; C = (st & 1) * 32 + (swz % 64) / 2; }
__host__ __device__ __forceinline__ int perm32(int rho) { const int n = rho >> 4, i = rho & 15; return 8 * (i >> 2) + 4 * n + (i & 3); }

struct Unit { int pm, pn; };
struct Gemm { const u16* A; const u16* Bt; int M, N, K, lda, ldb; };

struct StaticOrder {
    int nM, nN, nwg, G, c;
    __host__ __device__ void init(int M, int N, int G_, int c_) { nM = M / BM; nN = N / BM; nwg = nM * nN; G = G_; c = c_; }
    __host__ __device__ bool next(int i, Unit& u) const {
        const long L = (long)i * G + c; if (L >= nwg) return false;
        int wgid = (int)L; { const int q = nwg / NXCD, r = nwg % NXCD, xcd = wgid % NXCD, off = wgid / NXCD; wgid = (xcd < r ? xcd * (q + 1) : r * (q + 1) + (xcd - r) * q) + off; }
        const int nig = WGM * nN, gid = wgid / nig, fm = gid * WGM, gsz = (nM - fm) < WGM ? (nM - fm) : WGM;
        u.pm = fm + ((wgid % nig) % gsz); u.pn = (wgid % nig) / gsz; return true;
    }
    __device__ __forceinline__ void a_ready(const Unit&) const {}
    __device__ __forceinline__ void done(const Unit&) const {}
};

struct EpiF32 {
    static constexpr bool PERM = false, AFTER_DRAIN = false;
    float* C; int ldc;
    __device__ __forceinline__ void operator()(const f32x4 (&acc)[2][2][4][2], const Unit& u, int wr, int wc, int fr, int fq) const {
        const int row0 = u.pm * BM + wr * 64 + fr, col0 = u.pn * BM + wc * 32 + 4 * fq;
#pragma unroll
        for (int ai = 0; ai < 2; ++ai)
#pragma unroll
            for (int m = 0; m < 4; ++m) { float* rowp = C + (size_t)(row0 + ai * HALF + m * 16) * ldc + col0;
#pragma unroll
                for (int bj = 0; bj < 2; ++bj)
#pragma unroll
                    for (int n = 0; n < 2; ++n) *(f32x4*)(rowp + bj * HALF + n * 16) = acc[ai][bj][m][n]; }
    }
};
__device__ __forceinline__ float gelu_tanh(float x) { const float z = 1.5957691216057308f * (x + 0.044715f * x * x * x); return x * __builtin_amdgcn_rcpf(1.0f + __builtin_amdgcn_exp2f(-1.4426950408889634f * z)); }
template <int ACT> struct EpiF16 {
    static constexpr bool PERM = true, AFTER_DRAIN = false;
    u16* O; int ldc; const float* bias;
    __device__ __forceinline__ void operator()(const f32x4 (&acc)[2][2][4][2], const Unit& u, int wr, int wc, int fr, int fq) const {
        const int row0 = u.pm * BM + wr * 64 + fr, col0 = u.pn * BM + wc * 32 + 8 * fq;
#pragma unroll
        for (int ai = 0; ai < 2; ++ai)
#pragma unroll
            for (int m = 0; m < 4; ++m) { u16* rowp = O + (size_t)(row0 + ai * HALF + m * 16) * ldc + col0;
#pragma unroll
                for (int bj = 0; bj < 2; ++bj) { f32x4 v0 = acc[ai][bj][m][0], v1 = acc[ai][bj][m][1];
                    if (ACT == 1) { const f32x4 b0 = *(const f32x4*)(bias + col0 + bj * HALF), b1 = *(const f32x4*)(bias + col0 + bj * HALF + 4); v0 = v0 + b0; v1 = v1 + b1;
#pragma unroll
                        for (int j = 0; j < 4; ++j) { v0[j] = gelu_tanh(v0[j]); v1[j] = gelu_tanh(v1[j]); } }
                    u32x4 w; w.x = pkh(v0[0], v0[1]); w.y = pkh(v0[2], v0[3]); w.z = pkh(v1[0], v1[1]); w.w = pkh(v1[2], v1[3]);
                    *(u32x4*)(rowp + bj * HALF) = w; } }
    }
};
struct EpiSwiGLU {
    static constexpr bool PERM = true, AFTER_DRAIN = false;
    u16* H; int ldh;
    __device__ __forceinline__ void operator()(const f32x4 (&acc)[2][2][4][2], const Unit& u, int wr, int wc, int fr, int fq) const {
        const int row0 = u.pm * BM + wr * 64 + fr, col0 = u.pn * HALF + wc * 32 + 8 * fq;
#pragma unroll
        for (int ai = 0; ai < 2; ++ai)
#pragma unroll
            for (int m = 0; m < 4; ++m) { u16* rowp = H + (size_t)(row0 + ai * HALF + m * 16) * ldh + col0; float o[8];
#pragma unroll
                for (int n = 0; n < 2; ++n)
#pragma unroll
                    for (int j = 0; j < 4; ++j) { const float g = acc[ai][0][m][n][j], up = acc[ai][1][m][n][j];
                        o[n * 4 + j] = g * __builtin_amdgcn_rcpf(1.0f + __builtin_amdgcn_exp2f(-1.4426950408889634f * g)) * up; }
                u32x4 w; w.x = pkh(o[0], o[1]); w.y = pkh(o[2], o[3]); w.z = pkh(o[4], o[5]); w.w = pkh(o[6], o[7]);
                *(u32x4*)rowp = w; }
    }
};

template <class Epi, class Sched, bool ALIGN_EPI, bool SP2, bool AMODE>
__device__ __forceinline__ void gemm_phase(PG8_LAS unsigned char* lds, const Gemm g, const Sched& S, const Epi& E, const int tid) {
    const int wid = __builtin_amdgcn_readfirstlane(tid >> 6), lane = tid & 63, wr = wid >> 2, wc = wid & 3, fr = lane & 15, fq = lane >> 4;
    const int K = g.K, nt = K / BK;
    unsigned voffA[2], voffB[2];
#pragma unroll
    for (int i = 0; i < 2; ++i) { int R, C; stage_rc(tid * 16 + i * 8192, R, C); const int Rb = Epi::PERM ? ((R & ~31) + perm32(R & 31)) : R;
        voffA[i] = (unsigned)(R * g.lda + C) * 2u; voffB[i] = (unsigned)(Rb * g.ldb + C) * 2u; }
    const size_t kstep = (size_t)(BK * 2);
    const size_t hstepA = (size_t)HALF * g.lda * 2, hstepB = (size_t)HALF * g.ldb * 2;
    const size_t tstepA = 2 * hstepA, tstepB = 2 * hstepB;
    const unsigned ldsw = (unsigned)wid * 1024u;
    const int aoff = lds_byte(wr * 64 + fr, fq * 8), boff = lds_byte(wc * 32 + fr, fq * 8);
#define PG8_KOA(t) (AMODE ? ((size_t)((t) >> 1) * 3072u + (size_t)((t) & 1) * 128u) : (size_t)(t) * kstep)
#define PG8_SA(b, h) (((b) * 2 + (h)) * HTB)
#define PG8_SB(b, h) ((4 + (b) * 2 + (h)) * HTB)
#define PG8_STAGE(bufoff, gbase, voff) do { _Pragma("unroll") for (int _i = 0; _i < 2; ++_i) \
        __builtin_amdgcn_global_load_lds((const unsigned*)((const char*)(gbase) + (voff)[_i]), (PG8_LAS unsigned*)(lds + (bufoff) + ldsw + _i * 8192), 16, 0, 0); } while (0)
#define PG8_LDA(dst, b, h) do { _Pragma("unroll") for (int m = 0; m < 4; ++m) _Pragma("unroll") for (int k = 0; k < 2; ++k) dst[m][k] = *(const PG8_LAS h8*)(lds + PG8_SA(b, h) + aoff + m * 2048 + k * 1024); } while (0)
#define PG8_LDB(dst, b, h) do { _Pragma("unroll") for (int n = 0; n < 2; ++n) _Pragma("unroll") for (int k = 0; k < 2; ++k) dst[n][k] = *(const PG8_LAS h8*)(lds + PG8_SB(b, h) + boff + n * 2048 + k * 1024); } while (0)
#define PG8_MMA(ai, bj, At, Bt) do { __builtin_amdgcn_s_setprio(1); _Pragma("unroll") for (int m = 0; m < 4; ++m) _Pragma("unroll") for (int n = 0; n < 2; ++n) _Pragma("unroll") for (int k = 0; k < 2; ++k) \
        acc[ai][bj][m][n] = __builtin_amdgcn_mfma_f32_16x16x32_f16(Bt[n][k], At[m][k], acc[ai][bj][m][n], 0, 0, 0); __builtin_amdgcn_s_setprio(0); } while (0)
#define PG8_WAIT_V(n) asm volatile("s_waitcnt vmcnt(" #n ")" ::: "memory")
#define PG8_WAIT_L(n) asm volatile("s_waitcnt lgkmcnt(" #n ")" ::: "memory")
#define PG8_BAR __builtin_amdgcn_s_barrier()
#define PG8_SCHED __builtin_amdgcn_sched_barrier(0)
    Unit cur, nxt; int ui = 0;
    if (!S.next(0, cur)) return;
    f32x4 acc[2][2][4][2];
#pragma unroll
    for (int a = 0; a < 2; ++a)
#pragma unroll
        for (int b = 0; b < 2; ++b)
#pragma unroll
            for (int m = 0; m < 4; ++m)
#pragma unroll
                for (int n = 0; n < 2; ++n) acc[a][b][m][n] = (f32x4){0.f, 0.f, 0.f, 0.f};
    h8 At[4][2], B0[2][2], B1[2][2];
    const char* cA = (const char*)g.A + (size_t)cur.pm * tstepA; const char* cB = (const char*)g.Bt + (size_t)cur.pn * tstepB;
    S.a_ready(cur);
    if constexpr (SP2) {
        PG8_STAGE(PG8_SB(0, 0), cB, voffB); PG8_STAGE(PG8_SB(0, 1), cB + hstepB, voffB); PG8_STAGE(PG8_SA(0, 0), cA, voffA); PG8_STAGE(PG8_SA(0, 1), cA + hstepA, voffA);
        if (wr == 1) PG8_BAR;
        PG8_WAIT_V(2); PG8_BAR;
        PG8_STAGE(PG8_SB(1, 0), cB + kstep, voffB); PG8_STAGE(PG8_SA(1, 0), cA + kstep, voffA); PG8_STAGE(PG8_SB(1, 1), cB + hstepB + kstep, voffB);
        PG8_WAIT_V(6); PG8_BAR;
    } else {
        PG8_STAGE(PG8_SB(0, 0), cB, voffB); PG8_STAGE(PG8_SA(0, 0), cA, voffA); PG8_STAGE(PG8_SB(0, 1), cB + hstepB, voffB); PG8_STAGE(PG8_SA(0, 1), cA + hstepA, voffA);
        if (wr == 1) PG8_BAR;
        PG8_WAIT_V(4); PG8_BAR;
        PG8_STAGE(PG8_SB(1, 0), cB + kstep, voffB); PG8_STAGE(PG8_SA(1, 0), cA + kstep, voffA); PG8_STAGE(PG8_SB(1, 1), cB + hstepB + kstep, voffB);
        PG8_WAIT_V(6); PG8_BAR;
    }
    for (;;) {
        const bool has_next = S.next(ui + 1, nxt);
        const char* nA = has_next ? (const char*)g.A + (size_t)nxt.pm * tstepA : cA; const char* nB = has_next ? (const char*)g.Bt + (size_t)nxt.pn * tstepB : cB;
        for (int t = 0; t < nt; t += 2) {
            const bool last = (t == nt - 2);
            const char* a1 = cA + PG8_KOA(t + 1);
            const char* a2 = last ? nA : cA + PG8_KOA(t + 2); const char* b2 = last ? nB : cB + (size_t)(t + 2) * kstep;
            const char* a3 = a2 + kstep; const char* b3 = b2 + kstep;
            if (last && has_next) S.a_ready(nxt);
            if constexpr (SP2) {
            PG8_LDB(B0, 0, 0); PG8_LDB(B1, 0, 1); PG8_SCHED; PG8_LDA(At, 0, 0); PG8_STAGE(PG8_SA(1, 1), a1 + hstepA, voffA);
            PG8_WAIT_V(8); PG8_WAIT_L(0); PG8_BAR; PG8_MMA(0, 0, At, B0); PG8_MMA(0, 1, At, B1); PG8_BAR; PG8_SCHED;
            PG8_LDA(At, 0, 1); PG8_STAGE(PG8_SB(0, 0), b2, voffB); PG8_STAGE(PG8_SB(0, 1), b2 + hstepB, voffB); PG8_STAGE(PG8_SA(0, 0), a2, voffA);
            PG8_WAIT_V(8); PG8_WAIT_L(0); PG8_BAR; PG8_MMA(1, 0, At, B0); PG8_MMA(1, 1, At, B1); PG8_BAR; PG8_SCHED;
            PG8_LDB(B0, 1, 0); PG8_LDB(B1, 1, 1); PG8_SCHED; PG8_LDA(At, 1, 0); PG8_STAGE(PG8_SA(0, 1), a2 + hstepA, voffA);
            PG8_WAIT_V(8); PG8_WAIT_L(0); PG8_BAR; PG8_MMA(0, 0, At, B0); PG8_MMA(0, 1, At, B1); PG8_BAR; PG8_SCHED;
            PG8_LDA(At, 1, 1); PG8_STAGE(PG8_SB(1, 0), b3, voffB); PG8_STAGE(PG8_SB(1, 1), b3 + hstepB, voffB); PG8_STAGE(PG8_SA(1, 0), a3, voffA);
            PG8_WAIT_V(8); PG8_WAIT_L(0); PG8_BAR; PG8_MMA(1, 0, At, B0); PG8_MMA(1, 1, At, B1); PG8_BAR; PG8_SCHED;
            } else {
            PG8_LDB(B0, 0, 0); PG8_SCHED; PG8_LDA(At, 0, 0); PG8_STAGE(PG8_SA(1, 1), a1 + hstepA, voffA);
            PG8_WAIT_L(8); PG8_BAR; PG8_WAIT_L(0); PG8_MMA(0, 0, At, B0); PG8_BAR; PG8_SCHED;
            PG8_LDB(B1, 0, 1); PG8_STAGE(PG8_SB(0, 0), b2, voffB);
            PG8_BAR; PG8_WAIT_L(0); PG8_MMA(0, 1, At, B1); PG8_BAR;
            PG8_LDA(At, 0, 1); PG8_STAGE(PG8_SA(0, 0), a2, voffA);
            PG8_BAR; PG8_WAIT_L(0); PG8_MMA(1, 0, At, B0); PG8_BAR; PG8_SCHED;
            PG8_STAGE(PG8_SB(0, 1), b2 + hstepB, voffB);
            PG8_WAIT_V(6); PG8_BAR; PG8_MMA(1, 1, At, B1); PG8_BAR;
            PG8_LDB(B0, 1, 0); PG8_SCHED; PG8_LDA(At, 1, 0); PG8_STAGE(PG8_SA(0, 1), a2 + hstepA, voffA);
            PG8_WAIT_L(8); PG8_BAR; PG8_WAIT_L(0); PG8_MMA(0, 0, At, B0); PG8_BAR; PG8_SCHED;
            PG8_LDB(B1, 1, 1); PG8_STAGE(PG8_SB(1, 0), b3, voffB);
            PG8_BAR; PG8_WAIT_L(0); PG8_MMA(0, 1, At, B1); PG8_BAR;
            PG8_LDA(At, 1, 1); PG8_STAGE(PG8_SA(1, 0), a3, voffA);
            PG8_BAR; PG8_WAIT_L(0); PG8_MMA(1, 0, At, B0); PG8_BAR; PG8_SCHED;
            PG8_STAGE(PG8_SB(1, 1), b3 + hstepB, voffB);
            PG8_WAIT_V(6); PG8_BAR; PG8_MMA(1, 1, At, B1); PG8_BAR;
            }
        }
        if constexpr (ALIGN_EPI) { if (wr == 0) PG8_BAR; }
        E(acc, cur, wr, wc, fr, fq); S.done(cur);
        if (!has_next) break;
#pragma unroll
        for (int a = 0; a < 2; ++a)
#pragma unroll
            for (int b = 0; b < 2; ++b)
#pragma unroll
                for (int m = 0; m < 4; ++m)
#pragma unroll
                    for (int n = 0; n < 2; ++n) acc[a][b][m][n] = (f32x4){0.f, 0.f, 0.f, 0.f};
        cur = nxt; cA = nA; cB = nB; ++ui;
        if constexpr (ALIGN_EPI) { if (wr == 1) PG8_BAR; }
    }
    PG8_WAIT_V(0);
    if constexpr (!ALIGN_EPI) { if (wr == 0) PG8_BAR; }
    PG8_BAR;
#undef PG8_KOA
#undef PG8_SA
#undef PG8_SB
#undef PG8_STAGE
#undef PG8_LDA
#undef PG8_LDB
#undef PG8_MMA
#undef PG8_WAIT_V
#undef PG8_WAIT_L
#undef PG8_BAR
#undef PG8_SCHED
}
}

constexpr int NWAVES = 8;
constexpr int S = 16384, D = 2048, FF = 5632;
constexpr int MEM_LEN = 256, MEM_W = 512;
constexpr int MAIN_W = 1536;
constexpr int ML_H = 4, ML_DQK = 192, ML_DV = 384, ML_L = 64, ML_NC = S / ML_L;
constexpr int A_INW = 5128, A_N = 5120;
constexpr int B_INW = 2084, B_N = 2048;
constexpr int KVW = 1536;
constexpr int NCMP = 1023;
constexpr float EPS = 1e-6f;

constexpr size_t MiB = 1u << 20;
constexpr size_t WS_CTL = 0, CTL_ZERO_BYTES = 64 * 1024;
constexpr size_t WS_MEMN  = 1 * MiB;
constexpr size_t WS_MEMKV = 3 * MiB;
constexpr size_t WS_GA    = 4 * MiB;
constexpr size_t WS_GB    = 5 * MiB;
constexpr size_t WS_WGA   = 8 * MiB;
constexpr size_t WS_WGB   = 8 * MiB + 128 * 1024;
constexpr size_t WS_CB1   = 8 * MiB + 512 * 1024;
constexpr size_t WS_B63   = 8 * MiB + 520 * 1024;
constexpr size_t WS_MLOC  = 8 * MiB + 524 * 1024;
constexpr size_t WS_MST   = 8 * MiB + 528 * 1024;
constexpr size_t WS_DN    = 9 * MiB;
constexpr size_t WS_KVC   = 10 * MiB;
constexpr size_t WS_CMPH  = 11 * MiB;
constexpr size_t WS_ROPE  = 13 * MiB;
constexpr size_t WS_W     = 24 * MiB;
constexpr size_t WS_WGU   = WS_W;
constexpr size_t WS_WD    = WS_WGU + 176 * MiB;
constexpr size_t WS_WAIN  = WS_WD + 88 * MiB;
constexpr size_t WS_WOUT  = WS_WAIN + 20 * MiB;
constexpr size_t WS_WKV   = WS_WOUT + 16 * MiB;
constexpr size_t WS_WBIN  = WS_WKV + 6 * MiB;
constexpr size_t WS_WMKV  = WS_WBIN + 8 * MiB;
constexpr size_t WS_WC1   = WS_WMKV + 8 * MiB;
constexpr size_t WS_WC2   = WS_WC1 + 4 * MiB;
constexpr size_t WS_XN    = WS_WC2 + 1 * MiB;
constexpr size_t WS_SCR   = WS_XN + 64 * MiB;
constexpr size_t WS_H     = WS_SCR;
constexpr size_t WS_Y     = WS_SCR + 176 * MiB;
constexpr size_t WS_CT    = WS_SCR;
constexpr size_t WS_AOUT  = WS_SCR + 144 * MiB;
constexpr size_t WS_XKV   = WS_SCR;
constexpr size_t WS_BOUT  = WS_SCR;
constexpr size_t WS_KVRAW = WS_SCR + 304 * MiB;
constexpr size_t WS_END   = WS_KVRAW + 48 * MiB + 128 * 1024;
constexpr int CW_TMO = 0;
constexpr int CW_BAR = 4096;

constexpr int RING_OFF = 0, RING_BYTES = 131072;
constexpr int LDSCTL_OFF = RING_BYTES, MISC_OFF = LDSCTL_OFF + 320;
constexpr int LDS_BYTES = 147456;

typedef GAS unsigned gu32;
#define RLX_AGENT __ATOMIC_RELAXED, __HIP_MEMORY_SCOPE_AGENT
#define LDS_WAIT() asm volatile("s_waitcnt lgkmcnt(0)" ::: "memory")
#define VM_WAIT() asm volatile("s_waitcnt vmcnt(0)" ::: "memory")

#define XB_TMO      128
#define XB_XCNT(j)  (256  + 64 * (j))
#define XB_XSUB(j)  (1280 + 64 * (j))
#define XB_XGEN(j)  (2304 + 64 * (j))
#define XB_TOP      3328
#define XB_TOPGEN   3392
#define XCD_BAR_WORDS 3456
#define XB_SPIN_CAP (1u << 18)

__device__ __forceinline__ unsigned xb_ld(unsigned* p)              { return __hip_atomic_load(p, __ATOMIC_RELAXED, __HIP_MEMORY_SCOPE_AGENT); }
__device__ __forceinline__ unsigned xb_add(unsigned* p, unsigned v) { return __hip_atomic_fetch_add(p, v, __ATOMIC_RELAXED, __HIP_MEMORY_SCOPE_AGENT); }
__device__ __forceinline__ unsigned xb_xcc_id() { return (unsigned)__builtin_amdgcn_s_getreg((3 << 11) | 20) & 0xFu; }
#define XB_SPIN(cond, bar) do { unsigned _sp = 0; while (cond) { __builtin_amdgcn_s_sleep(1); \
    if ((++_sp & 255u) == 0u) { if (xb_ld(&(bar)[XB_TMO])) break; if (_sp > XB_SPIN_CAP) { atomicAdd(&(bar)[XB_TMO], 1u); break; } } } } while (0)

struct XcdBarrier { unsigned* bar; unsigned x; volatile LAS unsigned* st; };

__device__ __forceinline__ XcdBarrier xcd_barrier_post(unsigned* bar, volatile LAS unsigned* st) {
    XcdBarrier b; b.bar = bar; b.x = xb_xcc_id(); b.st = st;
    if (threadIdx.x == 0) (void)xb_add(&bar[XB_XCNT(b.x)], 1u);
    return b;
}
__device__ __forceinline__ void xcd_barrier_complete(unsigned* bar, unsigned x, unsigned& nloc, unsigned& nx) {
    const unsigned G = gridDim.x * gridDim.y * gridDim.z;
    unsigned sum, cnt, mine, sp = 0u;
    for (;;) {
        sum = 0u; cnt = 0u; mine = 0u;
#pragma unroll
        for (unsigned j = 0; j < 16; ++j) { const unsigned c = xb_ld(&bar[XB_XCNT(j)]); sum += c; cnt += (c > 0u) ? 1u : 0u; mine = (j == x) ? c : mine; }
        if (sum == G) break;
        __builtin_amdgcn_s_sleep(1);
        if ((++sp & 255u) == 0u) { if (xb_ld(&bar[XB_TMO])) break; if (sp > XB_SPIN_CAP) { atomicAdd(&bar[XB_TMO], 1u); break; } }
    }
    nloc = mine > 0u ? mine : 1u; nx = cnt > 0u ? cnt : 1u;
}
__device__ __forceinline__ void xcd_barrier(const XcdBarrier& b) {
    asm volatile("s_waitcnt vmcnt(0)" ::: "memory");
    __syncthreads();
    if (threadIdx.x == 0) {
        unsigned* bar = b.bar;
        __builtin_amdgcn_s_waitcnt(0);
        unsigned nloc = b.st[0], nx = b.st[1];
        if (nloc == 0u) { xcd_barrier_complete(bar, b.x, nloc, nx); b.st[0] = nloc; b.st[1] = nx; }
        const unsigned old = xb_add(&bar[XB_XSUB(b.x)], 1u);
        const unsigned gen = old / nloc;
        if (old + 1u == (gen + 1u) * nloc) {
            __builtin_amdgcn_fence(__ATOMIC_RELEASE, "agent");
            asm volatile("s_waitcnt vmcnt(0)" ::: "memory");
            const unsigned og = xb_add(&bar[XB_TOP], 1u);
            const unsigned tg = og / nx;
            if (og + 1u == (tg + 1u) * nx) xb_add(&bar[XB_TOPGEN], 1u);
            else XB_SPIN(xb_ld(&bar[XB_TOPGEN]) == tg, bar);
            __builtin_amdgcn_fence(__ATOMIC_ACQUIRE, "agent");
            xb_add(&bar[XB_XGEN(b.x)], 1u);
            asm volatile("s_waitcnt vmcnt(0)" ::: "memory");
        } else {
            XB_SPIN(xb_ld(&bar[XB_XGEN(b.x)]) == gen, bar);
            __builtin_amdgcn_fence(__ATOMIC_ACQUIRE, "agent");
            asm volatile("s_waitcnt vmcnt(0)" ::: "memory");
        }
    }
    __syncthreads();
}

__device__ __forceinline__ float wave_sum(float v) {
#pragma unroll
    for (int o = 1; o < 64; o <<= 1) v += __shfl_xor(v, o);
    return v;
}
__device__ __forceinline__ float wave_max(float v) {
#pragma unroll
    for (int o = 1; o < 64; o <<= 1) v = fmaxf(v, __shfl_xor(v, o));
    return v;
}
__device__ __forceinline__ float sigmoidf_(float x) { return 1.0f / (1.0f + __expf(-x)); }
__device__ __forceinline__ float log_sigmoidf_(float x) { return fminf(x, 0.f) - log1pf(__expf(-fabsf(x))); }

__device__ __forceinline__ void cvt_item(const float* W, int ldw, int col0, int k0, u16* WT, int Kdst, int drow0, float scale, LAS float* scr, int lane) {
#pragma unroll 8
    for (int i = 0; i < 32; ++i) { const int kk = 2 * i + (lane >> 5); scr[kk * 33 + (lane & 31)] = W[(size_t)(k0 + kk) * ldw + col0 + (lane & 31)]; }
    LDS_WAIT(); asm volatile("" ::: "memory");
    const int c = lane & 7;
#pragma unroll
    for (int j = 0; j < 4; ++j) { const int n = (lane >> 3) + 8 * j; const LAS float* s = scr + (8 * c) * 33 + n;
        u32x4 o; o.x = pkh(s[0 * 33] * scale, s[1 * 33] * scale); o.y = pkh(s[2 * 33] * scale, s[3 * 33] * scale); o.z = pkh(s[4 * 33] * scale, s[5 * 33] * scale); o.w = pkh(s[6 * 33] * scale, s[7 * 33] * scale);
        *(GAS u32x4*)(WT + (size_t)(drow0 + n) * Kdst + k0 + 8 * c) = o; }
    LDS_WAIT(); asm volatile("" ::: "memory");
}

template <int NG>
__device__ __forceinline__ void thin_rows(const float* Y, float alpha, const float* gpost, const float* Xin, float* Xout,
                                          const float* gpre1, u16* XN1, const float* gpre2, u16* XN2,
                                          const float* WgT, const float* gbias, float* gates, bool gate_sigmoid, int gw, int NGW, int lane) {
    for (int row = gw; row < S; row += NGW) {
        f32x4 x[8];
        const GAS f32x4* xr = (const GAS f32x4*)(Xin + (size_t)row * D) + lane;
#pragma unroll
        for (int j = 0; j < 8; ++j) x[j] = xr[64 * j];
        if (Y) {
            f32x4 y[8]; float ss = 0.f;
            const GAS f32x4* yr = (const GAS f32x4*)(Y + (size_t)row * D) + lane;
#pragma unroll
            for (int j = 0; j < 8; ++j) { y[j] = yr[64 * j]; ss += (y[j].x * y[j].x + y[j].y * y[j].y) + (y[j].z * y[j].z + y[j].w * y[j].w); }
            const float r = alpha * rsqrtf(wave_sum(ss) * (1.0f / D) + EPS);
#pragma unroll
            for (int j = 0; j < 8; ++j) { const f32x4 g = ((const GAS f32x4*)gpost)[lane + 64 * j]; x[j] = x[j] + y[j] * g * r; }
        }
        if (Xout) { GAS f32x4* xo = (GAS f32x4*)(Xout + (size_t)row * D) + lane;
#pragma unroll
            for (int j = 0; j < 8; ++j) xo[64 * j] = x[j]; }
        if (XN1) {
            float ss = 0.f;
#pragma unroll
            for (int j = 0; j < 8; ++j) ss += (x[j].x * x[j].x + x[j].y * x[j].y) + (x[j].z * x[j].z + x[j].w * x[j].w);
            const float r = rsqrtf(wave_sum(ss) * (1.0f / D) + EPS);
#pragma unroll
            for (int j = 0; j < 8; ++j) x[j] = x[j] * r;
            if (XN2) { GAS u32x2* o2 = (GAS u32x2*)(XN2 + (size_t)row * D) + lane;
#pragma unroll
                for (int j = 0; j < 8; ++j) { const f32x4 g = ((const GAS f32x4*)gpre2)[lane + 64 * j]; const f32x4 v = x[j] * g; u32x2 w; w.x = pkh(v.x, v.y); w.y = pkh(v.z, v.w); o2[64 * j] = w; } }
            GAS u32x2* o1 = (GAS u32x2*)(XN1 + (size_t)row * D) + lane;
#pragma unroll
            for (int j = 0; j < 8; ++j) { const f32x4 g = ((const GAS f32x4*)gpre1)[lane + 64 * j]; x[j] = x[j] * g; u32x2 w; w.x = pkh(x[j].x, x[j].y); w.y = pkh(x[j].z, x[j].w); o1[64 * j] = w; }
            if (NG > 0) {
                for (int gi = 0; gi < NG; ++gi) {
                    const GAS f32x4* wr = (const GAS f32x4*)(WgT + (size_t)gi * D) + lane; float a = 0.f;
#pragma unroll
                    for (int j = 0; j < 8; ++j) { const f32x4 w = wr[64 * j]; a += (x[j].x * w.x + x[j].y * w.y) + (x[j].z * w.z + x[j].w * w.w); }
                    a = wave_sum(a) + gbias[gi];
                    if (gate_sigmoid) a = sigmoidf_(a);
                    if (lane == 0) gates[(size_t)row * NG + gi] = a;
                }
            }
        }
    }
}

__device__ __forceinline__ void mem_attn_scalar(const u16* Q, int ldq, int qoff, const u16* MKV, u16* HEADS, int gw, int NGW, int lane) {
    const float scale = 0.08838834764831845f;
    for (int item = gw; item < S * 4; item += NGW) {
        const int t = item >> 2, hd = item & 3;
        const h8* qp = (const h8*)(Q + (size_t)t * ldq + qoff + hd * 128);
        float sc[4];
#pragma unroll
        for (int i = 0; i < 4; ++i) { const int key = lane + 64 * i; const h8* kr = (const h8*)(MKV + (size_t)key * 1024 + hd * 128); float a = 0.f;
#pragma unroll 4
            for (int c = 0; c < 16; ++c) { const h8 kv = kr[c], qv = qp[c];
#pragma unroll
                for (int e = 0; e < 8; ++e) a += (float)kv[e] * (float)qv[e]; }
            sc[i] = a * scale; }
        const float m = wave_max(fmaxf(fmaxf(sc[0], sc[1]), fmaxf(sc[2], sc[3])));
        float p[4], ls = 0.f;
#pragma unroll
        for (int i = 0; i < 4; ++i) { p[i] = __expf(sc[i] - m); ls += p[i]; }
        const float l = wave_sum(ls);
        float o0 = 0.f, o1 = 0.f;
#pragma unroll
        for (int i = 0; i < 4; ++i) {
            for (int kk = 0; kk < 64; ++kk) { const float pk = __builtin_bit_cast(float, __builtin_amdgcn_readlane(__builtin_bit_cast(int, p[i]), kk));
                const h2 vv = *(const h2*)(MKV + (size_t)(kk + 64 * i) * 1024 + 512 + hd * 128 + 2 * lane); o0 += pk * (float)vv[0]; o1 += pk * (float)vv[1]; } }
        const float il = 1.0f / l;
        *(unsigned*)(HEADS + (size_t)t * D + MAIN_W + hd * 128 + 2 * lane) = pkh(o0 * il, o1 * il);
    }
}

struct Args { const float* in[19]; float* out; unsigned char* ws; int ph_lo, ph_hi, li, pad; };
typedef const Args __attribute__((address_space(4))) CArgs;
#define I_X 0
#define I_MEM 1
#define I_NG 2
#define I_WG 3
#define I_WU 4
#define I_WDN 5
#define I_MEMNORM 6
#define I_MEMWKV 7
#define I_WOUT 8
#define I_AWIN 9
#define I_AGB 10
#define I_AHN 11
#define I_KVN 12
#define I_WKV 13
#define I_CPOS 14
#define I_CW1 15
#define I_CW2 16
#define I_BWIN 17
#define I_BGB 18
#define WSP(T, off) ((T*)(ws + (off)))

__global__ void __launch_bounds__(NWAVES * 64, 2) yoco_fwd(Args args) {
    extern __shared__ __attribute__((aligned(16))) unsigned char lds_raw[];
    LAS unsigned char* lds = (LAS unsigned char*)lds_raw;
    const int G = gridDim.x;
    { volatile LAS unsigned* MISC0 = (volatile LAS unsigned*)(lds + LDSCTL_OFF);
      for (int u = threadIdx.x; u < (LDS_BYTES - LDSCTL_OFF) / 4; u += NWAVES * 64) MISC0[u] = 0u; }
    __syncthreads();
    XcdBarrier bar; bar.bar = (unsigned*)(args.ws + WS_CTL) + CW_BAR; bar.x = 0; bar.st = nullptr;
    if (!MK_PER_PHASE) bar = xcd_barrier_post((unsigned*)(args.ws + WS_CTL) + CW_BAR, (volatile LAS unsigned*)(lds + MISC_OFF) + 8);

    const int lo = args.ph_lo, hi = args.ph_hi;
    int ph = 0;
#define PH_BEGIN if (lo <= ph && ph < hi) { \
        int tid = (int)threadIdx.x; asm volatile("" : "+v"(tid)); \
        const int lane = tid & 63, wave = __builtin_amdgcn_readfirstlane(tid >> 6); \
        const int gw = (int)blockIdx.x * NWAVES + wave, NGW = G * NWAVES; \
        CArgs* ap = (CArgs*)__builtin_amdgcn_kernarg_segment_ptr(); asm volatile("" : "+s"(ap)); \
        unsigned char* ws = ap->ws; (void)lane; (void)gw; (void)NGW; (void)ws;
#define PH_END   if (ph + 1 < hi) { if (MK_PER_PHASE) { if (threadIdx.x == 0) __hip_atomic_store((gu32*)(args.ws + WS_CTL) + CW_TMO, 0xBADBA0u, RLX_AGENT); } else xcd_barrier(bar); } } ++ph;

    PH_BEGIN
    {
        LAS float* scr = (LAS float*)(lds + RING_OFF + wave * 16384);
        constexpr int J_FF = 5632;
        constexpr int J_AIN = 32 * 160, J_WOUT = 2048, J_WKVI = 32 * 48, J_BIN = 2048, J_MKV = 1024, J_C1 = 512, J_C2 = 16;
        constexpr int NIT = 12 * J_FF + J_AIN + 2 * J_WOUT + J_WKVI + J_BIN + 2 * J_MKV + 2 * J_C1 + 2 * J_C2;
        for (int it = gw; it < NIT; it += NGW) {
            int r = it;
            if (r < 12 * J_FF) { const int job = r / J_FF, idx = job / 3, kind = job % 3; r -= job * J_FF;
                if (kind < 2) { const int nblk = FF / 32, kb = r / nblk, nb = r % nblk, n0 = nb * 32;
                    cvt_item(ap->in[kind == 0 ? I_WG : I_WU] + (size_t)idx * D * FF, FF, n0, kb * 64, WSP(u16, WS_WGU) + (size_t)idx * 2 * FF * D, D, 256 * (n0 >> 7) + (n0 & 127) + (kind ? 128 : 0), 1.0f, scr, lane); }
                else { const int nblk = D / 32, kb = r / nblk, nb = r % nblk;
                    cvt_item(ap->in[I_WDN] + (size_t)idx * FF * D, D, nb * 32, kb * 64, WSP(u16, WS_WD) + (size_t)idx * D * FF, FF, nb * 32, 1.0f, scr, lane); }
                continue; }
            r -= 12 * J_FF;
            if (r < J_AIN) { const int nblk = A_N / 32, kb = r / nblk, nb = r % nblk, n0 = nb * 32;
                cvt_item(ap->in[I_AWIN], A_INW, n0 < 4608 ? n0 : n0 + 8, kb * 64, WSP(u16, WS_WAIN), D, n0, (n0 >= 768 && n0 < 1536) ? 0.07216878364870322f : 1.0f, scr, lane); continue; }
            r -= J_AIN;
            if (r < 2 * J_WOUT) { const int l = r / J_WOUT; r -= l * J_WOUT; const int nblk = D / 32, kb = r / nblk, nb = r % nblk;
                cvt_item(ap->in[I_WOUT] + (size_t)l * D * D, D, nb * 32, kb * 64, WSP(u16, WS_WOUT) + (size_t)l * D * D, D, nb * 32, 1.0f, scr, lane); continue; }
            r -= 2 * J_WOUT;
            if (r < J_WKVI) { const int nblk = KVW / 32, kb = r / nblk, nb = r % nblk;
                cvt_item(ap->in[I_WKV], KVW, nb * 32, kb * 64, WSP(u16, WS_WKV), D, nb * 32, 1.0f, scr, lane); continue; }
            r -= J_WKVI;
            if (r < J_BIN) { const int nblk = B_N / 32, kb = r / nblk, nb = r % nblk, n0 = nb * 32;
                cvt_item(ap->in[I_BWIN], B_INW, n0 < 1536 ? n0 : n0 + 36, kb * 64, WSP(u16, WS_WBIN), D, n0, 1.0f, scr, lane); continue; }
            r -= J_BIN;
            if (r < 2 * J_MKV) { const int l = r / J_MKV; r -= l * J_MKV; const int nblk = 1024 / 32, kb = r / nblk, nb = r % nblk;
                cvt_item(ap->in[I_MEMWKV] + (size_t)l * D * 1024, 1024, nb * 32, kb * 64, WSP(u16, WS_WMKV) + (size_t)l * 1024 * D, D, nb * 32, 1.0f, scr, lane); continue; }
            r -= 2 * J_MKV;
            if (r < 2 * J_C1) { const int c = r / J_C1; r -= c * J_C1; const int nblk = 256 / 32, kb = r / nblk, nb = r % nblk;
                cvt_item(ap->in[I_CW1] + (size_t)c * 4096 * 256, 256, nb * 32, kb * 64, WSP(u16, WS_WC1) + (size_t)c * 256 * 4096, 4096, nb * 32, 1.0f, scr, lane); continue; }
            r -= 2 * J_C1;
            { const int c = r / J_C2; r -= c * J_C2; const int nblk = 128 / 32, kb = r / nblk, nb = r % nblk;
                cvt_item(ap->in[I_CW2] + (size_t)c * 256 * 128, 128, nb * 32, kb * 64, WSP(u16, WS_WC2) + (size_t)c * 128 * 256, 256, nb * 32, 1.0f, scr, lane); }
        }
        for (int it = gw; it < 2 * MEM_LEN; it += NGW) { const int l = it >> 8, m = it & 255;
            const GAS f32x4* xr = (const GAS f32x4*)(ap->in[I_MEM] + (size_t)m * D) + lane; f32x4 v[8]; float ss = 0.f;
#pragma unroll
            for (int j = 0; j < 8; ++j) { v[j] = xr[64 * j]; ss += (v[j].x * v[j].x + v[j].y * v[j].y) + (v[j].z * v[j].z + v[j].w * v[j].w); }
            const float rr = rsqrtf(wave_sum(ss) * (1.0f / D) + EPS);
            GAS u32x2* o = (GAS u32x2*)(WSP(u16, WS_MEMN) + ((size_t)l * MEM_LEN + m) * D) + lane;
#pragma unroll
            for (int j = 0; j < 8; ++j) { const f32x4 g = ((const GAS f32x4*)(ap->in[I_MEMNORM] + (size_t)l * D))[lane + 64 * j]; const f32x4 w = v[j] * rr * g; u32x2 pk; pk.x = pkh(w.x, w.y); pk.y = pkh(w.z, w.w); o[64 * j] = pk; } }
        for (int e = blockIdx.x * 512 + tid; e < 44 * D; e += G * 512) { const int gi = e / D, k = e % D;
            if (gi < 8) WSP(float, WS_WGA)[gi * D + k] = ap->in[I_AWIN][(size_t)k * A_INW + 4608 + gi]; else WSP(float, WS_WGB)[(gi - 8) * D + k] = ap->in[I_BWIN][(size_t)k * B_INW + 1536 + (gi - 8)]; }
        for (int it = gw; it < 512; it += NGW) { const int c = it >> 8, j = it & 255; float a = 0.f;
            for (int k = lane; k < 4096; k += 64) a += ap->in[I_CPOS][c * 4096 + k] * ap->in[I_CW1][((size_t)c * 4096 + k) * 256 + j];
            a = wave_sum(a); if (lane == 0) WSP(float, WS_CB1)[it] = a; }
        for (int e = blockIdx.x * 512 + tid; e < S * 64; e += G * 512) { const int t = e >> 6, i = e & 63;
            const float inv = exp2f(-(float)(2 * i) * (13.287712379549449f / 128.0f)); const float ang = (float)t * inv;
            const double k = rint((double)ang * 0.15915494309189535); const float rr = (float)((double)ang - k * 6.283185307179586);
            WSP(float, WS_ROPE)[e] = __cosf(rr); WSP(float, WS_ROPE)[S * 64 + e] = __sinf(rr); }
        thin_rows<0>(nullptr, 0.f, nullptr, ap->in[I_X], nullptr, ap->in[I_NG], WSP(u16, WS_XN), nullptr, nullptr, nullptr, nullptr, nullptr, false, gw, NGW, lane);
    }
    PH_END

#pragma unroll
    for (int f = 0; f < 4; ++f) {
        const int layer = f >> 1;
        PH_BEGIN
        {
            pg8::Gemm g{WSP(u16, WS_XN), WSP(u16, WS_WGU) + (size_t)f * 2 * FF * D, S, 2 * FF, D, D, D}; pg8::StaticOrder So; So.init(S, 2 * FF, G, (int)blockIdx.x);
            pg8::EpiSwiGLU E{WSP(u16, WS_H), FF};
            pg8::gemm_phase<pg8::EpiSwiGLU, pg8::StaticOrder, true, true, false>(lds + RING_OFF, g, So, E, tid);
            if (f == 0) {
                const int l = (blockIdx.x >> 2) & 1;
                pg8::Gemm g2{WSP(u16, WS_MEMN) + (size_t)l * MEM_LEN * D, WSP(u16, WS_WMKV) + (size_t)l * 1024 * D, 256, 1024, D, D, D}; pg8::StaticOrder S2; S2.init(256, 1024, G, blockIdx.x < 8 ? (int)(blockIdx.x & 3) : 1 << 20);
                pg8::EpiF16<0> E2{WSP(u16, WS_MEMKV) + (size_t)l * MEM_LEN * 1024, 1024, nullptr};
                pg8::gemm_phase<pg8::EpiF16<0>, pg8::StaticOrder, true, true, false>(lds + RING_OFF, g2, S2, E2, tid);
            }
            if (f == 2) {
                const float* ROPE = WSP(float, WS_ROPE);
                for (int e = blockIdx.x * 512 + tid; e < S * 256; e += G * 512) { const int t = e >> 8, r = e & 255, cc = (r >> 7) ? 4 : 2, gg = (r >> 6) & 1, i = r & 63;
                    u16* p = WSP(u16, WS_KVRAW) + (size_t)t * KVW + cc * 256 + gg * 128 + i; const float x1 = (float)*(f16*)p, x2 = (float)*(f16*)(p + 64);
                    const float c = ROPE[t * 64 + i], s = ROPE[S * 64 + t * 64 + i];
                    *(f16*)p = (f16)(x1 * c - x2 * s); *(f16*)(p + 64) = (f16)(x2 * c + x1 * s); }
                const int idx = (blockIdx.x >> 2) & 3, c = idx >> 1, gg = idx & 1;
                pg8::Gemm g3{WSP(u16, WS_KVRAW) + c * 256 + gg * 128, WSP(u16, WS_WC1) + (size_t)c * 256 * 4096, 1024, 256, 4096, 16 * KVW, 4096}; pg8::StaticOrder S3; S3.init(1024, 256, G, blockIdx.x < 16 ? (int)(blockIdx.x & 3) : 1 << 20);
                pg8::EpiF16<1> E3{WSP(u16, WS_CMPH) + (size_t)idx * 1024 * 256, 256, WSP(float, WS_CB1) + c * 256};
                pg8::gemm_phase<pg8::EpiF16<1>, pg8::StaticOrder, true, true, true>(lds + RING_OFF, g3, S3, E3, tid);
            }
        }
        PH_END
        PH_BEGIN
        {
            pg8::Gemm g{WSP(u16, WS_H), WSP(u16, WS_WD) + (size_t)f * D * FF, S, D, FF, FF, FF}; pg8::StaticOrder So; So.init(S, D, G, (int)blockIdx.x);
            pg8::EpiF32 E{WSP(float, WS_Y), D};
            pg8::gemm_phase<pg8::EpiF32, pg8::StaticOrder, true, true, false>(lds + RING_OFF, g, So, E, tid);
            if (f == 2) {
                for (int e = blockIdx.x * 512 + tid; e < 4 * 1024 * 128; e += G * 512) { const int idx = e >> 17, n = (e >> 7) & 1023, d = e & 127, c = idx >> 1;
                    const h8* hr = (const h8*)(WSP(u16, WS_CMPH) + ((size_t)idx * 1024 + n) * 256); const h8* wr = (const h8*)(WSP(u16, WS_WC2) + ((size_t)c * 128 + d) * 256); float a = 0.f;
                    for (int k = 0; k < 32; ++k) { const h8 hv = hr[k], wv = wr[k];
#pragma unroll
                        for (int j = 0; j < 8; ++j) a += (float)hv[j] * (float)wv[j]; }
                    *(f16*)(WSP(u16, WS_KVC) + (size_t)e) = (f16)a; }
            }
        }
        PH_END
        PH_BEGIN
        {
            const float* gl = ap->in[I_NG] + (size_t)layer * 6 * D;
            const float* gpost = gl + (size_t)((f & 1) ? 5 : 1) * D;
            float* X = ap->out; const float* Y = WSP(float, WS_Y);
            if (f == 0)      thin_rows<8>(Y, 0.5f, gpost, ap->in[I_X], X, gl + 2 * D, WSP(u16, WS_XN), nullptr, nullptr, WSP(float, WS_WGA), ap->in[I_AGB], WSP(float, WS_GA), false, gw, NGW, lane);
            else if (f == 1) thin_rows<0>(Y, 0.5f, gpost, X, X, ap->in[I_NG] + (size_t)6 * D, WSP(u16, WS_XN), ap->in[I_KVN], WSP(u16, WS_XKV), nullptr, nullptr, nullptr, false, gw, NGW, lane);
            else if (f == 2) thin_rows<36>(Y, 0.5f, gpost, X, X, gl + 2 * D, WSP(u16, WS_XN), nullptr, nullptr, WSP(float, WS_WGB), ap->in[I_BGB], WSP(float, WS_GB), true, gw, NGW, lane);
            else             thin_rows<0>(Y, 0.5f, gpost, X, X, nullptr, nullptr, nullptr, nullptr, nullptr, nullptr, nullptr, false, gw, NGW, lane);
        }
        PH_END

        if (f == 1) {
            PH_BEGIN
            {
                pg8::Gemm g{WSP(u16, WS_XKV), WSP(u16, WS_WKV), S, KVW, D, D, D}; pg8::StaticOrder So; So.init(S, KVW, G, (int)blockIdx.x);
                pg8::EpiF16<0> E{WSP(u16, WS_KVRAW), KVW, nullptr};
                pg8::gemm_phase<pg8::EpiF16<0>, pg8::StaticOrder, true, true, false>(lds + RING_OFF, g, So, E, tid);
            }
            PH_END
        }
        if (f == 0 || f == 2) {
            const bool isA = (f == 0);
            PH_BEGIN
            {
                const int ldq = isA ? A_N : B_N;
                pg8::Gemm g{WSP(u16, WS_XN), isA ? WSP(u16, WS_WAIN) : WSP(u16, WS_WBIN), S, ldq, D, D, D}; pg8::StaticOrder So; So.init(S, ldq, G, (int)blockIdx.x);
                pg8::EpiF16<0> E{isA ? WSP(u16, WS_AOUT) : WSP(u16, WS_BOUT), ldq, nullptr};
                pg8::gemm_phase<pg8::EpiF16<0>, pg8::StaticOrder, true, true, false>(lds + RING_OFF, g, So, E, tid);
            }
            PH_END
            if (isA) {
                PH_BEGIN
                {
                    const u16* AOUT = WSP(u16, WS_AOUT); const float* GA = WSP(float, WS_GA); u16* CT = WSP(u16, WS_CT);
                    mem_attn_scalar(AOUT, A_N, 4608, WSP(u16, WS_MEMKV), WSP(u16, WS_XN), gw, NGW, lane);
                    LAS f16* ks = (LAS f16*)(lds);
                    LAS f16* vs = (LAS f16*)(lds + 24576);
                    LAS float* fv = (LAS float*)(lds + 24576 + 49152);
                    for (int u = blockIdx.x; u < ML_H * ML_NC; u += G) {
                        const int h = u >> 8, c = u & 255, t0 = c * ML_L;
                        __syncthreads();
                        if (tid < 64) { const int t = t0 + tid; fv[tid] = log_sigmoidf_(GA[(size_t)t * 8 + 4 + h]); fv[64 + tid] = GA[(size_t)t * 8 + h]; }
                        for (int e = tid; e < 64 * 24; e += 512) { const int s = e / 24, cc = e % 24; *(LAS h8*)(ks + s * 192 + cc * 8) = *(const h8*)(AOUT + (size_t)(t0 + s) * A_N + 768 + h * 192 + cc * 8); }
                        for (int e = tid; e < 64 * 48; e += 512) { const int s = e / 48, cc = e % 48; *(LAS h8*)(vs + s * 384 + cc * 8) = *(const h8*)(AOUT + (size_t)(t0 + s) * A_N + 1536 + h * 384 + cc * 8); }
                        __syncthreads();
                        if (tid == 0) { float b = 0.f; for (int s = 0; s < 64; ++s) { b += fv[s]; fv[s] = b; }
                            const float b63 = b; float ml = -3.0e38f; for (int s = 0; s < 64; ++s) ml = fmaxf(ml, b63 - fv[s] + fv[64 + s]);
                            fv[192] = b63; fv[193] = ml; WSP(float, WS_B63)[u] = b63; WSP(float, WS_MLOC)[u] = ml; }
                        __syncthreads();
                        if (tid < 64) fv[128 + tid] = __expf(fv[192] - fv[tid] + fv[64 + tid] - fv[193]);
                        __syncthreads();
                        for (int o = tid; o < ML_DV * ML_DQK; o += 512) { const int v = o / ML_DQK, d = o % ML_DQK; float a = 0.f;
                            for (int s = 0; s < 64; ++s) a += fv[128 + s] * (float)ks[s * 192 + d] * (float)vs[s * 384 + v];
                            *(f16*)(CT + (size_t)u * ML_DV * ML_DQK + o) = (f16)a; }
                        if (tid < ML_DQK) { float a = 0.f; for (int s = 0; s < 64; ++s) a += fv[128 + s] * (float)ks[s * 192 + tid]; WSP(float, WS_DN)[(size_t)u * ML_DQK + tid] = a; }
                    }
                }
                PH_END
                PH_BEGIN
                {
                    const float* B63 = WSP(float, WS_B63); const float* MLOC = WSP(float, WS_MLOC);
                    LAS float* dec = (LAS float*)(lds); LAS float* scl = dec + 256;
                    constexpr int PER_HEAD = ML_DV * ML_DQK / 2;
                    for (int e0 = blockIdx.x * 512; e0 < ML_H * PER_HEAD; e0 += G * 512) {
                        const int h = e0 / PER_HEAD;
                        __syncthreads();
                        if (tid == 0) { float m = 0.f; for (int c = 0; c < ML_NC; ++c) { const float b63 = B63[h * 256 + c], ml = MLOC[h * 256 + c]; const float mn = fmaxf(ml, b63 + m);
                                dec[c] = __expf(b63 + m - mn); scl[c] = __expf(ml - mn); if (e0 % PER_HEAD == 0) WSP(float, WS_MST)[h * 256 + c] = m; m = mn; } }
                        __syncthreads();
                        unsigned* p = WSP(unsigned, WS_CT) + (size_t)h * ML_NC * PER_HEAD + (e0 - h * PER_HEAD) + tid;
                        float c0 = 0.f, c1 = 0.f;
                        for (int c = 0; c < ML_NC; c += 8) { unsigned dv[8];
#pragma unroll
                            for (int j = 0; j < 8; ++j) dv[j] = p[(size_t)(c + j) * PER_HEAD];
#pragma unroll
                            for (int j = 0; j < 8; ++j) { const h2 d2 = __builtin_bit_cast(h2, dv[j]); p[(size_t)(c + j) * PER_HEAD] = pkh(c0, c1);
                                c0 = dec[c + j] * c0 + scl[c + j] * (float)d2[0]; c1 = dec[c + j] * c1 + scl[c + j] * (float)d2[1]; } }
                    }
                    if (blockIdx.x < ML_H) { const int h = blockIdx.x;
                        __syncthreads();
                        if (tid == 0) { float m = 0.f; for (int c = 0; c < ML_NC; ++c) { const float b63 = B63[h * 256 + c], ml = MLOC[h * 256 + c]; const float mn = fmaxf(ml, b63 + m);
                                dec[c] = __expf(b63 + m - mn); scl[c] = __expf(ml - mn); m = mn; } }
                        __syncthreads();
                        if (tid < ML_DQK) { float n = 0.f; for (int c = 0; c < ML_NC; ++c) { float* q = WSP(float, WS_DN) + ((size_t)h * 256 + c) * ML_DQK + tid; const float d = *q; *q = n; n = dec[c] * n + scl[c] * d; } }
                    }
                }
                PH_END
                PH_BEGIN
                {
                    const u16* AOUT = WSP(u16, WS_AOUT); const float* GA = WSP(float, WS_GA); u16* XN = WSP(u16, WS_XN);
                    LAS f16* qs = (LAS f16*)(lds);
                    LAS f16* ks = (LAS f16*)(lds + 24576);
                    LAS f16* vs = (LAS f16*)(lds + 24576 + 25600);
                    LAS float* Sm = (LAS float*)(lds + 24576 + 25600 + 49152);
                    LAS float* fv = Sm + 4096;
                    for (int u = blockIdx.x; u < ML_H * ML_NC; u += G) {
                        const int h = u >> 8, c = u & 255, t0 = c * ML_L;
                        __syncthreads();
                        if (tid < 64) { const int t = t0 + tid; fv[tid] = log_sigmoidf_(GA[(size_t)t * 8 + 4 + h]); fv[64 + tid] = GA[(size_t)t * 8 + h]; fv[320 + tid] = 0.f; }
                        for (int e = tid; e < 64 * 24; e += 512) { const int s = e / 24, cc = e % 24;
                            *(LAS h8*)(qs + s * 192 + cc * 8) = *(const h8*)(AOUT + (size_t)(t0 + s) * A_N + h * 192 + cc * 8);
                            *(LAS h8*)(ks + s * 200 + cc * 8) = *(const h8*)(AOUT + (size_t)(t0 + s) * A_N + 768 + h * 192 + cc * 8); }
                        for (int e = tid; e < 64 * 48; e += 512) { const int s = e / 48, cc = e % 48; *(LAS h8*)(vs + s * 384 + cc * 8) = *(const h8*)(AOUT + (size_t)(t0 + s) * A_N + 1536 + h * 384 + cc * 8); }
                        __syncthreads();
                        const float mc = WSP(float, WS_MST)[u];
                        if (tid == 0) { float b = 0.f, pm = -3.0e38f; for (int s = 0; s < 64; ++s) { b += fv[s]; fv[s] = b; const float a = fv[64 + s] - b; fv[64 + s] = a; pm = fmaxf(pm, a);
                                const float mx = fmaxf(pm, mc); fv[128 + s] = mx; fv[192 + s] = __expf(mc - mx); } }
                        __syncthreads();
                        for (int o = tid; o < 4096; o += 512) { const int t = o >> 6, s = o & 63; float a = 0.f;
                            if (s <= t) { for (int k = 0; k < 24; ++k) { const h8 qv = *(const LAS h8*)(qs + t * 192 + k * 8), kv = *(const LAS h8*)(ks + s * 200 + k * 8);
#pragma unroll
                                    for (int j = 0; j < 8; ++j) a += (float)qv[j] * (float)kv[j]; }
                                a *= __expf(fv[64 + s] - fv[128 + t]); }
                            Sm[o] = a; }
                        __syncthreads();
                        if (tid < 64) { const int t = tid; float den = 0.f; for (int s = 0; s < 64; ++s) den += Sm[t * 64 + s];
                            float qn = 0.f; const float* np = WSP(float, WS_DN) + (size_t)u * ML_DQK; for (int d = 0; d < ML_DQK; ++d) qn += (float)qs[t * 192 + d] * np[d];
                            den += fv[192 + t] * qn; const float mvec = fv[t] + fv[128 + t];
                            fv[256 + t] = fmaxf(fabsf(den), __expf(-mvec)); }
                        __syncthreads();
                        const u16* ctp = WSP(u16, WS_CT) + (size_t)u * ML_DV * ML_DQK;
                        for (int o = tid; o < 64 * ML_DV; o += 512) { const int t = o / ML_DV, v = o % ML_DV; float a1 = 0.f, a2 = 0.f;
                            for (int s = 0; s <= t; ++s) a1 += Sm[t * 64 + s] * (float)vs[s * 384 + v];
                            const h8* cr = (const h8*)(ctp + (size_t)v * ML_DQK);
                            for (int k = 0; k < 24; ++k) { const h8 cv = cr[k], qv = *(const LAS h8*)(qs + t * 192 + k * 8);
#pragma unroll
                                for (int j = 0; j < 8; ++j) a2 += (float)qv[j] * (float)cv[j]; }
                            const float hv = (a1 + fv[192 + t] * a2) / fv[256 + t];
                            const float sq = wave_sum(hv * hv); if (lane == 0) atomicAdd((float*)(fv + 320 + t), sq);
                            *(f16*)(XN + (size_t)(t0 + t) * D + h * ML_DV + v) = (f16)hv; }
                        __syncthreads();
                        for (int o = tid; o < 64 * ML_DV; o += 512) { const int t = o / ML_DV, v = o % ML_DV;
                            f16* hp = (f16*)(XN + (size_t)(t0 + t) * D + h * ML_DV + v);
                            const float og = (float)*(const f16*)(AOUT + (size_t)(t0 + t) * A_N + 3072 + h * ML_DV + v);
                            *hp = (f16)((float)*hp * rsqrtf(fv[320 + t] * (1.0f / ML_DV) + EPS) * ap->in[I_AHN][h * ML_DV + v] * sigmoidf_(og)); }
                    }
                }
                PH_END
            } else {
                PH_BEGIN
                {
                    const u16* BOUT = WSP(u16, WS_BOUT); const u16* KVRAW = WSP(u16, WS_KVRAW); const float* GB = WSP(float, WS_GB); const float* ROPE = WSP(float, WS_ROPE); u16* XN = WSP(u16, WS_XN);
                    mem_attn_scalar(BOUT, B_N, 1536, WSP(u16, WS_MEMKV) + (size_t)MEM_LEN * 1024, XN, gw, NGW, lane);
                    LAS float* wl = (LAS float*)(lds + wave * 16384);
                    LAS float* qs = wl; LAS float* qr = wl + 128; LAS float* pb = wl + 256; LAS float* psl = wl + 1280; LAS float* ob = wl + 1536; LAS int* sel = (LAS int*)(wl + 2304);
                    const float scale = 0.08838834764831845f;
                    const u16* KC = WSP(u16, WS_KVC); const u16* VC = KC + (size_t)2 * 1024 * 128;
                    for (int item = gw; item < S * 2; item += NGW) {
                        const int t = item >> 1, g = item & 1, cur = t >> 6;
                        const int nv = (t >= 31) ? ((t - 31) >> 4) + 1 : 0;
                        const float c0 = ROPE[t * 64 + lane], s0 = ROPE[S * 64 + t * 64 + lane];
                        for (int i = 0; i < 4; ++i) psl[lane + 64 * i] = 0.f;
                        for (int j = 0; j < 6; ++j) {
                            const int hh = g * 6 + j; const u16* qp = BOUT + (size_t)t * B_N + hh * 128;
                            LDS_WAIT();
                            qs[lane] = (float)*(const f16*)(qp + lane); qs[lane + 64] = (float)*(const f16*)(qp + 64 + lane);
                            LDS_WAIT();
                            float mx = -3.0e38f;
                            for (int k0 = 0; k0 < nv; k0 += 64) { const int key = k0 + lane; float a = -3.0e38f;
                                if (key < nv) { const h8* kr = (const h8*)(KC + ((size_t)g * 1024 + key) * 128); a = 0.f;
                                    for (int cc = 0; cc < 16; ++cc) { const h8 kv = kr[cc]; const f32x4 q0 = *(const LAS f32x4*)(qs + cc * 8), q1 = *(const LAS f32x4*)(qs + cc * 8 + 4);
                                        a += (float)kv[0] * q0.x + (float)kv[1] * q0.y + (float)kv[2] * q0.z + (float)kv[3] * q0.w + (float)kv[4] * q1.x + (float)kv[5] * q1.y + (float)kv[6] * q1.z + (float)kv[7] * q1.w; }
                                    a *= scale; }
                                pb[key] = a; mx = fmaxf(mx, a); }
                            mx = wave_max(mx); float ls = 0.f;
                            LDS_WAIT();
                            for (int k0 = 0; k0 < nv; k0 += 64) { const int key = k0 + lane; if (key < nv) { const float p = __expf(pb[key] - mx); pb[key] = p; ls += p; } }
                            ls = wave_sum(ls); const float il = nv > 0 ? 1.0f / ls : 0.f;
                            LDS_WAIT();
                            float o0 = 0.f, o1 = 0.f;
                            for (int key = 0; key < nv; ++key) { const float p = pb[key]; const u16* vr = VC + ((size_t)g * 1024 + key) * 128; o0 += p * (float)*(const f16*)(vr + lane); o1 += p * (float)*(const f16*)(vr + 64 + lane); }
                            const float gc = GB[(size_t)t * 36 + hh * 3 + 0];
                            ob[j * 128 + lane] = gc * o0 * il; ob[j * 128 + 64 + lane] = gc * o1 * il;
                            for (int i = 0; i < 4; ++i) { const int jb = lane + 64 * i; float a = 0.f;
#pragma unroll
                                for (int e = -1; e < 4; ++e) { const int key = 4 * jb + e; if (key >= 0 && key < nv) a += ((e >= 0 && e < 3) ? 2.f : 1.f) * pb[key]; }
                                psl[jb] += a * il; }
                        }
                        LDS_WAIT();
                        int nsel;
                        if (cur <= 15) { nsel = cur + 1; if (lane < 16) sel[lane] = lane; }
                        else { nsel = 16; float val[4];
#pragma unroll
                            for (int i = 0; i < 4; ++i) { const int jb = lane + 64 * i; val[i] = (jb >= 1 && jb <= cur - 2) ? psl[jb] : -1.f; }
                            if (lane == 0) { sel[0] = 0; sel[1] = cur - 1; sel[2] = cur; }
                            for (int r = 0; r < 13; ++r) { float bv = val[0]; int bi = lane;
#pragma unroll
                                for (int i = 1; i < 4; ++i) if (val[i] > bv) { bv = val[i]; bi = lane + 64 * i; }
#pragma unroll
                                for (int off = 1; off < 64; off <<= 1) { const float ov = __shfl_xor(bv, off); const int oi = __shfl_xor(bi, off); if (ov > bv || (ov == bv && oi < bi)) { bv = ov; bi = oi; } }
                                if (lane == 0) sel[3 + r] = bi;
#pragma unroll
                                for (int i = 0; i < 4; ++i) if (bi == lane + 64 * i) val[i] = -2.f; } }
                        LDS_WAIT();
                        for (int j = 0; j < 6; ++j) {
                            const int hh = g * 6 + j; const u16* qp = BOUT + (size_t)t * B_N + hh * 128;
                            LDS_WAIT();
                            { const float q1 = (float)*(const f16*)(qp + lane), q2 = (float)*(const f16*)(qp + 64 + lane); qr[lane] = q1 * c0 - q2 * s0; qr[lane + 64] = q2 * c0 + q1 * s0; }
                            LDS_WAIT();
                            float mx = -3.0e38f;
                            for (int b = 0; b < nsel; ++b) { const int kpos = sel[b] * 64 + lane; float a = -3.0e38f;
                                if (kpos <= t) { const h8* kr = (const h8*)(KVRAW + (size_t)kpos * KVW + 2 * 256 + g * 128); a = 0.f;
                                    for (int cc = 0; cc < 16; ++cc) { const h8 kv = kr[cc]; const f32x4 q0 = *(const LAS f32x4*)(qr + cc * 8), q1 = *(const LAS f32x4*)(qr + cc * 8 + 4);
                                        a += (float)kv[0] * q0.x + (float)kv[1] * q0.y + (float)kv[2] * q0.z + (float)kv[3] * q0.w + (float)kv[4] * q1.x + (float)kv[5] * q1.y + (float)kv[6] * q1.z + (float)kv[7] * q1.w; }
                                    a *= scale; }
                                pb[b * 64 + lane] = a; mx = fmaxf(mx, a); }
                            mx = wave_max(mx); float ls = 0.f;
                            LDS_WAIT();
                            for (int b = 0; b < nsel; ++b) { const float a = pb[b * 64 + lane]; const float p = (a > -1.0e38f) ? __expf(a - mx) : 0.f; pb[b * 64 + lane] = p; ls += p; }
                            ls = wave_sum(ls);
                            LDS_WAIT();
                            float o0 = 0.f, o1 = 0.f;
                            for (int b = 0; b < nsel; ++b) { const int kb = sel[b] * 64; const int kn = (t - kb + 1) < 64 ? (t - kb + 1) : 64;
                                for (int kk = 0; kk < kn; ++kk) { const float p = pb[b * 64 + kk]; const u16* vr = KVRAW + (size_t)(kb + kk) * KVW + 3 * 256 + g * 128; o0 += p * (float)*(const f16*)(vr + lane); o1 += p * (float)*(const f16*)(vr + 64 + lane); } }
                            const float gs = GB[(size_t)t * 36 + hh * 3 + 1] / ls;
                            float r0 = ob[j * 128 + lane] + gs * o0, r1 = ob[j * 128 + 64 + lane] + gs * o1;
                            LDS_WAIT();
                            mx = -3.0e38f;
                            for (int b = 0; b < 8; ++b) { const int kpos = t - 511 + b * 64 + lane; float a = -3.0e38f;
                                if (kpos >= 0) { const h8* kr = (const h8*)(KVRAW + (size_t)kpos * KVW + 4 * 256 + g * 128); a = 0.f;
                                    for (int cc = 0; cc < 16; ++cc) { const h8 kv = kr[cc]; const f32x4 q0 = *(const LAS f32x4*)(qr + cc * 8), q1 = *(const LAS f32x4*)(qr + cc * 8 + 4);
                                        a += (float)kv[0] * q0.x + (float)kv[1] * q0.y + (float)kv[2] * q0.z + (float)kv[3] * q0.w + (float)kv[4] * q1.x + (float)kv[5] * q1.y + (float)kv[6] * q1.z + (float)kv[7] * q1.w; }
                                    a *= scale; }
                                pb[b * 64 + lane] = a; mx = fmaxf(mx, a); }
                            mx = wave_max(mx); ls = 0.f;
                            LDS_WAIT();
                            for (int b = 0; b < 8; ++b) { const float a = pb[b * 64 + lane]; const float p = (a > -1.0e38f) ? __expf(a - mx) : 0.f; pb[b * 64 + lane] = p; ls += p; }
                            ls = wave_sum(ls);
                            LDS_WAIT();
                            o0 = 0.f; o1 = 0.f;
                            { const int k_lo = (t - 511) < 0 ? 0 : (t - 511);
                              for (int kpos = k_lo; kpos <= t; ++kpos) { const float p = pb[kpos - (t - 511)]; const u16* vr = KVRAW + (size_t)kpos * KVW + 5 * 256 + g * 128; o0 += p * (float)*(const f16*)(vr + lane); o1 += p * (float)*(const f16*)(vr + 64 + lane); } }
                            const float gwn = GB[(size_t)t * 36 + hh * 3 + 2] / ls;
                            r0 += gwn * o0; r1 += gwn * o1;
                            *(f16*)(XN + (size_t)t * D + hh * 128 + lane) = (f16)r0; *(f16*)(XN + (size_t)t * D + hh * 128 + 64 + lane) = (f16)r1;
                        }
                    }
                }
                PH_END
            }
            PH_BEGIN
            {
                pg8::Gemm g{WSP(u16, WS_XN), WSP(u16, WS_WOUT) + (size_t)layer * D * D, S, D, D, D, D}; pg8::StaticOrder So; So.init(S, D, G, (int)blockIdx.x);
                pg8::EpiF32 E{WSP(float, WS_Y), D};
                pg8::gemm_phase<pg8::EpiF32, pg8::StaticOrder, true, true, false>(lds + RING_OFF, g, So, E, tid);
            }
            PH_END
            PH_BEGIN
            {
                const float* gl = ap->in[I_NG] + (size_t)layer * 6 * D; float* X = ap->out;
                thin_rows<0>(WSP(float, WS_Y), 1.0f, gl + 3 * D, X, X, gl + 4 * D, WSP(u16, WS_XN), nullptr, nullptr, nullptr, nullptr, nullptr, false, gw, NGW, lane);
            }
            PH_END
        }
    }
#undef PH_BEGIN
#undef PH_END
}

constexpr int N_PHASES = 1 + 4 * 3 + 1 + 2 * 3 + 3 + 1;

extern "C" void kernel_launch(void* const* d_in, const int* in_sizes, int n_in, void* d_out, int out_size, void* d_ws, size_t ws_size, hipStream_t stream) {
    static int grid = 0;
    if (grid == 0) {
        if (n_in != 19 || in_sizes[0] != S * D || out_size != S * D || ws_size < WS_END) { fprintf(stderr, "kernel_launch: unexpected shapes: n_in %d in0 %d out %d ws %zu (need %zu)\n", n_in, n_in > 0 ? in_sizes[0] : -1, out_size, ws_size, (size_t)WS_END); grid = -1; return; }
        int dev = 0, cus = 0, per_cu = 0;
        if (hipGetDevice(&dev) != hipSuccess || hipDeviceGetAttribute(&cus, hipDeviceAttributeMultiprocessorCount, dev) != hipSuccess) { grid = -1; return; }
        if (hipFuncSetAttribute((const void*)yoco_fwd, hipFuncAttributeMaxDynamicSharedMemorySize, LDS_BYTES) != hipSuccess) { fprintf(stderr, "kernel_launch: hipFuncSetAttribute failed\n"); grid = -1; return; }
        if (hipOccupancyMaxActiveBlocksPerMultiprocessor(&per_cu, (const void*)yoco_fwd, NWAVES * 64, LDS_BYTES) != hipSuccess || per_cu < 1) { fprintf(stderr, "kernel_launch: occupancy query reports %d\n", per_cu); (void)hipGetLastError(); grid = -1; return; }
        grid = cus;
    }
    if (grid < 0) return;
    (void)hipMemsetAsync((char*)d_ws + WS_CTL, 0, CTL_ZERO_BYTES, stream);
    Args a{};
    for (int i = 0; i < 19; ++i) a.in[i] = (const float*)d_in[i];
    a.out = (float*)d_out; a.ws = (unsigned char*)d_ws;
#if MK_PER_PHASE
    for (int p = 0; p < N_PHASES; ++p) { a.ph_lo = p; a.ph_hi = p + 1; a.li = p; hipLaunchKernelGGL(yoco_fwd, dim3(grid), dim3(NWAVES * 64), LDS_BYTES, stream, a); }
#else
    a.ph_lo = 0; a.ph_hi = N_PHASES; a.li = 0;
    hipLaunchKernelGGL(yoco_fwd, dim3(grid), dim3(NWAVES * 64), LDS_BYTES, stream, a);
#endif
}
```

```cpp
#include <hip/hip_runtime.h>
#include <cstdio>
#include <cstdint>

#ifndef MK_PER_PHASE
#define MK_PER_PHASE 0
#endif

#define LAS __attribute__((address_space(3)))
#define GAS __attribute__((address_space(1)))
typedef unsigned short u16;
typedef _Float16 f16;
typedef _Float16 h8 __attribute__((ext_vector_type(8)));
typedef _Float16 h4 __attribute__((ext_vector_type(4)));
typedef _Float16 h2 __attribute__((ext_vector_type(2)));
typedef float f32x4 __attribute__((ext_vector_type(4)));
typedef float f32x2 __attribute__((ext_vector_type(2)));
typedef unsigned u32x4 __attribute__((ext_vector_type(4)));
typedef unsigned u32x2 __attribute__((ext_vector_type(2)));

__device__ __forceinline__ unsigned pkh(float a, float b) { h2 v = __builtin_convertvector((f32x2){a, b}, h2); return __builtin_bit_cast(unsigned, v); }

namespace pg8 {
#define PG8_LAS __attribute__((address_space(3)))
constexpr int BM = 256, BK = 64, HALF = 128, HTB = HALF * BK * 2, STAGE_BYTES = 8 * HTB, NXCD = 8, WGM = 8;
__host__ __device__ __forceinline__ int lds_byte(int r, int c) { const int st = (r >> 4) * 2 + (c >> 5), rr = r & 15, cc = c & 31, ob = rr * 64 + cc * 2; return st * 1024 + (ob ^ (((ob >> 9) & 1) << 5)); }
__host__ __device__ __forceinline__ void stage_rc(int b, int& R, int& C) { const int st = b / 1024, sb = b % 1024, swz = sb ^ (((sb >> 9) & 1) << 5); R = (st >> 1) * 16 + swz / 64; C = (st & 1) * 32 + (swz % 64) / 2; }
__host__ __device__ __forceinline__ int perm32(int rho) { const int n = rho >> 4, i = rho & 15; return 8 * (i >> 2) + 4 * n + (i & 3); }

struct Unit { int pm, pn; };
struct Gemm { const u16* A; const u16* Bt; int M, N, K, lda, ldb; };

struct StaticOrder {
    int nM, nN, nwg, G, c;
    __host__ __device__ void init(int M, int N, int G_, int c_) { nM = M / BM; nN = N / BM; nwg = nM * nN; G = G_; c = c_; }
    __host__ __device__ bool next(int i, Unit& u) const {
        const long L = (long)i * G + c; if (L >= nwg) return false;
        int wgid = (int)L; { const int q = nwg / NXCD, r = nwg % NXCD, xcd = wgid % NXCD, off = wgid / NXCD; wgid = (xcd < r ? xcd * (q + 1) : r * (q + 1) + (xcd - r) * q) + off; }
        const int nig = WGM * nN, gid = wgid / nig, fm = gid * WGM, gsz = (nM - fm) < WGM ? (nM - fm) : WGM;
        u.pm = fm + ((wgid % nig) % gsz); u.pn = (wgid % nig) / gsz; return true;
    }
    __device__ __forceinline__ void a_ready(const Unit&) const {}
    __device__ __forceinline__ void done(const Unit&) const {}
};

struct EpiF32 {
    static constexpr bool PERM = false, AFTER_DRAIN = false;
    float* C; int ldc;
    __device__ __forceinline__ void operator()(const f32x4 (&acc)[2][2][4][2], const Unit& u, int wr, int wc, int fr, int fq) const {
        const int row0 = u.pm * BM + wr * 64 + fr, col0 = u.pn * BM + wc * 32 + 4 * fq;
#pragma unroll
        for (int ai = 0; ai < 2; ++ai)
#pragma unroll
            for (int m = 0; m < 4; ++m) { float* rowp = C + (size_t)(row0 + ai * HALF + m * 16) * ldc + col0;
#pragma unroll
                for (int bj = 0; bj < 2; ++bj)
#pragma unroll
                    for (int n = 0; n < 2; ++n) *(f32x4*)(rowp + bj * HALF + n * 16) = acc[ai][bj][m][n]; }
    }
};
__device__ __forceinline__ float gelu_tanh(float x) { const float z = 1.5957691216057308f * (x + 0.044715f * x * x * x); return x * __builtin_amdgcn_rcpf(1.0f + __builtin_amdgcn_exp2f(-1.4426950408889634f * z)); }
template <int ACT> struct EpiF16 {
    static constexpr bool PERM = true, AFTER_DRAIN = false;
    u16* O; int ldc; const float* bias;
    __device__ __forceinline__ void operator()(const f32x4 (&acc)[2][2][4][2], const Unit& u, int wr, int wc, int fr, int fq) const {
        const int row0 = u.pm * BM + wr * 64 + fr, col0 = u.pn * BM + wc * 32 + 8 * fq;
#pragma unroll
        for (int ai = 0; ai < 2; ++ai)
#pragma unroll
            for (int m = 0; m < 4; ++m) { u16* rowp = O + (size_t)(row0 + ai * HALF + m * 16) * ldc + col0;
#pragma unroll
                for (int bj = 0; bj < 2; ++bj) { f32x4 v0 = acc[ai][bj][m][0], v1 = acc[ai][bj][m][1];
                    if (ACT == 1) { const f32x4 b0 = *(const f32x4*)(bias + col0 + bj * HALF), b1 = *(const f32x4*)(bias + col0 + bj * HALF + 4); v0 = v0 + b0; v1 = v1 + b1;
#pragma unroll
                        for (int j = 0; j < 4; ++j) { v0[j] = gelu_tanh(v0[j]); v1[j] = gelu_tanh(v1[j]); } }
                    u32x4 w; w.x = pkh(v0[0], v0[1]); w.y = pkh(v0[2], v0[3]); w.z = pkh(v1[0], v1[1]); w.w = pkh(v1[2], v1[3]);
                    *(u32x4*)(rowp + bj * HALF) = w; } }
    }
};
struct EpiSwiGLU {
    static constexpr bool PERM = true, AFTER_DRAIN = false;
    u16* H; int ldh;
    __device__ __forceinline__ void operator()(const f32x4 (&acc)[2][2][4][2], const Unit& u, int wr, int wc, int fr, int fq) const {
        const int row0 = u.pm * BM + wr * 64 + fr, col0 = u.pn * HALF + wc * 32 + 8 * fq;
#pragma unroll
        for (int ai = 0; ai < 2; ++ai)
#pragma unroll
            for (int m = 0; m < 4; ++m) { u16* rowp = H + (size_t)(row0 + ai * HALF + m * 16) * ldh + col0; float o[8];
#pragma unroll
                for (int n = 0; n < 2; ++n)
#pragma unroll
                    for (int j = 0; j < 4; ++j) { const float g = acc[ai][0][m][n][j], up = acc[ai][1][m][n][j];
                        o[n * 4 + j] = g * __builtin_amdgcn_rcpf(1.0f + __builtin_amdgcn_exp2f(-1.4426950408889634f * g)) * up; }
                u32x4 w; w.x = pkh(o[0], o[1]); w.y = pkh(o[2], o[3]); w.z = pkh(o[4], o[5]); w.w = pkh(o[6], o[7]);
                *(u32x4*)rowp = w; }
    }
};

template <class Epi, class Sched, bool ALIGN_EPI, bool SP2, bool AMODE>
__device__ __forceinline__ void gemm_phase(PG8_LAS unsigned char* lds, const Gemm g, const Sched& S, const Epi& E, const int tid) {
    const int wid = __builtin_amdgcn_readfirstlane(tid >> 6), lane = tid & 63, wr = wid >> 2, wc = wid & 3, fr = lane & 15, fq = lane >> 4;
    const int K = g.K, nt = K / BK;
    unsigned voffA[2], voffB[2];
#pragma unroll
    for (int i = 0; i < 2; ++i) { int R, C; stage_rc(tid * 16 + i * 8192, R, C); const int Rb = Epi::PERM ? ((R & ~31) + perm32(R & 31)) : R;
        voffA[i] = (unsigned)(R * g.lda + C) * 2u; voffB[i] = (unsigned)(Rb * g.ldb + C) * 2u; }
    const size_t kstep = (size_t)(BK * 2);
    const size_t hstepA = (size_t)HALF * g.lda * 2, hstepB = (size_t)HALF * g.ldb * 2;
    const size_t tstepA = 2 * hstepA, tstepB = 2 * hstepB;
    const unsigned ldsw = (unsigned)wid * 1024u;
    const int aoff = lds_byte(wr * 64 + fr, fq * 8), boff = lds_byte(wc * 32 + fr, fq * 8);
#define PG8_KOA(t) (AMODE ? ((size_t)((t) >> 1) * 3072u + (size_t)((t) & 1) * 128u) : (size_t)(t) * kstep)
#define PG8_SA(b, h) (((b) * 2 + (h)) * HTB)
#define PG8_SB(b, h) ((4 + (b) * 2 + (h)) * HTB)
#define PG8_STAGE(bufoff, gbase, voff) do { _Pragma("unroll") for (int _i = 0; _i < 2; ++_i) \
        __builtin_amdgcn_global_load_lds((const unsigned*)((const char*)(gbase) + (voff)[_i]), (PG8_LAS unsigned*)(lds + (bufoff) + ldsw + _i * 8192), 16, 0, 0); } while (0)
#define PG8_LDA(dst, b, h) do { _Pragma("unroll") for (int m = 0; m < 4; ++m) _Pragma("unroll") for (int k = 0; k < 2; ++k) dst[m][k] = *(const PG8_LAS h8*)(lds + PG8_SA(b, h) + aoff + m * 2048 + k * 1024); } while (0)
#define PG8_LDB(dst, b, h) do { _Pragma("unroll") for (int n = 0; n < 2; ++n) _Pragma("unroll") for (int k = 0; k < 2; ++k) dst[n][k] = *(const PG8_LAS h8*)(lds + PG8_SB(b, h) + boff + n * 2048 + k * 1024); } while (0)
#define PG8_MMA(ai, bj, At, Bt) do { __builtin_amdgcn_s_setprio(1); _Pragma("unroll") for (int m = 0; m < 4; ++m) _Pragma("unroll") for (int n = 0; n < 2; ++n) _Pragma("unroll") for (int k = 0; k < 2; ++k) \
        acc[ai][bj][m][n] = __builtin_amdgcn_mfma_f32_16x16x32_f16(Bt[n][k], At[m][k], acc[ai][bj][m][n], 0, 0, 0); __builtin_amdgcn_s_setprio(0); } while (0)
#define PG8_WAIT_V(n) asm volatile("s_waitcnt vmcnt(" #n ")" ::: "memory")
#define PG8_WAIT_L(n) asm volatile("s_waitcnt lgkmcnt(" #n ")" ::: "memory")
#define PG8_BAR __builtin_amdgcn_s_barrier()
#define PG8_SCHED __builtin_amdgcn_sched_barrier(0)
    Unit cur, nxt; int ui = 0;
    if (!S.next(0, cur)) return;
    f32x4 acc[2][2][4][2];
#pragma unroll
    for (int a = 0; a < 2; ++a)
#pragma unroll
        for (int b = 0; b < 2; ++b)
#pragma unroll
            for (int m = 0; m < 4; ++m)
#pragma unroll
                for (int n = 0; n < 2; ++n) acc[a][b][m][n] = (f32x4){0.f, 0.f, 0.f, 0.f};
    h8 At[4][2], B0[2][2], B1[2][2];
    const char* cA = (const char*)g.A + (size_t)cur.pm * tstepA; const char* cB = (const char*)g.Bt + (size_t)cur.pn * tstepB;
    S.a_ready(cur);
    if constexpr (SP2) {
        PG8_STAGE(PG8_SB(0, 0), cB, voffB); PG8_STAGE(PG8_SB(0, 1), cB + hstepB, voffB); PG8_STAGE(PG8_SA(0, 0), cA, voffA); PG8_STAGE(PG8_SA(0, 1), cA + hstepA, voffA);
        if (wr == 1) PG8_BAR;
        PG8_WAIT_V(2); PG8_BAR;
        PG8_STAGE(PG8_SB(1, 0), cB + kstep, voffB); PG8_STAGE(PG8_SA(1, 0), cA + kstep, voffA); PG8_STAGE(PG8_SB(1, 1), cB + hstepB + kstep, voffB);
        PG8_WAIT_V(6); PG8_BAR;
    } else {
        PG8_STAGE(PG8_SB(0, 0), cB, voffB); PG8_STAGE(PG8_SA(0, 0), cA, voffA); PG8_STAGE(PG8_SB(0, 1), cB + hstepB, voffB); PG8_STAGE(PG8_SA(0, 1), cA + hstepA, voffA);
        if (wr == 1) PG8_BAR;
        PG8_WAIT_V(4); PG8_BAR;
        PG8_STAGE(PG8_SB(1, 0), cB + kstep, voffB); PG8_STAGE(PG8_SA(1, 0), cA + kstep, voffA); PG8_STAGE(PG8_SB(1, 1), cB + hstepB + kstep, voffB);
        PG8_WAIT_V(6); PG8_BAR;
    }
    for (;;) {
        const bool has_next = S.next(ui + 1, nxt);
        const char* nA = has_next ? (const char*)g.A + (size_t)nxt.pm * tstepA : cA; const char* nB = has_next ? (const char*)g.Bt + (size_t)nxt.pn * tstepB : cB;
        for (int t = 0; t < nt; t += 2) {
            const bool last = (t == nt - 2);
            const char* a1 = cA + PG8_KOA(t + 1);
            const char* a2 = last ? nA : cA + PG8_KOA(t + 2); const char* b2 = last ? nB : cB + (size_t)(t + 2) * kstep;
            const char* a3 = a2 + kstep; const char* b3 = b2 + kstep;
            if (last && has_next) S.a_ready(nxt);
            if constexpr (SP2) {
            PG8_LDB(B0, 0, 0); PG8_LDB(B1, 0, 1); PG8_SCHED; PG8_LDA(At, 0, 0); PG8_STAGE(PG8_SA(1, 1), a1 + hstepA, voffA);
            PG8_WAIT_V(8); PG8_WAIT_L(0); PG8_BAR; PG8_MMA(0, 0, At, B0); PG8_MMA(0, 1, At, B1); PG8_BAR; PG8_SCHED;
            PG8_LDA(At, 0, 1); PG8_STAGE(PG8_SB(0, 0), b2, voffB); PG8_STAGE(PG8_SB(0, 1), b2 + hstepB, voffB); PG8_STAGE(PG8_SA(0, 0), a2, voffA);
            PG8_WAIT_V(8); PG8_WAIT_L(0); PG8_BAR; PG8_MMA(1, 0, At, B0); PG8_MMA(1, 1, At, B1); PG8_BAR; PG8_SCHED;
            PG8_LDB(B0, 1, 0); PG8_LDB(B1, 1, 1); PG8_SCHED; PG8_LDA(At, 1, 0); PG8_STAGE(PG8_SA(0, 1), a2 + hstepA, voffA);
            PG8_WAIT_V(8); PG8_WAIT_L(0); PG8_BAR; PG8_MMA(0, 0, At, B0); PG8_MMA(0, 1, At, B1); PG8_BAR; PG8_SCHED;
            PG8_LDA(At, 1, 1); PG8_STAGE(PG8_SB(1, 0), b3, voffB); PG8_STAGE(PG8_SB(1, 1), b3 + hstepB, voffB); PG8_STAGE(PG8_SA(1, 0), a3, voffA);
            PG8_WAIT_V(8); PG8_WAIT_L(0); PG8_BAR; PG8_MMA(1, 0, At, B0); PG8_MMA(1, 1, At, B1); PG8_BAR; PG8_SCHED;
            } else {
            PG8_LDB(B0, 0, 0); PG8_SCHED; PG8_LDA(At, 0, 0); PG8_STAGE(PG8_SA(1, 1), a1 + hstepA, voffA);
            PG8_WAIT_L(8); PG8_BAR; PG8_WAIT_L(0); PG8_MMA(0, 0, At, B0); PG8_BAR; PG8_SCHED;
            PG8_LDB(B1, 0, 1); PG8_STAGE(PG8_SB(0, 0), b2, voffB);
            PG8_BAR; PG8_WAIT_L(0); PG8_MMA(0, 1, At, B1); PG8_BAR;
            PG8_LDA(At, 0, 1); PG8_STAGE(PG8_SA(0, 0), a2, voffA);
            PG8_BAR; PG8_WAIT_L(0); PG8_MMA(1, 0, At, B0); PG8_BAR; PG8_SCHED;
            PG8_STAGE(PG8_SB(0, 1), b2 + hstepB, voffB);
            PG8_WAIT_V(6); PG8_BAR; PG8_MMA(1, 1, At, B1); PG8_BAR;
            PG8_LDB(B0, 1, 0); PG8_SCHED; PG8_LDA(At, 1, 0); PG8_STAGE(PG8_SA(0, 1), a2 + hstepA, voffA);
            PG8_WAIT_L(8); PG8_BAR; PG8_WAIT_L(0); PG8_MMA(0, 0, At, B0); PG8_BAR; PG8_SCHED;
            PG8_LDB(B1, 1, 1); PG8_STAGE(PG8_SB(1, 0), b3, voffB);
            PG8_BAR; PG8_WAIT_L(0); PG8_MMA(0, 1, At, B1); PG8_BAR;
            PG8_LDA(At, 1, 1); PG8_STAGE(PG8_SA(1, 0), a3, voffA);
            PG8_BAR; PG8_WAIT_L(0); PG8_MMA(1, 0, At, B0); PG8_BAR; PG8_SCHED;
            PG8_STAGE(PG8_SB(1, 1), b3 + hstepB, voffB);
            PG8_WAIT_V(6); PG8_BAR; PG8_MMA(1, 1, At, B1); PG8_BAR;
            }
        }
        if constexpr (ALIGN_EPI) { if (wr == 0) PG8_BAR; }
        E(acc, cur, wr, wc, fr, fq); S.done(cur);
        if (!has_next) break;
#pragma unroll
        for (int a = 0; a < 2; ++a)
#pragma unroll
            for (int b = 0; b < 2; ++b)
#pragma unroll
                for (int m = 0; m < 4; ++m)
#pragma unroll
                    for (int n = 0; n < 2; ++n) acc[a][b][m][n] = (f32x4){0.f, 0.f, 0.f, 0.f};
        cur = nxt; cA = nA; cB = nB; ++ui;
        if constexpr (ALIGN_EPI) { if (wr == 1) PG8_BAR; }
    }
    PG8_WAIT_V(0);
    if constexpr (!ALIGN_EPI) { if (wr == 0) PG8_BAR; }
    PG8_BAR;
#undef PG8_KOA
#undef PG8_SA
#undef PG8_SB
#undef PG8_STAGE
#undef PG8_LDA
#undef PG8_LDB
#undef PG8_MMA
#undef PG8_WAIT_V
#undef PG8_WAIT_L
#undef PG8_BAR
#undef PG8_SCHED
}
}

constexpr int NWAVES = 8;
constexpr int S = 16384, D = 2048, FF = 5632;
constexpr int MEM_LEN = 256, MEM_W = 512;
constexpr int MAIN_W = 1536;
constexpr int ML_H = 4, ML_DQK = 192, ML_DV = 384, ML_L = 64, ML_NC = S / ML_L;
constexpr int A_INW = 5128, A_N = 5120;
constexpr int B_INW = 2084, B_N = 2048;
constexpr int KVW = 1536;
constexpr int NCMP = 1023;
constexpr float EPS = 1e-6f;

constexpr size_t MiB = 1u << 20;
constexpr size_t WS_CTL = 0, CTL_ZERO_BYTES = 64 * 1024;
constexpr size_t WS_MEMN  = 1 * MiB;
constexpr size_t WS_MEMKV = 3 * MiB;
constexpr size_t WS_GA    = 4 * MiB;
constexpr size_t WS_GB    = 5 * MiB;
constexpr size_t WS_WGA   = 8 * MiB;
constexpr size_t WS_WGB   = 8 * MiB + 128 * 1024;
constexpr size_t WS_CB1   = 8 * MiB + 512 * 1024;
constexpr size_t WS_B63   = 8 * MiB + 520 * 1024;
constexpr size_t WS_MLOC  = 8 * MiB + 524 * 1024;
constexpr size_t WS_MST   = 8 * MiB + 528 * 1024;
constexpr size_t WS_DN    = 9 * MiB;
constexpr size_t WS_KVC   = 10 * MiB;
constexpr size_t WS_CMPH  = 11 * MiB;
constexpr size_t WS_ROPE  = 13 * MiB;
constexpr size_t WS_W     = 24 * MiB;
constexpr size_t WS_WGU   = WS_W;
constexpr size_t WS_WD    = WS_WGU + 176 * MiB;
constexpr size_t WS_WAIN  = WS_WD + 88 * MiB;
constexpr size_t WS_WOUT  = WS_WAIN + 20 * MiB;
constexpr size_t WS_WKV   = WS_WOUT + 16 * MiB;
constexpr size_t WS_WBIN  = WS_WKV + 6 * MiB;
constexpr size_t WS_WMKV  = WS_WBIN + 8 * MiB;
constexpr size_t WS_WC1   = WS_WMKV + 8 * MiB;
constexpr size_t WS_WC2   = WS_WC1 + 4 * MiB;
constexpr size_t WS_XN    = WS_WC2 + 1 * MiB;
constexpr size_t WS_SCR   = WS_XN + 64 * MiB;
constexpr size_t WS_H     = WS_SCR;
constexpr size_t WS_Y     = WS_SCR + 176 * MiB;
constexpr size_t WS_CT    = WS_SCR;
constexpr size_t WS_AOUT  = WS_SCR + 144 * MiB;
constexpr size_t WS_XKV   = WS_SCR;
constexpr size_t WS_BOUT  = WS_SCR;
constexpr size_t WS_VST   = WS_SCR + 64 * MiB;
constexpr size_t WS_VWT   = WS_SCR + 72 * MiB;
constexpr size_t WS_KVRAW = WS_SCR + 304 * MiB;
constexpr size_t WS_END   = WS_KVRAW + 48 * MiB + 128 * 1024;
constexpr int CW_TMO = 0;
constexpr int CW_BAR = 4096;

constexpr int LDSCTL_OFF = 0, LDSCTL_BYTES = 512, MISC_OFF = 320;
constexpr int RING_OFF = 512, RING_BYTES = 146944;
constexpr int LDS_BYTES = 147456;
constexpr int WAVE_LDS = 18368;

typedef GAS unsigned gu32;
#define RLX_AGENT __ATOMIC_RELAXED, __HIP_MEMORY_SCOPE_AGENT
#define LDS_WAIT() asm volatile("s_waitcnt lgkmcnt(0)" ::: "memory")
#define VM_WAIT() asm volatile("s_waitcnt vmcnt(0)" ::: "memory")

#define XB_TMO      128
#define XB_XCNT(j)  (256  + 64 * (j))
#define XB_XSUB(j)  (1280 + 64 * (j))
#define XB_XGEN(j)  (2304 + 64 * (j))
#define XB_TOP      3328
#define XB_TOPGEN   3392
#define XCD_BAR_WORDS 3456
#define XB_SPIN_CAP (1u << 18)

__device__ __forceinline__ unsigned xb_ld(unsigned* p)              { return __hip_atomic_load(p, __ATOMIC_RELAXED, __HIP_MEMORY_SCOPE_AGENT); }
__device__ __forceinline__ unsigned xb_add(unsigned* p, unsigned v) { return __hip_atomic_fetch_add(p, v, __ATOMIC_RELAXED, __HIP_MEMORY_SCOPE_AGENT); }
__device__ __forceinline__ unsigned xb_xcc_id() { return (unsigned)__builtin_amdgcn_s_getreg((3 << 11) | 20) & 0xFu; }
#define XB_SPIN(cond, bar) do { unsigned _sp = 0; while (cond) { __builtin_amdgcn_s_sleep(1); \
    if ((++_sp & 255u) == 0u) { if (xb_ld(&(bar)[XB_TMO])) break; if (_sp > XB_SPIN_CAP) { atomicAdd(&(bar)[XB_TMO], 1u); break; } } } } while (0)

struct XcdBarrier { unsigned* bar; unsigned x; volatile LAS unsigned* st; };

__device__ __forceinline__ XcdBarrier xcd_barrier_post(unsigned* bar, volatile LAS unsigned* st) {
    XcdBarrier b; b.bar = bar; b.x = xb_xcc_id(); b.st = st;
    if (threadIdx.x == 0) (void)xb_add(&bar[XB_XCNT(b.x)], 1u);
    return b;
}
__device__ __forceinline__ void xcd_barrier_complete(unsigned* bar, unsigned x, unsigned& nloc, unsigned& nx) {
    const unsigned G = gridDim.x * gridDim.y * gridDim.z;
    unsigned sum, cnt, mine, sp = 0u;
    for (;;) {
        sum = 0u; cnt = 0u; mine = 0u;
#pragma unroll
        for (unsigned j = 0; j < 16; ++j) { const unsigned c = xb_ld(&bar[XB_XCNT(j)]); sum += c; cnt += (c > 0u) ? 1u : 0u; mine = (j == x) ? c : mine; }
        if (sum == G) break;
        __builtin_amdgcn_s_sleep(1);
        if ((++sp & 255u) == 0u) { if (xb_ld(&bar[XB_TMO])) break; if (sp > XB_SPIN_CAP) { atomicAdd(&bar[XB_TMO], 1u); break; } }
    }
    nloc = mine > 0u ? mine : 1u; nx = cnt > 0u ? cnt : 1u;
}
__device__ __forceinline__ void xcd_barrier(const XcdBarrier& b) {
    asm volatile("s_waitcnt vmcnt(0)" ::: "memory");
    __syncthreads();
    if (threadIdx.x == 0) {
        unsigned* bar = b.bar;
        __builtin_amdgcn_s_waitcnt(0);
        unsigned nloc = b.st[0], nx = b.st[1];
        if (nloc == 0u) { xcd_barrier_complete(bar, b.x, nloc, nx); b.st[0] = nloc; b.st[1] = nx; }
        const unsigned old = xb_add(&bar[XB_XSUB(b.x)], 1u);
        const unsigned gen = old / nloc;
        if (old + 1u == (gen + 1u) * nloc) {
            __builtin_amdgcn_fence(__ATOMIC_RELEASE, "agent");
            asm volatile("s_waitcnt vmcnt(0)" ::: "memory");
            const unsigned og = xb_add(&bar[XB_TOP], 1u);
            const unsigned tg = og / nx;
            if (og + 1u == (tg + 1u) * nx) xb_add(&bar[XB_TOPGEN], 1u);
            else XB_SPIN(xb_ld(&bar[XB_TOPGEN]) == tg, bar);
            __builtin_amdgcn_fence(__ATOMIC_ACQUIRE, "agent");
            xb_add(&bar[XB_XGEN(b.x)], 1u);
            asm volatile("s_waitcnt vmcnt(0)" ::: "memory");
        } else {
            XB_SPIN(xb_ld(&bar[XB_XGEN(b.x)]) == gen, bar);
            __builtin_amdgcn_fence(__ATOMIC_ACQUIRE, "agent");
            asm volatile("s_waitcnt vmcnt(0)" ::: "memory");
        }
    }
    __syncthreads();
}

__device__ __forceinline__ float wave_sum(float v) {
#pragma unroll
    for (int o = 1; o < 64; o <<= 1) v += __shfl_xor(v, o);
    return v;
}
__device__ __forceinline__ float wave_max(float v) {
#pragma unroll
    for (int o = 1; o < 64; o <<= 1) v = fmaxf(v, __shfl_xor(v, o));
    return v;
}
__device__ __forceinline__ float sigmoidf_(float x) { return 1.0f / (1.0f + __expf(-x)); }
__device__ __forceinline__ float log_sigmoidf_(float x) { return fminf(x, 0.f) - log1pf(__expf(-fabsf(x))); }

__device__ __forceinline__ void cvt_item(const float* W, int ldw, int col0, int k0, u16* WT, int Kdst, int drow0, float scale, LAS float* scr, int lane) {
#pragma unroll 8
    for (int i = 0; i < 32; ++i) { const int kk = 2 * i + (lane >> 5); scr[kk * 33 + (lane & 31)] = W[(size_t)(k0 + kk) * ldw + col0 + (lane & 31)]; }
    LDS_WAIT(); asm volatile("" ::: "memory");
    const int c = lane & 7;
#pragma unroll
    for (int j = 0; j < 4; ++j) { const int n = (lane >> 3) + 8 * j; const LAS float* s = scr + (8 * c) * 33 + n;
        u32x4 o; o.x = pkh(s[0 * 33] * scale, s[1 * 33] * scale); o.y = pkh(s[2 * 33] * scale, s[3 * 33] * scale); o.z = pkh(s[4 * 33] * scale, s[5 * 33] * scale); o.w = pkh(s[6 * 33] * scale, s[7 * 33] * scale);
        *(GAS u32x4*)(WT + (size_t)(drow0 + n) * Kdst + k0 + 8 * c) = o; }
    LDS_WAIT(); asm volatile("" ::: "memory");
}

template <int NG>
__device__ __forceinline__ void thin_rows(const float* Y, float alpha, const float* gpost, const float* Xin, float* Xout,
                                          const float* gpre1, u16* XN1, const float* gpre2, u16* XN2,
                                          const float* WgT, const float* gbias, float* gates, bool gate_sigmoid, int gw, int NGW, int lane) {
    for (int row = gw; row < S; row += NGW) {
        f32x4 x[8];
        const GAS f32x4* xr = (const GAS f32x4*)(Xin + (size_t)row * D) + lane;
#pragma unroll
        for (int j = 0; j < 8; ++j) x[j] = xr[64 * j];
        if (Y) {
            f32x4 y[8]; float ss = 0.f;
            const GAS f32x4* yr = (const GAS f32x4*)(Y + (size_t)row * D) + lane;
#pragma unroll
            for (int j = 0; j < 8; ++j) { y[j] = yr[64 * j]; ss += (y[j].x * y[j].x + y[j].y * y[j].y) + (y[j].z * y[j].z + y[j].w * y[j].w); }
            const float r = alpha * rsqrtf(wave_sum(ss) * (1.0f / D) + EPS);
#pragma unroll
            for (int j = 0; j < 8; ++j) { const f32x4 g = ((const GAS f32x4*)gpost)[lane + 64 * j]; x[j] = x[j] + y[j] * g * r; }
        }
        if (Xout) { GAS f32x4* xo = (GAS f32x4*)(Xout + (size_t)row * D) + lane;
#pragma unroll
            for (int j = 0; j < 8; ++j) xo[64 * j] = x[j]; }
        if (XN1) {
            float ss = 0.f;
#pragma unroll
            for (int j = 0; j < 8; ++j) ss += (x[j].x * x[j].x + x[j].y * x[j].y) + (x[j].z * x[j].z + x[j].w * x[j].w);
            const float r = rsqrtf(wave_sum(ss) * (1.0f / D) + EPS);
#pragma unroll
            for (int j = 0; j < 8; ++j) x[j] = x[j] * r;
            if (XN2) { GAS u32x2* o2 = (GAS u32x2*)(XN2 + (size_t)row * D) + lane;
#pragma unroll
                for (int j = 0; j < 8; ++j) { const f32x4 g = ((const GAS f32x4*)gpre2)[lane + 64 * j]; const f32x4 v = x[j] * g; u32x2 w; w.x = pkh(v.x, v.y); w.y = pkh(v.z, v.w); o2[64 * j] = w; } }
            GAS u32x2* o1 = (GAS u32x2*)(XN1 + (size_t)row * D) + lane;
#pragma unroll
            for (int j = 0; j < 8; ++j) { const f32x4 g = ((const GAS f32x4*)gpre1)[lane + 64 * j]; x[j] = x[j] * g; u32x2 w; w.x = pkh(x[j].x, x[j].y); w.y = pkh(x[j].z, x[j].w); o1[64 * j] = w; }
            if (NG > 0) {
                for (int gi = 0; gi < NG; ++gi) {
                    const GAS f32x4* wr = (const GAS f32x4*)(WgT + (size_t)gi * D) + lane; float a = 0.f;
#pragma unroll
                    for (int j = 0; j < 8; ++j) { const f32x4 w = wr[64 * j]; a += (x[j].x * w.x + x[j].y * w.y) + (x[j].z * w.z + x[j].w * w.w); }
                    a = wave_sum(a) + gbias[gi];
                    if (gate_sigmoid) a = sigmoidf_(a);
                    if (lane == 0) gates[(size_t)row * NG + gi] = a;
                }
            }
        }
    }
}

__device__ __forceinline__ void mem_attn_scalar(const u16* Q, int ldq, int qoff, const u16* MKV, u16* HEADS, int gw, int NGW, int lane) {
    const float scale = 0.08838834764831845f;
    for (int item = gw; item < S * 4; item += NGW) {
        const int t = item >> 2, hd = item & 3;
        const h8* qp = (const h8*)(Q + (size_t)t * ldq + qoff + hd * 128);
        float sc[4];
#pragma unroll
        for (int i = 0; i < 4; ++i) { const int key = lane + 64 * i; const h8* kr = (const h8*)(MKV + (size_t)key * 1024 + hd * 128); float a = 0.f;
#pragma unroll 4
            for (int c = 0; c < 16; ++c) { const h8 kv = kr[c], qv = qp[c];
#pragma unroll
                for (int e = 0; e < 8; ++e) a += (float)kv[e] * (float)qv[e]; }
            sc[i] = a * scale; }
        const float m = wave_max(fmaxf(fmaxf(sc[0], sc[1]), fmaxf(sc[2], sc[3])));
        float p[4], ls = 0.f;
#pragma unroll
        for (int i = 0; i < 4; ++i) { p[i] = __expf(sc[i] - m); ls += p[i]; }
        const float l = wave_sum(ls);
        float o0 = 0.f, o1 = 0.f;
#pragma unroll
        for (int i = 0; i < 4; ++i) {
            for (int kk = 0; kk < 64; ++kk) { const float pk = __builtin_bit_cast(float, __builtin_amdgcn_readlane(__builtin_bit_cast(int, p[i]), kk));
                const h2 vv = *(const h2*)(MKV + (size_t)(kk + 64 * i) * 1024 + 512 + hd * 128 + 2 * lane); o0 += pk * (float)vv[0]; o1 += pk * (float)vv[1]; } }
        const float il = 1.0f / l;
        *(unsigned*)(HEADS + (size_t)t * D + MAIN_W + hd * 128 + 2 * lane) = pkh(o0 * il, o1 * il);
    }
}


__device__ __forceinline__ f32x4 mma16(h8 a, h8 b, f32x4 c) { return __builtin_amdgcn_mfma_f32_16x16x32_f16(a, b, c, 0, 0, 0); }
__device__ __forceinline__ h8 cat44(h4 a, h4 b) { return __builtin_shufflevector(a, b, 0, 1, 2, 3, 4, 5, 6, 7); }
__device__ __forceinline__ h4 cvt4(f32x4 v) { return __builtin_convertvector(v, h4); }
__device__ __forceinline__ h8 cvt8(f32x4 a, f32x4 b) { return cat44(cvt4(a), cvt4(b)); }

__device__ __forceinline__ void mem_attn_mfma(const u16* Q, int ldq, int qoff, const u16* MKV, u16* HEADS, LAS unsigned char* ring, int tid, int G) {
    const int lane = tid & 63, wave = __builtin_amdgcn_readfirstlane(tid >> 6), fr = lane & 15, fq = lane >> 4;
    const int hd = blockIdx.x & 3, rank = blockIdx.x >> 2, nbh = (G - hd + 3) >> 2;
    LAS f16* Ks = (LAS f16*)ring;
    LAS f16* Vt = (LAS f16*)(ring + 69632);
    __syncthreads();
    for (int e = tid; e < 4096; e += 512) { const int key = e & 255, cc = e >> 8;
        *(LAS h8*)(Ks + key * 136 + cc * 8) = *(const h8*)(MKV + (size_t)key * 1024 + hd * 128 + cc * 8);
        const h8 vv = *(const h8*)(MKV + (size_t)key * 1024 + 512 + hd * 128 + cc * 8);
#pragma unroll
        for (int j = 0; j < 8; ++j) Vt[(cc * 8 + j) * 264 + key] = vv[j]; }
    __syncthreads();
    const float sc = 0.08838834764831845f * 1.4426950408889634f;
    for (int tile = rank * 8 + wave; tile < S / 16; tile += nbh * 8) {
        const int t0 = tile * 16;
        h8 qf[4];
#pragma unroll
        for (int ks = 0; ks < 4; ++ks) qf[ks] = *(const h8*)(Q + (size_t)(t0 + fr) * ldq + qoff + hd * 128 + ks * 32 + fq * 8);
        f32x4 st[16]; float m = -3.0e38f;
#pragma unroll
        for (int kt = 0; kt < 16; ++kt) { f32x4 a = {0.f, 0.f, 0.f, 0.f};
#pragma unroll
            for (int ks = 0; ks < 4; ++ks) a = mma16(*(const LAS h8*)(Ks + (kt * 16 + fr) * 136 + ks * 32 + fq * 8), qf[ks], a);
            st[kt] = a; m = fmaxf(m, fmaxf(fmaxf(a[0], a[1]), fmaxf(a[2], a[3]))); asm volatile("" ::: "memory"); }
        m = fmaxf(m, __shfl_xor(m, 16)); m = fmaxf(m, __shfl_xor(m, 32));
        float l = 0.f; h8 pf[8];
#pragma unroll
        for (int kb = 0; kb < 8; ++kb) { f32x4 p0, p1;
#pragma unroll
            for (int r = 0; r < 4; ++r) { p0[r] = __builtin_amdgcn_exp2f((st[2 * kb][r] - m) * sc); p1[r] = __builtin_amdgcn_exp2f((st[2 * kb + 1][r] - m) * sc); }
            l += (p0[0] + p0[1]) + (p0[2] + p0[3]) + (p1[0] + p1[1]) + (p1[2] + p1[3]); pf[kb] = cvt8(p0, p1); }
        l += __shfl_xor(l, 16); l += __shfl_xor(l, 32);
        const float il = 1.0f / l;
#pragma unroll
        for (int dt = 0; dt < 8; ++dt) { f32x4 o = {0.f, 0.f, 0.f, 0.f};
#pragma unroll
            for (int kb = 0; kb < 8; ++kb) { const LAS f16* vp = Vt + (dt * 16 + fr) * 264 + kb * 32 + 4 * fq;
                o = mma16(cat44(*(const LAS h4*)vp, *(const LAS h4*)(vp + 16)), pf[kb], o); }
            *(h4*)(HEADS + (size_t)(t0 + fr) * D + MAIN_W + hd * 128 + dt * 16 + 4 * fq) = cvt4(o * il); asm volatile("" ::: "memory"); }
    }
    __syncthreads();
}

#define NSA_NEG (-1.0e30f)
constexpr int NSA_NH = 2;
__device__ __forceinline__ void nsa_item(const int t0, const int g, const u16* BOUT, const u16* KVRAW, const u16* KC, const u16* VCT, const u16* VST, const u16* VWT,
                                         const float* GB, const float* ROPE, u16* XN, LAS float* psl, LAS int* sel, const int lane) {
    const int fr = lane & 15, fq = lane >> 4;
    const float sc2 = 0.08838834764831845f * 1.4426950408889634f;
    const int cur = t0 >> 6;
    const int nvmax = t0 >> 4;
    const int nvl = (t0 >> 4) - 1 + (fr == 15 ? 1 : 0);
    const int nsteps = (nvmax + 31) >> 5;
#pragma unroll
    for (int kt = 0; kt < 64; ++kt) psl[kt * 64 + lane] = 0.f;
    for (int hb = 0; hb < 6 / NSA_NH; ++hb) {
        const int hh0 = g * 6 + hb * NSA_NH;
        h8 qf[NSA_NH][4];
#pragma unroll
        for (int j = 0; j < NSA_NH; ++j)
#pragma unroll
            for (int ks = 0; ks < 4; ++ks) qf[j][ks] = *(const h8*)(BOUT + (size_t)(t0 + fr) * B_N + (hh0 + j) * 128 + ks * 32 + fq * 8);
        float m[NSA_NH], l[NSA_NH];
#pragma unroll
        for (int j = 0; j < NSA_NH; ++j) { m[j] = NSA_NEG; l[j] = 0.f; }
        for (int st = 0; st < nsteps * 2; ++st) {
            h8 kf[4];
#pragma unroll
            for (int ks = 0; ks < 4; ++ks) kf[ks] = *(const h8*)(KC + ((size_t)g * 1024 + st * 16 + fr) * 128 + ks * 32 + fq * 8);
            const int n0 = st * 16 + 4 * fq;
#pragma unroll
            for (int j = 0; j < NSA_NH; ++j) { f32x4 s = {0.f, 0.f, 0.f, 0.f};
#pragma unroll
                for (int ks = 0; ks < 4; ++ks) s = mma16(kf[ks], qf[j][ks], s);
                float bm = NSA_NEG;
#pragma unroll
                for (int r = 0; r < 4; ++r) { s[r] = (n0 + r < nvl) ? s[r] * sc2 : NSA_NEG; bm = fmaxf(bm, s[r]); }
                const float mn = fmaxf(m[j], bm); float ps = 0.f;
#pragma unroll
                for (int r = 0; r < 4; ++r) ps += (n0 + r < nvl) ? __builtin_amdgcn_exp2f(s[r] - mn) : 0.f;
                l[j] = l[j] * __builtin_amdgcn_exp2f(m[j] - mn) + ps; m[j] = mn; }
        }
        float il[NSA_NH];
#pragma unroll
        for (int j = 0; j < NSA_NH; ++j) { float mt = fmaxf(m[j], __shfl_xor(m[j], 16)); mt = fmaxf(mt, __shfl_xor(mt, 32));
            float lt = l[j] * __builtin_amdgcn_exp2f(m[j] - mt); lt += __shfl_xor(lt, 16); lt += __shfl_xor(lt, 32);
            m[j] = mt; il[j] = lt > 0.f ? 1.0f / lt : 0.f; }
        f32x4 o[NSA_NH][8];
#pragma unroll
        for (int j = 0; j < NSA_NH; ++j)
#pragma unroll
            for (int dt = 0; dt < 8; ++dt) o[j][dt] = (f32x4){0.f, 0.f, 0.f, 0.f};
        float rot_prev = 0.f;
        for (int st = 0; st < nsteps; ++st) {
            f32x4 p[NSA_NH][2];
#pragma unroll
            for (int k2 = 0; k2 < 2; ++k2) { h8 kf[4];
#pragma unroll
                for (int ks = 0; ks < 4; ++ks) kf[ks] = *(const h8*)(KC + ((size_t)g * 1024 + st * 32 + k2 * 16 + fr) * 128 + ks * 32 + fq * 8);
                const int n0 = st * 32 + k2 * 16 + 4 * fq;
#pragma unroll
                for (int j = 0; j < NSA_NH; ++j) { f32x4 s = {0.f, 0.f, 0.f, 0.f};
#pragma unroll
                    for (int ks = 0; ks < 4; ++ks) s = mma16(kf[ks], qf[j][ks], s);
#pragma unroll
                    for (int r = 0; r < 4; ++r) s[r] = (n0 + r < nvl) ? __builtin_amdgcn_exp2f(s[r] * sc2 - m[j]) * il[j] : 0.f;
                    p[j][k2] = s; }
                f32x4 ps = p[0][k2];
#pragma unroll
                for (int j = 1; j < NSA_NH; ++j) ps = ps + p[j][k2];
                const float rot = __shfl(ps[3], (lane + 48) & 63);
                const float prev = (fq == 0) ? rot_prev : rot; rot_prev = rot;
                const int kt = st * 2 + k2;
                psl[kt * 64 + lane] += 2.f * (ps[0] + ps[1] + ps[2]) + ps[3] + prev;
            }
            h8 pf[NSA_NH];
#pragma unroll
            for (int j = 0; j < NSA_NH; ++j) pf[j] = cvt8(p[j][0], p[j][1]);
#pragma unroll
            for (int dt = 0; dt < 8; ++dt) { const u16* vp = VCT + ((size_t)g * 128 + dt * 16 + fr) * 1024 + st * 32 + 4 * fq;
                const h8 vf = cat44(*(const h4*)vp, *(const h4*)(vp + 16));
#pragma unroll
                for (int j = 0; j < NSA_NH; ++j) o[j][dt] = mma16(vf, pf[j], o[j][dt]); }
        }
#pragma unroll
        for (int j = 0; j < NSA_NH; ++j) { const float gc = GB[(size_t)(t0 + fr) * 36 + (hh0 + j) * 3 + 0];
#pragma unroll
            for (int dt = 0; dt < 8; ++dt) *(h4*)(XN + (size_t)(t0 + fr) * D + (hh0 + j) * 128 + dt * 16 + 4 * fq) = cvt4(o[j][dt] * gc); }
        asm volatile("" ::: "memory");
    }
    LDS_WAIT();
    int nsel;
    if (cur <= 15) { nsel = cur + 1; int z = 0; asm volatile("" : "+v"(z));
        if (fq == 0) {
#pragma unroll
            for (int b = 0; b < 16; ++b) sel[fr * 16 + b] = z + b; } }
    else { nsel = 16;
        float v[64];
#pragma unroll
        for (int kt = 0; kt < 64; ++kt) { const int jb = 4 * kt + fq; v[kt] = (jb >= 1 && jb <= cur - 2) ? psl[kt * 64 + lane] : -1.f; }
        if (fq == 0) { sel[fr * 16 + 0] = 0; sel[fr * 16 + 1] = cur - 1; sel[fr * 16 + 2] = cur; }
        for (int r = 0; r < 13; ++r) { float bv = -3.f; int bi = 0;
#pragma unroll
            for (int kt = 0; kt < 64; ++kt) if (v[kt] > bv) { bv = v[kt]; bi = 4 * kt + fq; }
#pragma unroll
            for (int off = 16; off < 64; off <<= 1) { const float ov = __shfl_xor(bv, off); const int oi = __shfl_xor(bi, off); if (ov > bv || (ov == bv && oi < bi)) { bv = ov; bi = oi; } }
            if (fq == 0) sel[fr * 16 + 3 + r] = bi;
#pragma unroll
            for (int kt = 0; kt < 64; ++kt) v[kt] = (4 * kt + fq == bi) ? -2.f : v[kt]; }
    }
    VM_WAIT(); LDS_WAIT();
    for (int i = 0; i < 16; ++i) {
        const int t = t0 + i;
        h8 qr[4];
        { h8 q[4];
#pragma unroll
          for (int ks = 0; ks < 4; ++ks) q[ks] = (fr < 6) ? *(const h8*)(BOUT + (size_t)t * B_N + (g * 6 + fr) * 128 + ks * 32 + fq * 8) : (h8){0, 0, 0, 0, 0, 0, 0, 0};
#pragma unroll
          for (int ks = 0; ks < 2; ++ks) { const float* cp = ROPE + (size_t)t * 64 + ks * 32 + fq * 8; const float* sp = cp + (size_t)S * 64;
              const f32x4 c0 = *(const f32x4*)cp, c1 = *(const f32x4*)(cp + 4), s0 = *(const f32x4*)sp, s1 = *(const f32x4*)(sp + 4);
#pragma unroll
              for (int e = 0; e < 8; ++e) { const float c = e < 4 ? c0[e & 3] : c1[e & 3], s = e < 4 ? s0[e & 3] : s1[e & 3]; const float x1 = (float)q[ks][e], x2 = (float)q[ks + 2][e];
                  qr[ks][e] = (f16)(x1 * c - x2 * s); qr[ks + 2][e] = (f16)(x2 * c + x1 * s); } } }
        float m = NSA_NEG, l = 0.f; f32x4 o[8];
#pragma unroll
        for (int dt = 0; dt < 8; ++dt) o[dt] = (f32x4){0.f, 0.f, 0.f, 0.f};
        for (int b = 0; b < nsel; ++b) {
            const int blk = __builtin_amdgcn_readfirstlane(sel[i * 16 + b]); const int kbase = blk * 64;
            f32x4 s[4]; float bm = NSA_NEG;
#pragma unroll
            for (int kt = 0; kt < 4; ++kt) { f32x4 a = {0.f, 0.f, 0.f, 0.f};
#pragma unroll
                for (int ks = 0; ks < 4; ++ks) a = mma16(*(const h8*)(KVRAW + (size_t)(kbase + kt * 16 + fr) * KVW + 512 + g * 128 + ks * 32 + fq * 8), qr[ks], a);
#pragma unroll
                for (int r = 0; r < 4; ++r) { a[r] = (kbase + kt * 16 + 4 * fq + r <= t) ? a[r] * sc2 : NSA_NEG; bm = fmaxf(bm, a[r]); }
                s[kt] = a; }
            bm = fmaxf(bm, __shfl_xor(bm, 16)); bm = fmaxf(bm, __shfl_xor(bm, 32));
            const float mn = fmaxf(m, bm), corr = __builtin_amdgcn_exp2f(m - mn); m = mn; float ps = 0.f;
#pragma unroll
            for (int kt = 0; kt < 4; ++kt)
#pragma unroll
                for (int r = 0; r < 4; ++r) { const float pv = (s[kt][r] > -1.0e29f) ? __builtin_amdgcn_exp2f(s[kt][r] - mn) : 0.f; s[kt][r] = pv; ps += pv; }
            l = l * corr + ps;
            const h8 pf0 = cvt8(s[0], s[1]), pf1 = cvt8(s[2], s[3]);
            const u16* vb = VST + ((size_t)(g * 256 + blk) * 128 + fr) * 64 + 4 * fq;
#pragma unroll
            for (int dt = 0; dt < 8; ++dt) { const u16* vp = vb + dt * 16 * 64;
                f32x4 a = o[dt] * corr;
                a = mma16(cat44(*(const h4*)vp, *(const h4*)(vp + 16)), pf0, a);
                a = mma16(cat44(*(const h4*)(vp + 32), *(const h4*)(vp + 48)), pf1, a);
                o[dt] = a; }
        }
        l += __shfl_xor(l, 16); l += __shfl_xor(l, 32);
        if (fr < 6) { const float gs = GB[(size_t)t * 36 + (g * 6 + fr) * 3 + 1] / l;
#pragma unroll
            for (int dt = 0; dt < 8; ++dt) { h4* op = (h4*)(XN + (size_t)t * D + (g * 6 + fr) * 128 + dt * 16 + 4 * fq);
                const f32x4 old = __builtin_convertvector(*op, f32x4); *op = cvt4(old + o[dt] * gs); } }
        asm volatile("" ::: "memory");
    }
    VM_WAIT();
    for (int hb = 0; hb < 6 / NSA_NH; ++hb) {
        const int hh0 = g * 6 + hb * NSA_NH; const int t = t0 + fr;
        h8 qf[NSA_NH][4];
        { const float* cp = ROPE + (size_t)t * 64 + fq * 8; const float* sp = cp + (size_t)S * 64;
#pragma unroll
          for (int ks = 0; ks < 2; ++ks) { const f32x4 c0 = *(const f32x4*)(cp + ks * 32), c1 = *(const f32x4*)(cp + ks * 32 + 4), s0 = *(const f32x4*)(sp + ks * 32), s1 = *(const f32x4*)(sp + ks * 32 + 4);
#pragma unroll
              for (int j = 0; j < NSA_NH; ++j) { const h8 qa = *(const h8*)(BOUT + (size_t)t * B_N + (hh0 + j) * 128 + ks * 32 + fq * 8), qb = *(const h8*)(BOUT + (size_t)t * B_N + (hh0 + j) * 128 + (ks + 2) * 32 + fq * 8);
#pragma unroll
                  for (int e = 0; e < 8; ++e) { const float c = e < 4 ? c0[e & 3] : c1[e & 3], s = e < 4 ? s0[e & 3] : s1[e & 3]; const float x1 = (float)qa[e], x2 = (float)qb[e];
                      qf[j][ks][e] = (f16)(x1 * c - x2 * s); qf[j][ks + 2][e] = (f16)(x2 * c + x1 * s); } } } }
        float m[NSA_NH], l[NSA_NH];
#pragma unroll
        for (int j = 0; j < NSA_NH; ++j) { m[j] = NSA_NEG; l[j] = 0.f; }
        f32x4 o[NSA_NH][8];
#pragma unroll
        for (int j = 0; j < NSA_NH; ++j)
#pragma unroll
            for (int dt = 0; dt < 8; ++dt) o[j][dt] = (f32x4){0.f, 0.f, 0.f, 0.f};
        const int klo = (t0 - 511 > 0 ? t0 - 511 : 0) & ~31;
        for (int kp = klo; kp <= t0 + 15; kp += 32) {
            f32x4 p[NSA_NH][2];
#pragma unroll
            for (int k2 = 0; k2 < 2; ++k2) { h8 kf[4];
#pragma unroll
                for (int ks = 0; ks < 4; ++ks) kf[ks] = *(const h8*)(KVRAW + (size_t)(kp + k2 * 16 + fr) * KVW + 1024 + g * 128 + ks * 32 + fq * 8);
                const int k0 = kp + k2 * 16 + 4 * fq;
#pragma unroll
                for (int j = 0; j < NSA_NH; ++j) { f32x4 s = {0.f, 0.f, 0.f, 0.f};
#pragma unroll
                    for (int ks = 0; ks < 4; ++ks) s = mma16(kf[ks], qf[j][ks], s);
#pragma unroll
                    for (int r = 0; r < 4; ++r) s[r] = (k0 + r <= t && k0 + r > t - 512) ? s[r] * sc2 : NSA_NEG;
                    p[j][k2] = s; } }
            h8 pf[NSA_NH];
#pragma unroll
            for (int j = 0; j < NSA_NH; ++j) { float bm = NSA_NEG;
#pragma unroll
                for (int k2 = 0; k2 < 2; ++k2)
#pragma unroll
                    for (int r = 0; r < 4; ++r) bm = fmaxf(bm, p[j][k2][r]);
                bm = fmaxf(bm, __shfl_xor(bm, 16)); bm = fmaxf(bm, __shfl_xor(bm, 32));
                const float mn = fmaxf(m[j], bm), corr = __builtin_amdgcn_exp2f(m[j] - mn); m[j] = mn; float ps = 0.f;
#pragma unroll
                for (int k2 = 0; k2 < 2; ++k2)
#pragma unroll
                    for (int r = 0; r < 4; ++r) { const float pv = (p[j][k2][r] > -1.0e29f) ? __builtin_amdgcn_exp2f(p[j][k2][r] - mn) : 0.f; p[j][k2][r] = pv; ps += pv; }
                l[j] = l[j] * corr + ps; pf[j] = cvt8(p[j][0], p[j][1]);
#pragma unroll
                for (int dt = 0; dt < 8; ++dt) o[j][dt] = o[j][dt] * corr; }
#pragma unroll
            for (int dt = 0; dt < 8; ++dt) { const u16* vp = VWT + ((size_t)g * 128 + dt * 16 + fr) * S + kp + 4 * fq;
                const h8 vf = cat44(*(const h4*)vp, *(const h4*)(vp + 16));
#pragma unroll
                for (int j = 0; j < NSA_NH; ++j) o[j][dt] = mma16(vf, pf[j], o[j][dt]); }
        }
#pragma unroll
        for (int j = 0; j < NSA_NH; ++j) { float lt = l[j]; lt += __shfl_xor(lt, 16); lt += __shfl_xor(lt, 32);
            const float gwv = GB[(size_t)t * 36 + (hh0 + j) * 3 + 2] / lt;
#pragma unroll
            for (int dt = 0; dt < 8; ++dt) { h4* op = (h4*)(XN + (size_t)t * D + (hh0 + j) * 128 + dt * 16 + 4 * fq);
                const f32x4 old = __builtin_convertvector(*op, f32x4); *op = cvt4(old + o[j][dt] * gwv); } }
        asm volatile("" ::: "memory");
    }
}

struct Args { const float* in[19]; float* out; unsigned char* ws; int ph_lo, ph_hi, li, pad; };
typedef const Args __attribute__((address_space(4))) CArgs;
#define I_X 0
#define I_MEM 1
#define I_NG 2
#define I_WG 3
#define I_WU 4
#define I_WDN 5
#define I_MEMNORM 6
#define I_MEMWKV 7
#define I_WOUT 8
#define I_AWIN 9
#define I_AGB 10
#define I_AHN 11
#define I_KVN 12
#define I_WKV 13
#define I_CPOS 14
#define I_CW1 15
#define I_CW2 16
#define I_BWIN 17
#define I_BGB 18
#define WSP(T, off) ((T*)(ws + (off)))


struct Ctx { LAS unsigned char* lds; unsigned char* ws0; int G, lo, hi; XcdBarrier bar; };
#define PH_BEGIN if (lo <= ph && ph < hi) { \
        int tid = (int)threadIdx.x; asm volatile("" : "+v"(tid)); \
        const int lane = tid & 63, wave = __builtin_amdgcn_readfirstlane(tid >> 6); \
        const int gw = (int)blockIdx.x * NWAVES + wave, NGW = G * NWAVES; \
        CArgs* ap = (CArgs*)__builtin_amdgcn_kernarg_segment_ptr(); asm volatile("" : "+s"(ap)); \
        unsigned char* ws = ap->ws; (void)lane; (void)gw; (void)NGW; (void)ws;
#define PH_END   if (ph + 1 < hi) { if (MK_PER_PHASE) { if (threadIdx.x == 0) __hip_atomic_store((gu32*)(ws0 + WS_CTL) + CW_TMO, 0xBADBA0u, RLX_AGENT); } else xcd_barrier(bar); } } ++ph;


template <int F> __device__ __forceinline__ void ffn_stage(const Ctx& cx, int& ph) {
    LAS unsigned char* const lds = cx.lds; unsigned char* const ws0 = cx.ws0; const int G = cx.G, lo = cx.lo, hi = cx.hi; const XcdBarrier bar = cx.bar;
        constexpr int f = F; constexpr int layer = F >> 1;
        PH_BEGIN
        {
            pg8::Gemm g{WSP(u16, WS_XN), WSP(u16, WS_WGU) + (size_t)f * 2 * FF * D, S, 2 * FF, D, D, D}; pg8::StaticOrder So; So.init(S, 2 * FF, G, (int)blockIdx.x);
            pg8::EpiSwiGLU E{WSP(u16, WS_H), FF};
            pg8::gemm_phase<pg8::EpiSwiGLU, pg8::StaticOrder, true, true, false>(lds + RING_OFF, g, So, E, tid);
            if constexpr (F == 0) {
                const int l = (blockIdx.x >> 2) & 1;
                pg8::Gemm g2{WSP(u16, WS_MEMN) + (size_t)l * MEM_LEN * D, WSP(u16, WS_WMKV) + (size_t)l * 1024 * D, 256, 1024, D, D, D}; pg8::StaticOrder S2; S2.init(256, 1024, G, blockIdx.x < 8 ? (int)(blockIdx.x & 3) : 1 << 20);
                pg8::EpiF16<0> E2{WSP(u16, WS_MEMKV) + (size_t)l * MEM_LEN * 1024, 1024, nullptr};
                pg8::gemm_phase<pg8::EpiF16<0>, pg8::StaticOrder, true, true, false>(lds + RING_OFF, g2, S2, E2, tid);
            }
            if constexpr (F == 2) {
                const float* ROPE = WSP(float, WS_ROPE);
                for (int e = blockIdx.x * 512 + tid; e < S * 256; e += G * 512) { const int t = e >> 8, r = e & 255, cc = (r >> 7) ? 4 : 2, gg = (r >> 6) & 1, i = r & 63;
                    u16* p = WSP(u16, WS_KVRAW) + (size_t)t * KVW + cc * 256 + gg * 128 + i; const float x1 = (float)*(f16*)p, x2 = (float)*(f16*)(p + 64);
                    const float c = ROPE[t * 64 + i], s = ROPE[S * 64 + t * 64 + i];
                    *(f16*)p = (f16)(x1 * c - x2 * s); *(f16*)(p + 64) = (f16)(x2 * c + x1 * s); }
                const int idx = (blockIdx.x >> 2) & 3, c = idx >> 1, gg = idx & 1;
                pg8::Gemm g3{WSP(u16, WS_KVRAW) + c * 256 + gg * 128, WSP(u16, WS_WC1) + (size_t)c * 256 * 4096, 1024, 256, 4096, 16 * KVW, 4096}; pg8::StaticOrder S3; S3.init(1024, 256, G, blockIdx.x < 16 ? (int)(blockIdx.x & 3) : 1 << 20);
                pg8::EpiF16<1> E3{WSP(u16, WS_CMPH) + (size_t)idx * 1024 * 256, 256, WSP(float, WS_CB1) + c * 256};
                pg8::gemm_phase<pg8::EpiF16<1>, pg8::StaticOrder, true, true, true>(lds + RING_OFF, g3, S3, E3, tid);
            }
        }
        PH_END
        PH_BEGIN
        {
            pg8::Gemm g{WSP(u16, WS_H), WSP(u16, WS_WD) + (size_t)f * D * FF, S, D, FF, FF, FF}; pg8::StaticOrder So; So.init(S, D, G, (int)blockIdx.x);
            pg8::EpiF32 E{WSP(float, WS_Y), D};
            pg8::gemm_phase<pg8::EpiF32, pg8::StaticOrder, true, true, false>(lds + RING_OFF, g, So, E, tid);
            if constexpr (F == 2) {
                for (int e = blockIdx.x * 512 + tid; e < 4 * 1024 * 128; e += G * 512) { const int idx = e >> 17, n = (e >> 7) & 1023, d = e & 127, c = idx >> 1;
                    const h8* hr = (const h8*)(WSP(u16, WS_CMPH) + ((size_t)idx * 1024 + n) * 256); const h8* wr = (const h8*)(WSP(u16, WS_WC2) + ((size_t)c * 128 + d) * 256); float a = 0.f;
                    for (int k = 0; k < 32; ++k) { const h8 hv = hr[k], wv = wr[k];
#pragma unroll
                        for (int j = 0; j < 8; ++j) a += (float)hv[j] * (float)wv[j]; }
                    if (c == 0) *(f16*)(WSP(u16, WS_KVC) + (size_t)e) = (f16)a;
                    else *(f16*)(WSP(u16, WS_KVC) + (size_t)2 * 1024 * 128 + ((size_t)(idx & 1) * 128 + d) * 1024 + n) = (f16)a; }
            }
        }
        PH_END
        PH_BEGIN
        {
            const float* gl = ap->in[I_NG] + (size_t)layer * 6 * D;
            const float* gpost = gl + (size_t)((f & 1) ? 5 : 1) * D;
            float* X = ap->out; const float* Y = WSP(float, WS_Y);
            if constexpr (F == 0)      thin_rows<8>(Y, 0.5f, gpost, ap->in[I_X], X, gl + 2 * D, WSP(u16, WS_XN), nullptr, nullptr, WSP(float, WS_WGA), ap->in[I_AGB], WSP(float, WS_GA), false, gw, NGW, lane);
            else if constexpr (F == 1) thin_rows<0>(Y, 0.5f, gpost, X, X, ap->in[I_NG] + (size_t)6 * D, WSP(u16, WS_XN), ap->in[I_KVN], WSP(u16, WS_XKV), nullptr, nullptr, nullptr, false, gw, NGW, lane);
            else if constexpr (F == 2) thin_rows<36>(Y, 0.5f, gpost, X, X, gl + 2 * D, WSP(u16, WS_XN), nullptr, nullptr, WSP(float, WS_WGB), ap->in[I_BGB], WSP(float, WS_GB), true, gw, NGW, lane);
            else             thin_rows<0>(Y, 0.5f, gpost, X, X, nullptr, nullptr, nullptr, nullptr, nullptr, nullptr, nullptr, false, gw, NGW, lane);
        }
        PH_END

        if constexpr (F == 1) {
            PH_BEGIN
            {
                pg8::Gemm g{WSP(u16, WS_XKV), WSP(u16, WS_WKV), S, KVW, D, D, D}; pg8::StaticOrder So; So.init(S, KVW, G, (int)blockIdx.x);
                pg8::EpiF16<0> E{WSP(u16, WS_KVRAW), KVW, nullptr};
                pg8::gemm_phase<pg8::EpiF16<0>, pg8::StaticOrder, true, true, false>(lds + RING_OFF, g, So, E, tid);
                for (int e = blockIdx.x * 512 + tid; e < 32 * KVW / 2; e += G * 512) WSP(unsigned, WS_KVRAW)[(size_t)S * KVW / 2 + e] = 0u;
            }
            PH_END
        }
        if constexpr (F == 0 || F == 2) {
            constexpr bool isA = (F == 0);
            PH_BEGIN
            {
                const int ldq = isA ? A_N : B_N;
                pg8::Gemm g{WSP(u16, WS_XN), isA ? WSP(u16, WS_WAIN) : WSP(u16, WS_WBIN), S, ldq, D, D, D}; pg8::StaticOrder So; So.init(S, ldq, G, (int)blockIdx.x);
                pg8::EpiF16<0> E{isA ? WSP(u16, WS_AOUT) : WSP(u16, WS_BOUT), ldq, nullptr};
                pg8::gemm_phase<pg8::EpiF16<0>, pg8::StaticOrder, true, true, false>(lds + RING_OFF, g, So, E, tid);
                if constexpr (!isA) {
                    const u16* KVRAW = WSP(u16, WS_KVRAW);
                    for (int e = blockIdx.x * 512 + tid; e < 2 * 256 * 8 * 128; e += G * 512) { const int d = e & 127, k8 = (e >> 7) & 7, blk = (e >> 10) & 255, gg = e >> 18; h8 o;
#pragma unroll
                        for (int j = 0; j < 8; ++j) o[j] = *(const f16*)(KVRAW + (size_t)(blk * 64 + k8 * 8 + j) * KVW + 768 + gg * 128 + d);
                        *(h8*)(WSP(u16, WS_VST) + ((size_t)(gg * 256 + blk) * 128 + d) * 64 + k8 * 8) = o; }
                    for (int e = blockIdx.x * 512 + tid; e < 2 * 2048 * 128; e += G * 512) { const int d = e & 127, t8 = (e >> 7) & 2047, gg = e >> 18; h8 o;
#pragma unroll
                        for (int j = 0; j < 8; ++j) o[j] = *(const f16*)(KVRAW + (size_t)(t8 * 8 + j) * KVW + 1280 + gg * 128 + d);
                        *(h8*)(WSP(u16, WS_VWT) + ((size_t)gg * 128 + d) * S + t8 * 8) = o; }
                }
            }
            PH_END
            if constexpr (isA) {
                PH_BEGIN
                {
                    const u16* AOUT = WSP(u16, WS_AOUT); const float* GA = WSP(float, WS_GA); u16* CT = WSP(u16, WS_CT);
                    mem_attn_mfma(AOUT, A_N, 4608, WSP(u16, WS_MEMKV), WSP(u16, WS_XN), lds + RING_OFF, tid, G);
                    const int fr = lane & 15, fq = lane >> 4;
                    LAS f16* KT = (LAS f16*)(lds + RING_OFF);
                    LAS f16* VT = (LAS f16*)(lds + RING_OFF + 27648);
                    LAS float* fv = (LAS float*)(lds + RING_OFF + 27648 + 55296);
                    for (int u = blockIdx.x; u < ML_H * ML_NC; u += G) {
                        const int h = u >> 8, c = u & 255, t0 = c * ML_L;
                        __syncthreads();
                        if (tid < 64) { const int t = t0 + tid; fv[tid] = log_sigmoidf_(GA[(size_t)t * 8 + 4 + h]); fv[64 + tid] = GA[(size_t)t * 8 + h]; }
                        __syncthreads();
                        if (tid == 0) { float b = 0.f; for (int s = 0; s < 64; ++s) { b += fv[s]; fv[s] = b; }
                            const float b63 = b; float ml = -3.0e38f; for (int s = 0; s < 64; ++s) ml = fmaxf(ml, b63 - fv[s] + fv[64 + s]);
                            fv[192] = b63; fv[193] = ml; WSP(float, WS_B63)[u] = b63; WSP(float, WS_MLOC)[u] = ml; }
                        __syncthreads();
                        if (tid < 64) fv[128 + tid] = __expf(fv[192] - fv[tid] + fv[64 + tid] - fv[193]);
                        __syncthreads();
                        for (int e = tid; e < 64 * 24; e += 512) { const int s = e & 63, cc = e >> 6; const float wsc = fv[128 + s];
                            const h8 kv = *(const h8*)(AOUT + (size_t)(t0 + s) * A_N + 768 + h * 192 + cc * 8);
#pragma unroll
                            for (int j = 0; j < 8; ++j) KT[(cc * 8 + j) * 72 + s] = (f16)((float)kv[j] * wsc); }
                        for (int e = tid; e < 64 * 48; e += 512) { const int s = e & 63, cc = e >> 6;
                            const h8 vv = *(const h8*)(AOUT + (size_t)(t0 + s) * A_N + 1536 + h * 384 + cc * 8);
#pragma unroll
                            for (int j = 0; j < 8; ++j) VT[(cc * 8 + j) * 72 + s] = vv[j]; }
                        __syncthreads();
                        h8 bf[3][2];
#pragma unroll
                        for (int vi = 0; vi < 3; ++vi)
#pragma unroll
                            for (int ks = 0; ks < 2; ++ks) bf[vi][ks] = *(const LAS h8*)(VT + ((wave * 3 + vi) * 16 + fr) * 72 + ks * 32 + fq * 8);
                        u16* ctu = CT + (size_t)u * ML_DV * ML_DQK;
#pragma unroll 2
                        for (int di = 0; di < 12; ++di) {
                            const h8 a0 = *(const LAS h8*)(KT + (di * 16 + fr) * 72 + fq * 8), a1 = *(const LAS h8*)(KT + (di * 16 + fr) * 72 + 32 + fq * 8);
#pragma unroll
                            for (int vi = 0; vi < 3; ++vi) { f32x4 acc = {0.f, 0.f, 0.f, 0.f}; acc = mma16(a0, bf[vi][0], acc); acc = mma16(a1, bf[vi][1], acc);
                                *(h4*)(ctu + (size_t)((wave * 3 + vi) * 16 + fr) * ML_DQK + di * 16 + 4 * fq) = cvt4(acc); } }
                        if (tid < ML_DQK) { float a = 0.f; for (int s = 0; s < 64; ++s) a += (float)KT[tid * 72 + s]; WSP(float, WS_DN)[(size_t)u * ML_DQK + tid] = a; }
                    }
                }
                PH_END
                PH_BEGIN
                {
                    const float* B63 = WSP(float, WS_B63); const float* MLOC = WSP(float, WS_MLOC);
                    LAS float* dec = (LAS float*)(lds + RING_OFF); LAS float* scl = dec + 256;
                    constexpr int PER_HEAD = ML_DV * ML_DQK / 2;
                    for (int e0 = blockIdx.x * 512; e0 < ML_H * PER_HEAD; e0 += G * 512) {
                        const int h = e0 / PER_HEAD;
                        __syncthreads();
                        if (tid == 0) { float m = 0.f; for (int c = 0; c < ML_NC; ++c) { const float b63 = B63[h * 256 + c], ml = MLOC[h * 256 + c]; const float mn = fmaxf(ml, b63 + m);
                                dec[c] = __expf(b63 + m - mn); scl[c] = __expf(ml - mn); if (e0 % PER_HEAD == 0) WSP(float, WS_MST)[h * 256 + c] = m; m = mn; } }
                        __syncthreads();
                        unsigned* p = WSP(unsigned, WS_CT) + (size_t)h * ML_NC * PER_HEAD + (e0 - h * PER_HEAD) + tid;
                        float c0 = 0.f, c1 = 0.f;
                        for (int c = 0; c < ML_NC; c += 8) { unsigned dv[8];
#pragma unroll
                            for (int j = 0; j < 8; ++j) dv[j] = p[(size_t)(c + j) * PER_HEAD];
#pragma unroll
                            for (int j = 0; j < 8; ++j) { const h2 d2 = __builtin_bit_cast(h2, dv[j]); p[(size_t)(c + j) * PER_HEAD] = pkh(c0, c1);
                                c0 = dec[c + j] * c0 + scl[c + j] * (float)d2[0]; c1 = dec[c + j] * c1 + scl[c + j] * (float)d2[1]; } }
                    }
                    if (blockIdx.x < ML_H) { const int h = blockIdx.x;
                        __syncthreads();
                        if (tid == 0) { float m = 0.f; for (int c = 0; c < ML_NC; ++c) { const float b63 = B63[h * 256 + c], ml = MLOC[h * 256 + c]; const float mn = fmaxf(ml, b63 + m);
                                dec[c] = __expf(b63 + m - mn); scl[c] = __expf(ml - mn); m = mn; } }
                        __syncthreads();
                        if (tid < ML_DQK) { float n = 0.f; for (int c = 0; c < ML_NC; ++c) { float* q = WSP(float, WS_DN) + ((size_t)h * 256 + c) * ML_DQK + tid; const float d = *q; *q = n; n = dec[c] * n + scl[c] * d; } }
                    }
                }
                PH_END
                PH_BEGIN
                {
                    const u16* AOUT = WSP(u16, WS_AOUT); const float* GA = WSP(float, WS_GA); u16* XN = WSP(u16, WS_XN);
                    const int fr = lane & 15, fq = lane >> 4;
                    LAS f16* Qs = (LAS f16*)(lds + RING_OFF);
                    LAS f16* Ks = (LAS f16*)(lds + RING_OFF + 25600);
                    LAS f16* VT = (LAS f16*)(lds + RING_OFF + 51200);
                    LAS f16* Sm = (LAS f16*)(lds + RING_OFF + 106496);
                    LAS float* fv = (LAS float*)(lds + RING_OFF + 115712);
                    for (int u = blockIdx.x; u < ML_H * ML_NC; u += G) {
                        const int h = u >> 8, c = u & 255, t0 = c * ML_L;
                        __syncthreads();
                        if (tid < 64) { const int t = t0 + tid; fv[tid] = log_sigmoidf_(GA[(size_t)t * 8 + 4 + h]); fv[64 + tid] = GA[(size_t)t * 8 + h]; fv[320 + tid] = 0.f; }
                        for (int e = tid; e < 64 * 24; e += 512) { const int s = e / 24, cc = e % 24;
                            *(LAS h8*)(Qs + s * 200 + cc * 8) = *(const h8*)(AOUT + (size_t)(t0 + s) * A_N + h * 192 + cc * 8);
                            *(LAS h8*)(Ks + s * 200 + cc * 8) = *(const h8*)(AOUT + (size_t)(t0 + s) * A_N + 768 + h * 192 + cc * 8); }
                        for (int e = tid; e < 64 * 48; e += 512) { const int s = e & 63, cc = e >> 6;
                            const h8 vv = *(const h8*)(AOUT + (size_t)(t0 + s) * A_N + 1536 + h * 384 + cc * 8);
#pragma unroll
                            for (int j = 0; j < 8; ++j) VT[(cc * 8 + j) * 72 + s] = vv[j]; }
                        __syncthreads();
                        const float mc = WSP(float, WS_MST)[u];
                        if (tid == 0) { float b = 0.f, pm = -3.0e38f; for (int s = 0; s < 64; ++s) { b += fv[s]; fv[s] = b; const float a = fv[64 + s] - b; fv[64 + s] = a; pm = fmaxf(pm, a);
                                const float mx = fmaxf(pm, mc); fv[128 + s] = mx; fv[192 + s] = __expf(mc - mx); } }
                        __syncthreads();
#pragma unroll
                        for (int q2 = 0; q2 < 2; ++q2) { const int tl = wave * 2 + q2, si = tl >> 2, tj = tl & 3; f32x4 acc = {0.f, 0.f, 0.f, 0.f};
#pragma unroll
                            for (int ks = 0; ks < 6; ++ks) acc = mma16(*(const LAS h8*)(Ks + (si * 16 + fr) * 200 + ks * 32 + fq * 8), *(const LAS h8*)(Qs + (tj * 16 + fr) * 200 + ks * 32 + fq * 8), acc);
                            const int t = tj * 16 + fr; const float mxt = fv[128 + t];
#pragma unroll
                            for (int r = 0; r < 4; ++r) { const int sx = si * 16 + 4 * fq + r; acc[r] = (sx <= t) ? acc[r] * __expf(fv[64 + sx] - mxt) : 0.f; }
                            *(LAS h4*)(Sm + t * 72 + si * 16 + 4 * fq) = cvt4(acc); }
                        __syncthreads();
                        if (tid < 64) { const int t = tid; float den = 0.f; for (int s = 0; s < 64; ++s) den += (float)Sm[t * 72 + s];
                            float qn = 0.f; const float* np = WSP(float, WS_DN) + (size_t)u * ML_DQK; for (int d = 0; d < ML_DQK; ++d) qn += (float)Qs[t * 200 + d] * np[d];
                            den += fv[192 + t] * qn; const float mvec = fv[t] + fv[128 + t];
                            fv[256 + t] = fmaxf(fabsf(den), __expf(-mvec)); }
                        __syncthreads();
                        const int tj = wave & 3, vh = wave >> 2, tt = tj * 16 + fr;
                        h8 bS[2], bQ[6];
#pragma unroll
                        for (int ks = 0; ks < 2; ++ks) bS[ks] = *(const LAS h8*)(Sm + tt * 72 + ks * 32 + fq * 8);
#pragma unroll
                        for (int ks = 0; ks < 6; ++ks) bQ[ks] = *(const LAS h8*)(Qs + tt * 200 + ks * 32 + fq * 8);
                        const u16* ctp = WSP(u16, WS_CT) + (size_t)u * ML_DV * ML_DQK;
                        const float inter = fv[192 + tt], idn = 1.0f / fv[256 + tt];
                        h4 hv[12]; float ssq = 0.f;
#pragma unroll
                        for (int vi = 0; vi < 12; ++vi) { const int vt = vh * 12 + vi; f32x4 a1 = {0.f, 0.f, 0.f, 0.f}, a2 = {0.f, 0.f, 0.f, 0.f};
#pragma unroll
                            for (int ks = 0; ks < 2; ++ks) a1 = mma16(*(const LAS h8*)(VT + (vt * 16 + fr) * 72 + ks * 32 + fq * 8), bS[ks], a1);
#pragma unroll
                            for (int ks = 0; ks < 6; ++ks) a2 = mma16(*(const h8*)(ctp + (size_t)(vt * 16 + fr) * ML_DQK + ks * 32 + fq * 8), bQ[ks], a2);
                            const f32x4 hx = (a1 + a2 * inter) * idn; hv[vi] = cvt4(hx); ssq += (hx[0] * hx[0] + hx[1] * hx[1]) + (hx[2] * hx[2] + hx[3] * hx[3]); asm volatile("" ::: "memory"); }
                        ssq += __shfl_xor(ssq, 16); ssq += __shfl_xor(ssq, 32);
                        if (fq == 0) atomicAdd((float*)(fv + 320 + tt), ssq);
                        __syncthreads();
                        const float rn = rsqrtf(fv[320 + tt] * (1.0f / ML_DV) + EPS);
#pragma unroll
                        for (int vi = 0; vi < 12; ++vi) { const int v0 = (vh * 12 + vi) * 16 + 4 * fq;
                            const h4 og = *(const h4*)(AOUT + (size_t)(t0 + tt) * A_N + 3072 + h * ML_DV + v0); const f32x4 hn = *(const f32x4*)(ap->in[I_AHN] + h * ML_DV + v0); f32x4 o;
#pragma unroll
                            for (int r = 0; r < 4; ++r) o[r] = (float)hv[vi][r] * rn * hn[r] * sigmoidf_((float)og[r]);
                            *(h4*)(XN + (size_t)(t0 + tt) * D + h * ML_DV + v0) = cvt4(o); asm volatile("" ::: "memory"); }
                    }
                }
                PH_END
            } else {
                PH_BEGIN
                {
                    const u16* BOUT = WSP(u16, WS_BOUT); u16* XN = WSP(u16, WS_XN);
                    mem_attn_mfma(BOUT, B_N, 1536, WSP(u16, WS_MEMKV) + (size_t)MEM_LEN * 1024, XN, lds + RING_OFF, tid, G);
                    LAS float* psl = (LAS float*)(lds + RING_OFF + wave * WAVE_LDS); LAS int* sel = (LAS int*)(psl + 4096);
                    for (int item = gw; item < (S / 16) * 2; item += NGW)
                        nsa_item((item >> 1) * 16, item & 1, BOUT, WSP(u16, WS_KVRAW), WSP(u16, WS_KVC), WSP(u16, WS_KVC) + (size_t)2 * 1024 * 128, WSP(u16, WS_VST), WSP(u16, WS_VWT),
                                 WSP(float, WS_GB), WSP(float, WS_ROPE), XN, psl, sel, lane);
                }
                PH_END
            }
            PH_BEGIN
            {
                pg8::Gemm g{WSP(u16, WS_XN), WSP(u16, WS_WOUT) + (size_t)layer * D * D, S, D, D, D, D}; pg8::StaticOrder So; So.init(S, D, G, (int)blockIdx.x);
                pg8::EpiF32 E{WSP(float, WS_Y), D};
                pg8::gemm_phase<pg8::EpiF32, pg8::StaticOrder, true, true, false>(lds + RING_OFF, g, So, E, tid);
            }
            PH_END
            PH_BEGIN
            {
                const float* gl = ap->in[I_NG] + (size_t)layer * 6 * D; float* X = ap->out;
                thin_rows<0>(WSP(float, WS_Y), 1.0f, gl + 3 * D, X, X, gl + 4 * D, WSP(u16, WS_XN), nullptr, nullptr, nullptr, nullptr, nullptr, false, gw, NGW, lane);
            }
            PH_END
        }

}

__global__ void __launch_bounds__(NWAVES * 64, 2) yoco_fwd(Args args) {
    extern __shared__ __attribute__((aligned(16))) unsigned char lds_raw[];
    LAS unsigned char* lds = (LAS unsigned char*)lds_raw;
    const int G = gridDim.x;
    { volatile LAS unsigned* MISC0 = (volatile LAS unsigned*)(lds + LDSCTL_OFF);
      for (int u = threadIdx.x; u < LDSCTL_BYTES / 4; u += NWAVES * 64) MISC0[u] = 0u; }
    __syncthreads();
    XcdBarrier bar; bar.bar = (unsigned*)(args.ws + WS_CTL) + CW_BAR; bar.x = 0; bar.st = nullptr;
    if (!MK_PER_PHASE) bar = xcd_barrier_post((unsigned*)(args.ws + WS_CTL) + CW_BAR, (volatile LAS unsigned*)(lds + MISC_OFF) + 8);

    const int lo = args.ph_lo, hi = args.ph_hi; unsigned char* const ws0 = args.ws;
    int ph = 0;
    PH_BEGIN
    {
        LAS float* scr = (LAS float*)(lds + RING_OFF + wave * 16384);
        constexpr int J_FF = 5632;
        constexpr int J_AIN = 32 * 160, J_WOUT = 2048, J_WKVI = 32 * 48, J_BIN = 2048, J_MKV = 1024, J_C1 = 512, J_C2 = 16;
        constexpr int NIT = 12 * J_FF + J_AIN + 2 * J_WOUT + J_WKVI + J_BIN + 2 * J_MKV + 2 * J_C1 + 2 * J_C2;
        for (int it = gw; it < NIT; it += NGW) {
            int r = it;
            if (r < 12 * J_FF) { const int job = r / J_FF, idx = job / 3, kind = job % 3; r -= job * J_FF;
                if (kind < 2) { const int nblk = FF / 32, kb = r / nblk, nb = r % nblk, n0 = nb * 32;
                    cvt_item(ap->in[kind == 0 ? I_WG : I_WU] + (size_t)idx * D * FF, FF, n0, kb * 64, WSP(u16, WS_WGU) + (size_t)idx * 2 * FF * D, D, 256 * (n0 >> 7) + (n0 & 127) + (kind ? 128 : 0), 1.0f, scr, lane); }
                else { const int nblk = D / 32, kb = r / nblk, nb = r % nblk;
                    cvt_item(ap->in[I_WDN] + (size_t)idx * FF * D, D, nb * 32, kb * 64, WSP(u16, WS_WD) + (size_t)idx * D * FF, FF, nb * 32, 1.0f, scr, lane); }
                continue; }
            r -= 12 * J_FF;
            if (r < J_AIN) { const int nblk = A_N / 32, kb = r / nblk, nb = r % nblk, n0 = nb * 32;
                cvt_item(ap->in[I_AWIN], A_INW, n0 < 4608 ? n0 : n0 + 8, kb * 64, WSP(u16, WS_WAIN), D, n0, (n0 >= 768 && n0 < 1536) ? 0.07216878364870322f : 1.0f, scr, lane); continue; }
            r -= J_AIN;
            if (r < 2 * J_WOUT) { const int l = r / J_WOUT; r -= l * J_WOUT; const int nblk = D / 32, kb = r / nblk, nb = r % nblk;
                cvt_item(ap->in[I_WOUT] + (size_t)l * D * D, D, nb * 32, kb * 64, WSP(u16, WS_WOUT) + (size_t)l * D * D, D, nb * 32, 1.0f, scr, lane); continue; }
            r -= 2 * J_WOUT;
            if (r < J_WKVI) { const int nblk = KVW / 32, kb = r / nblk, nb = r % nblk;
                cvt_item(ap->in[I_WKV], KVW, nb * 32, kb * 64, WSP(u16, WS_WKV), D, nb * 32, 1.0f, scr, lane); continue; }
            r -= J_WKVI;
            if (r < J_BIN) { const int nblk = B_N / 32, kb = r / nblk, nb = r % nblk, n0 = nb * 32;
                cvt_item(ap->in[I_BWIN], B_INW, n0 < 1536 ? n0 : n0 + 36, kb * 64, WSP(u16, WS_WBIN), D, n0, 1.0f, scr, lane); continue; }
            r -= J_BIN;
            if (r < 2 * J_MKV) { const int l = r / J_MKV; r -= l * J_MKV; const int nblk = 1024 / 32, kb = r / nblk, nb = r % nblk;
                cvt_item(ap->in[I_MEMWKV] + (size_t)l * D * 1024, 1024, nb * 32, kb * 64, WSP(u16, WS_WMKV) + (size_t)l * 1024 * D, D, nb * 32, 1.0f, scr, lane); continue; }
            r -= 2 * J_MKV;
            if (r < 2 * J_C1) { const int c = r / J_C1; r -= c * J_C1; const int nblk = 256 / 32, kb = r / nblk, nb = r % nblk;
                cvt_item(ap->in[I_CW1] + (size_t)c * 4096 * 256, 256, nb * 32, kb * 64, WSP(u16, WS_WC1) + (size_t)c * 256 * 4096, 4096, nb * 32, 1.0f, scr, lane); continue; }
            r -= 2 * J_C1;
            { const int c = r / J_C2; r -= c * J_C2; const int nblk = 128 / 32, kb = r / nblk, nb = r % nblk;
                cvt_item(ap->in[I_CW2] + (size_t)c * 256 * 128, 128, nb * 32, kb * 64, WSP(u16, WS_WC2) + (size_t)c * 128 * 256, 256, nb * 32, 1.0f, scr, lane); }
        }
        for (int it = gw; it < 2 * MEM_LEN; it += NGW) { const int l = it >> 8, m = it & 255;
            const GAS f32x4* xr = (const GAS f32x4*)(ap->in[I_MEM] + (size_t)m * D) + lane; f32x4 v[8]; float ss = 0.f;
#pragma unroll
            for (int j = 0; j < 8; ++j) { v[j] = xr[64 * j]; ss += (v[j].x * v[j].x + v[j].y * v[j].y) + (v[j].z * v[j].z + v[j].w * v[j].w); }
            const float rr = rsqrtf(wave_sum(ss) * (1.0f / D) + EPS);
            GAS u32x2* o = (GAS u32x2*)(WSP(u16, WS_MEMN) + ((size_t)l * MEM_LEN + m) * D) + lane;
#pragma unroll
            for (int j = 0; j < 8; ++j) { const f32x4 g = ((const GAS f32x4*)(ap->in[I_MEMNORM] + (size_t)l * D))[lane + 64 * j]; const f32x4 w = v[j] * rr * g; u32x2 pk; pk.x = pkh(w.x, w.y); pk.y = pkh(w.z, w.w); o[64 * j] = pk; } }
        for (int e = blockIdx.x * 512 + tid; e < 44 * D; e += G * 512) { const int gi = e / D, k = e % D;
            if (gi < 8) WSP(float, WS_WGA)[gi * D + k] = ap->in[I_AWIN][(size_t)k * A_INW + 4608 + gi]; else WSP(float, WS_WGB)[(gi - 8) * D + k] = ap->in[I_BWIN][(size_t)k * B_INW + 1536 + (gi - 8)]; }
        for (int it = gw; it < 512; it += NGW) { const int c = it >> 8, j = it & 255; float a = 0.f;
            for (int k = lane; k < 4096; k += 64) a += ap->in[I_CPOS][c * 4096 + k] * ap->in[I_CW1][((size_t)c * 4096 + k) * 256 + j];
            a = wave_sum(a); if (lane == 0) WSP(float, WS_CB1)[it] = a; }
        for (int e = blockIdx.x * 512 + tid; e < S * 64; e += G * 512) { const int t = e >> 6, i = e & 63;
            const float inv = exp2f(-(float)(2 * i) * (13.287712379549449f / 128.0f)); const float ang = (float)t * inv;
            const double k = rint((double)ang * 0.15915494309189535); const float rr = (float)((double)ang - k * 6.283185307179586);
            WSP(float, WS_ROPE)[e] = __cosf(rr); WSP(float, WS_ROPE)[S * 64 + e] = __sinf(rr); }
        thin_rows<0>(nullptr, 0.f, nullptr, ap->in[I_X], nullptr, ap->in[I_NG], WSP(u16, WS_XN), nullptr, nullptr, nullptr, nullptr, nullptr, false, gw, NGW, lane);
    }
    PH_END

    Ctx cx; cx.lds = lds; cx.ws0 = ws0; cx.G = G; cx.lo = lo; cx.hi = hi; cx.bar = bar;
    ffn_stage<0>(cx, ph); ffn_stage<1>(cx, ph); ffn_stage<2>(cx, ph); ffn_stage<3>(cx, ph);
}
#undef PH_BEGIN
#undef PH_END


constexpr int N_PHASES = 1 + 4 * 3 + 1 + 2 * 3 + 3 + 1;

extern "C" void kernel_launch(void* const* d_in, const int* in_sizes, int n_in, void* d_out, int out_size, void* d_ws, size_t ws_size, hipStream_t stream) {
    static int grid = 0;
    if (grid == 0) {
        if (n_in != 19 || in_sizes[0] != S * D || out_size != S * D || ws_size < WS_END) { fprintf(stderr, "kernel_launch: unexpected shapes: n_in %d in0 %d out %d ws %zu (need %zu)\n", n_in, n_in > 0 ? in_sizes[0] : -1, out_size, ws_size, (size_t)WS_END); grid = -1; return; }
        int dev = 0, cus = 0, per_cu = 0;
        if (hipGetDevice(&dev) != hipSuccess || hipDeviceGetAttribute(&cus, hipDeviceAttributeMultiprocessorCount, dev) != hipSuccess) { grid = -1; return; }
        if (hipFuncSetAttribute((const void*)yoco_fwd, hipFuncAttributeMaxDynamicSharedMemorySize, LDS_BYTES) != hipSuccess) { fprintf(stderr, "kernel_launch: hipFuncSetAttribute failed\n"); grid = -1; return; }
        if (hipOccupancyMaxActiveBlocksPerMultiprocessor(&per_cu, (const void*)yoco_fwd, NWAVES * 64, LDS_BYTES) != hipSuccess || per_cu < 1) { fprintf(stderr, "kernel_launch: occupancy query reports %d\n", per_cu); (void)hipGetLastError(); grid = -1; return; }
        grid = cus;
    }
    if (grid < 0) return;
    (void)hipMemsetAsync((char*)d_ws + WS_CTL, 0, CTL_ZERO_BYTES, stream);
    Args a{};
    for (int i = 0; i < 19; ++i) a.in[i] = (const float*)d_in[i];
    a.out = (float*)d_out; a.ws = (unsigned char*)d_ws;
#if MK_PER_PHASE
    for (int p = 0; p < N_PHASES; ++p) { a.ph_lo = p; a.ph_hi = p + 1; a.li = p; hipLaunchKernelGGL(yoco_fwd, dim3(grid), dim3(NWAVES * 64), LDS_BYTES, stream, a); }
#else
    a.ph_lo = 0; a.ph_hi = N_PHASES; a.li = 0;
    hipLaunchKernelGGL(yoco_fwd, dim3(grid), dim3(NWAVES * 64), LDS_BYTES, stream, a);
#endif
}
```

```cpp
#include <hip/hip_runtime.h>
#include <cstdio>
#include <cstdint>
#include <type_traits>

#ifndef MK_PER_PHASE
#define MK_PER_PHASE 0
#endif

#ifndef PROBE_MASK
#define PROBE_MASK 0u
#endif
#ifndef PROBE_MULT
#define PROBE_MULT 4
#endif

#define LAS __attribute__((address_space(3)))
#define GAS __attribute__((address_space(1)))
typedef unsigned short u16;
typedef _Float16 f16;
typedef _Float16 h8 __attribute__((ext_vector_type(8)));
typedef _Float16 h4 __attribute__((ext_vector_type(4)));
typedef _Float16 h2 __attribute__((ext_vector_type(2)));
typedef float f32x4 __attribute__((ext_vector_type(4)));
typedef float f32x2 __attribute__((ext_vector_type(2)));
typedef unsigned u32x4 __attribute__((ext_vector_type(4)));
typedef unsigned u32x2 __attribute__((ext_vector_type(2)));

__device__ __forceinline__ int lane_id_v() { int l; asm volatile("v_mbcnt_lo_u32_b32 %0, -1, 0\n\tv_mbcnt_hi_u32_b32 %0, -1, %0" : "=v"(l)); return l; }
__device__ __forceinline__ unsigned pkh(float a, float b) { h2 v = __builtin_convertvector((f32x2){a, b}, h2); return __builtin_bit_cast(unsigned, v); }

namespace pg8 {
#define PG8_LAS __attribute__((address_space(3)))
constexpr int BM = 256, BK = 64, HALF = 128, HTB = HALF * BK * 2, STAGE_BYTES = 8 * HTB, NXCD = 8, WGM = 8;
__host__ __device__ __forceinline__ int lds_byte(int r, int c) { const int st = (r >> 4) * 2 + (c >> 5), rr = r & 15, cc = c & 31, ob = rr * 64 + cc * 2; return st * 1024 + (ob ^ (((ob >> 9) & 1) << 5)); }
__host__ __device__ __forceinline__ void stage_rc(int b, int& R, int& C) { const int st = b / 1024, sb = b % 1024, swz = sb ^ (((sb >> 9) & 1) << 5); R = (st >> 1) * 16 + swz / 64; C = (st & 1) * 32 + (swz % 64) / 2; }
__host__ __device__ __forceinline__ int perm32(int rho) { const int n = rho >> 4, i = rho & 15; return 8 * (i >> 2) + 4 * n + (i & 3); }

struct Unit { int pm, pn; };
struct Gemm { const u16* A; const u16* Bt; int M, N, K, lda, ldb; };

struct StaticOrder {
    int nM, nN, nwg, G, c, wgm;
    __host__ __device__ void init(int M, int N, int G_, int c_, int wgm_ = WGM) { nM = M / BM; nN = N / BM; nwg = nM * nN; G = G_; c = c_; wgm = wgm_; }
    __host__ __device__ bool next(int i, Unit& u) const {
        const long L = (long)i * G + c; if (L >= nwg) return false;
        int wgid = (int)L; { const int q = nwg / NXCD, r = nwg % NXCD, xcd = wgid % NXCD, off = wgid / NXCD; wgid = (xcd < r ? xcd * (q + 1) : r * (q + 1) + (xcd - r) * q) + off; }
        const int nig = wgm * nN, gid = wgid / nig, fm = gid * wgm, gsz = (nM - fm) < wgm ? (nM - fm) : wgm;
        u.pm = fm + ((wgid % nig) % gsz); u.pn = (wgid % nig) / gsz; return true;
    }
    __device__ __forceinline__ void a_ready(const Unit&) const {}
    __device__ __forceinline__ void done(const Unit&) const {}
};

__device__ __forceinline__ float rinv8(const float* rs, int row) { const f32x4 a = *(const f32x4*)(rs + (size_t)row * 8), b = *(const f32x4*)(rs + (size_t)row * 8 + 4);
    return __builtin_amdgcn_rsqf((((a[0] + a[1]) + (a[2] + a[3])) + ((b[0] + b[1]) + (b[2] + b[3]))) * (1.0f / 2048.0f) + 1e-6f); }
template <bool RS> struct EpiF32S {
    static constexpr bool PERM = false, AFTER_DRAIN = false;
    float* C; int ldc; const float* rs;
    __device__ __forceinline__ void operator()(const f32x4 (&acc)[2][2][4][2], const Unit& u, int wr, int wc, int fr, int fq) const {
        const int row0 = u.pm * BM + wr * 64 + fr, col0 = u.pn * BM + wc * 32 + 4 * fq;
#pragma unroll
        for (int ai = 0; ai < 2; ++ai)
#pragma unroll
            for (int m = 0; m < 4; ++m) { float* rowp = C + (size_t)(row0 + ai * HALF + m * 16) * ldc + col0; const float rsv = RS ? rinv8(rs, row0 + ai * HALF + m * 16) : 1.0f;
#pragma unroll
                for (int bj = 0; bj < 2; ++bj)
#pragma unroll
                    for (int n = 0; n < 2; ++n) *(f32x4*)(rowp + bj * HALF + n * 16) = RS ? acc[ai][bj][m][n] * rsv : acc[ai][bj][m][n]; }
    }
};
typedef EpiF32S<false> EpiF32;
__device__ __forceinline__ float gelu_tanh(float x) { const float z = 1.5957691216057308f * (x + 0.044715f * x * x * x); return x * __builtin_amdgcn_rcpf(1.0f + __builtin_amdgcn_exp2f(-1.4426950408889634f * z)); }
template <int ACT, bool RS = false> struct EpiF16 {
    static constexpr bool PERM = true, AFTER_DRAIN = false;
    u16* O; int ldc; const float* bias; const float* rs;
    __device__ __forceinline__ void operator()(const f32x4 (&acc)[2][2][4][2], const Unit& u, int wr, int wc, int fr, int fq) const {
        const int row0 = u.pm * BM + wr * 64 + fr, col0 = u.pn * BM + wc * 32 + 8 * fq;
#pragma unroll
        for (int ai = 0; ai < 2; ++ai)
#pragma unroll
            for (int m = 0; m < 4; ++m) { u16* rowp = O + (size_t)(row0 + ai * HALF + m * 16) * ldc + col0; const float rsv = RS ? rinv8(rs, row0 + ai * HALF + m * 16) : 1.0f;
#pragma unroll
                for (int bj = 0; bj < 2; ++bj) { f32x4 v0 = acc[ai][bj][m][0], v1 = acc[ai][bj][m][1];
                    if (RS) { v0 = v0 * rsv; v1 = v1 * rsv; }
                    if (ACT == 1) { const f32x4 b0 = *(const f32x4*)(bias + col0 + bj * HALF), b1 = *(const f32x4*)(bias + col0 + bj * HALF + 4); v0 = v0 + b0; v1 = v1 + b1;
#pragma unroll
                        for (int j = 0; j < 4; ++j) { v0[j] = gelu_tanh(v0[j]); v1[j] = gelu_tanh(v1[j]); } }
                    u32x4 w; w.x = pkh(v0[0], v0[1]); w.y = pkh(v0[2], v0[3]); w.z = pkh(v1[0], v1[1]); w.w = pkh(v1[2], v1[3]);
                    *(u32x4*)(rowp + bj * HALF) = w; } }
    }
};
struct EpiKV {
    static constexpr bool PERM = true, AFTER_DRAIN = false;
    u16* KV; int ldc; u16* KCS; int rows_pad; const float* rs;
    __device__ __forceinline__ void operator()(const f32x4 (&acc)[2][2][4][2], const Unit& u, int wr, int wc, int fr, int fq) const {
        const int row0 = u.pm * BM + wr * 64 + fr, col0 = u.pn * BM + wc * 32 + 8 * fq;
#pragma unroll
        for (int ai = 0; ai < 2; ++ai)
#pragma unroll
            for (int m = 0; m < 4; ++m) { const int row = row0 + ai * HALF + m * 16; const float rsv = rinv8(rs, row);
#pragma unroll
                for (int bj = 0; bj < 2; ++bj) { const f32x4 v0 = acc[ai][bj][m][0] * rsv, v1 = acc[ai][bj][m][1] * rsv;
                    u32x4 w; w.x = pkh(v0[0], v0[1]); w.y = pkh(v0[2], v0[3]); w.z = pkh(v1[0], v1[1]); w.w = pkh(v1[2], v1[3]);
                    u16* dst = (u.pn < 2) ? KCS + ((size_t)(u.pn * 2 + bj) * rows_pad + row) * 128 + wc * 32 + 8 * fq : KV + (size_t)row * ldc + col0 + bj * HALF;
                    *(u32x4*)dst = w; } }
    }
};
struct EpiSwiGLU {
    static constexpr bool PERM = true, AFTER_DRAIN = false;
    u16* H; int ldh; const float* rs;
    __device__ __forceinline__ void operator()(const f32x4 (&acc)[2][2][4][2], const Unit& u, int wr, int wc, int fr, int fq) const {
        const int row0 = u.pm * BM + wr * 64 + fr, col0 = u.pn * HALF + wc * 32 + 8 * fq;
#pragma unroll
        for (int ai = 0; ai < 2; ++ai)
#pragma unroll
            for (int m = 0; m < 4; ++m) { u16* rowp = H + (size_t)(row0 + ai * HALF + m * 16) * ldh + col0; float o[8]; const float rsv = rinv8(rs, row0 + ai * HALF + m * 16);
#pragma unroll
                for (int n = 0; n < 2; ++n)
#pragma unroll
                    for (int j = 0; j < 4; ++j) { const float g = acc[ai][0][m][n][j] * rsv, up = acc[ai][1][m][n][j] * rsv;
                        o[n * 4 + j] = g * __builtin_amdgcn_rcpf(1.0f + __builtin_amdgcn_exp2f(-1.4426950408889634f * g)) * up; }
                u32x4 w; w.x = pkh(o[0], o[1]); w.y = pkh(o[2], o[3]); w.z = pkh(o[4], o[5]); w.w = pkh(o[6], o[7]);
                *(u32x4*)rowp = w; }
    }
};

__device__ __forceinline__ float qsum4(float x) { float a = x, b = x;
    asm volatile("s_nop 1\n\tv_permlane16_swap_b32 %0, %1\n\tv_add_f32 %0, %0, %1\n\tv_mov_b32 %1, %0\n\ts_nop 1\n\tv_permlane32_swap_b32 %0, %1\n\tv_add_f32 %0, %0, %1" : "+v"(a), "+v"(b)); return a; }
template <bool OUTF32> struct EpiResNorm {
    static constexpr bool PERM = true, AFTER_DRAIN = false;
    const u16* Xin; void* Xout; const float* gpost; float alpha; unsigned* slots; unsigned* cnt; float* rinvp; PG8_LAS unsigned char* tab;
    __device__ __forceinline__ void operator()(const f32x4 (&acc)[2][2][4][2], const Unit& u, int wr, int wc, int fr, int fq) const {
        PG8_LAS float* P = (PG8_LAS float*)tab; PG8_LAS float* Sx = P + 1024;
        const int wid = wr * 4 + wc, lane = fq * 16 + fr, row = wid * 64 + lane;
#pragma unroll
        for (int ai = 0; ai < 2; ++ai)
#pragma unroll
            for (int m = 0; m < 4; ++m) { float q = 0.f;
#pragma unroll
                for (int bj = 0; bj < 2; ++bj)
#pragma unroll
                    for (int n = 0; n < 2; ++n) { const f32x4 v = acc[ai][bj][m][n]; q += (v[0] * v[0] + v[1] * v[1]) + (v[2] * v[2] + v[3] * v[3]); }
                q = qsum4(q);
                if (fq == 0) P[(ai * HALF + wr * 64 + m * 16 + fr) * 4 + wc] = q; }
        asm volatile("s_waitcnt lgkmcnt(0)" ::: "memory"); __builtin_amdgcn_s_barrier(); asm volatile("" ::: "memory");
        if (wid < 4) { const float t = (P[row * 4] + P[row * 4 + 1]) + (P[row * 4 + 2] + P[row * 4 + 3]);
            __hip_atomic_store(slots + (size_t)(u.pm * BM + row) * 8 + u.pn, __builtin_bit_cast(unsigned, t), __ATOMIC_RELAXED, __HIP_MEMORY_SCOPE_AGENT);
            asm volatile("s_waitcnt vmcnt(0)" ::: "memory");
            if (lane == 0) __hip_atomic_fetch_add(cnt + 8 * u.pm, 1u, __ATOMIC_RELAXED, __HIP_MEMORY_SCOPE_AGENT); }
        h8 xv[4][2]; f32x4 gv[2][2];
#pragma unroll
        for (int m = 0; m < 4; ++m)
#pragma unroll
            for (int bj = 0; bj < 2; ++bj) xv[m][bj] = *(const h8*)(Xin + (size_t)(u.pm * BM + wr * 64 + m * 16 + fr) * 2048 + (u.pn * BM + bj * HALF + wc * 32 + 8 * fq));
#pragma unroll
        for (int bj = 0; bj < 2; ++bj) { gv[bj][0] = *(const f32x4*)(gpost + u.pn * BM + bj * HALF + wc * 32 + 8 * fq); gv[bj][1] = *(const f32x4*)(gpost + u.pn * BM + bj * HALF + wc * 32 + 8 * fq + 4); }
        if (wid == 0) { unsigned sp = 0;
            while ((unsigned)__builtin_amdgcn_readfirstlane(__hip_atomic_load(cnt + 8 * u.pm, __ATOMIC_RELAXED, __HIP_MEMORY_SCOPE_AGENT)) < 32u) { __builtin_amdgcn_s_sleep(2); if (++sp > (1u << 19)) break; }
            __builtin_amdgcn_fence(__ATOMIC_ACQUIRE, "agent");
            asm volatile("s_waitcnt vmcnt(0)" ::: "memory"); }
        asm volatile("s_waitcnt lgkmcnt(0)" ::: "memory"); __builtin_amdgcn_s_barrier(); asm volatile("" ::: "memory");
        if (wid < 4) { const unsigned* sl = slots + (size_t)(u.pm * BM + row) * 8; float t = 0.f;
#pragma unroll
            for (int k = 0; k < 8; ++k) t += __builtin_bit_cast(float, __hip_atomic_load(sl + k, __ATOMIC_RELAXED, __HIP_MEMORY_SCOPE_AGENT));
            Sx[row] = alpha * __builtin_amdgcn_rsqf(t * (1.0f / 2048.0f) + 1e-6f); }
        asm volatile("s_waitcnt lgkmcnt(0)" ::: "memory"); __builtin_amdgcn_s_barrier(); asm volatile("" ::: "memory");
#pragma unroll
        for (int ai = 0; ai < 2; ++ai)
#pragma unroll
            for (int m = 0; m < 4; ++m) { const int r = ai * HALF + wr * 64 + m * 16 + fr; const float rs = Sx[r]; const size_t grow = (size_t)(u.pm * BM + r) * 2048; float qq = 0.f;
#pragma unroll
                for (int bj = 0; bj < 2; ++bj) { const int c0 = u.pn * BM + bj * HALF + wc * 32 + 8 * fq;
                    const h8 xq = xv[m][bj]; const f32x4 g0 = gv[bj][0], g1 = gv[bj][1];
                    if (ai == 0) xv[m][bj] = *(const h8*)(Xin + grow + (size_t)HALF * 2048 + c0);
                    f32x4 x0 = {(float)xq[0], (float)xq[1], (float)xq[2], (float)xq[3]}, x1 = {(float)xq[4], (float)xq[5], (float)xq[6], (float)xq[7]};
                    x0 = x0 + acc[ai][bj][m][0] * g0 * rs; x1 = x1 + acc[ai][bj][m][1] * g1 * rs;
                    qq += ((x0[0] * x0[0] + x0[1] * x0[1]) + (x0[2] * x0[2] + x0[3] * x0[3])) + ((x1[0] * x1[0] + x1[1] * x1[1]) + (x1[2] * x1[2] + x1[3] * x1[3]));
                    if constexpr (OUTF32) { float* o = (float*)Xout + grow + c0; *(f32x4*)o = x0; *(f32x4*)(o + 4) = x1; }
                    else { u32x4 w; w.x = pkh(x0[0], x0[1]); w.y = pkh(x0[2], x0[3]); w.z = pkh(x1[0], x1[1]); w.w = pkh(x1[2], x1[3]); *(u32x4*)((u16*)Xout + grow + c0) = w; } }
                if constexpr (!OUTF32) { qq = qsum4(qq); if (fq == 0) P[r * 4 + wc] = qq; }
                asm volatile("" ::: "memory"); }
        if constexpr (!OUTF32) {
            asm volatile("s_waitcnt lgkmcnt(0)" ::: "memory"); __builtin_amdgcn_s_barrier(); asm volatile("" ::: "memory");
            if (wid < 4) rinvp[(size_t)(u.pm * BM + row) * 8 + u.pn] = (P[row * 4] + P[row * 4 + 1]) + (P[row * 4 + 2] + P[row * 4 + 3]); }
    }
};

template <class Epi, class Sched, bool ALIGN_EPI, bool SP2, bool AMODE>
__device__ __forceinline__ void gemm_phase(PG8_LAS unsigned char* lds, const Gemm g, const Sched& S, const Epi& E, const int tid) {
    const int wid = __builtin_amdgcn_readfirstlane(tid >> 6), lane = tid & 63, wr = wid >> 2, wc = wid & 3, fr = lane & 15, fq = lane >> 4;
    const int K = g.K, nt = K / BK;
    unsigned voffA[2], voffB[2];
#pragma unroll
    for (int i = 0; i < 2; ++i) { int R, C; stage_rc(tid * 16 + i * 8192, R, C); const int Rb = Epi::PERM ? ((R & ~31) + perm32(R & 31)) : R;
        voffA[i] = (unsigned)(R * g.lda + C) * 2u; voffB[i] = (unsigned)(Rb * g.ldb + C) * 2u; }
    const size_t kstep = (size_t)(BK * 2);
    const size_t hstepA = (size_t)HALF * g.lda * 2, hstepB = (size_t)HALF * g.ldb * 2;
    const size_t tstepA = 2 * hstepA, tstepB = 2 * hstepB;
    const unsigned ldsw = (unsigned)wid * 1024u;
    const int aoff = lds_byte(wr * 64 + fr, fq * 8), boff = lds_byte(wc * 32 + fr, fq * 8);
#define PG8_KOA(t) (AMODE ? ((size_t)((t) >> 1) * 3072u + (size_t)((t) & 1) * 128u) : (size_t)(t) * kstep)
#define PG8_SA(b, h) (((b) * 2 + (h)) * HTB)
#define PG8_SB(b, h) ((4 + (b) * 2 + (h)) * HTB)
#define PG8_STAGE(bufoff, gbase, voff) do { _Pragma("unroll") for (int _i = 0; _i < 2; ++_i) \
        __builtin_amdgcn_global_load_lds((const unsigned*)((const char*)(gbase) + (voff)[_i]), (PG8_LAS unsigned*)(lds + (bufoff) + ldsw + _i * 8192), 16, 0, 0); } while (0)
#define PG8_LDA(dst, b, h) do { _Pragma("unroll") for (int m = 0; m < 4; ++m) _Pragma("unroll") for (int k = 0; k < 2; ++k) dst[m][k] = *(const PG8_LAS h8*)(lds + PG8_SA(b, h) + aoff + m * 2048 + k * 1024); } while (0)
#define PG8_LDB(dst, b, h) do { _Pragma("unroll") for (int n = 0; n < 2; ++n) _Pragma("unroll") for (int k = 0; k < 2; ++k) dst[n][k] = *(const PG8_LAS h8*)(lds + PG8_SB(b, h) + boff + n * 2048 + k * 1024); } while (0)
#define PG8_MMA(ai, bj, At, Bt) do { __builtin_amdgcn_s_setprio(1); _Pragma("unroll") for (int m = 0; m < 4; ++m) _Pragma("unroll") for (int n = 0; n < 2; ++n) _Pragma("unroll") for (int k = 0; k < 2; ++k) \
        acc[ai][bj][m][n] = __builtin_amdgcn_mfma_f32_16x16x32_f16(Bt[n][k], At[m][k], acc[ai][bj][m][n], 0, 0, 0); __builtin_amdgcn_s_setprio(0); } while (0)
#define PG8_WAIT_V(n) asm volatile("s_waitcnt vmcnt(" #n ")" ::: "memory")
#define PG8_WAIT_L(n) asm volatile("s_waitcnt lgkmcnt(" #n ")" ::: "memory")
#define PG8_BAR __builtin_amdgcn_s_barrier()
#define PG8_SCHED __builtin_amdgcn_sched_barrier(0)
    Unit cur, nxt; int ui = 0;
    if (!S.next(0, cur)) return;
    f32x4 acc[2][2][4][2];
#pragma unroll
    for (int a = 0; a < 2; ++a)
#pragma unroll
        for (int b = 0; b < 2; ++b)
#pragma unroll
            for (int m = 0; m < 4; ++m)
#pragma unroll
                for (int n = 0; n < 2; ++n) acc[a][b][m][n] = (f32x4){0.f, 0.f, 0.f, 0.f};
    h8 At[4][2], B0[2][2], B1[2][2];
    const char* cA = (const char*)g.A + (size_t)cur.pm * tstepA; const char* cB = (const char*)g.Bt + (size_t)cur.pn * tstepB;
    S.a_ready(cur);
    if constexpr (SP2) {
        PG8_STAGE(PG8_SB(0, 0), cB, voffB); PG8_STAGE(PG8_SB(0, 1), cB + hstepB, voffB); PG8_STAGE(PG8_SA(0, 0), cA, voffA); PG8_STAGE(PG8_SA(0, 1), cA + hstepA, voffA);
        if (wr == 1) PG8_BAR;
        PG8_WAIT_V(2); PG8_BAR;
        PG8_STAGE(PG8_SB(1, 0), cB + kstep, voffB); PG8_STAGE(PG8_SA(1, 0), cA + kstep, voffA); PG8_STAGE(PG8_SB(1, 1), cB + hstepB + kstep, voffB);
        PG8_WAIT_V(6); PG8_BAR;
    } else {
        PG8_STAGE(PG8_SB(0, 0), cB, voffB); PG8_STAGE(PG8_SA(0, 0), cA, voffA); PG8_STAGE(PG8_SB(0, 1), cB + hstepB, voffB); PG8_STAGE(PG8_SA(0, 1), cA + hstepA, voffA);
        if (wr == 1) PG8_BAR;
        PG8_WAIT_V(4); PG8_BAR;
        PG8_STAGE(PG8_SB(1, 0), cB + kstep, voffB); PG8_STAGE(PG8_SA(1, 0), cA + kstep, voffA); PG8_STAGE(PG8_SB(1, 1), cB + hstepB + kstep, voffB);
        PG8_WAIT_V(6); PG8_BAR;
    }
    for (;;) {
        const bool has_next = S.next(ui + 1, nxt);
        const char* nA = has_next ? (const char*)g.A + (size_t)nxt.pm * tstepA : cA; const char* nB = has_next ? (const char*)g.Bt + (size_t)nxt.pn * tstepB : cB;
        for (int t = 0; t < nt; t += 2) {
            const bool last = (t == nt - 2);
            const char* a1 = cA + PG8_KOA(t + 1);
            const char* a2 = last ? nA : cA + PG8_KOA(t + 2); const char* b2 = last ? nB : cB + (size_t)(t + 2) * kstep;
            const char* a3 = a2 + kstep; const char* b3 = b2 + kstep;
            if (last && has_next) S.a_ready(nxt);
            if constexpr (SP2) {
            PG8_LDB(B0, 0, 0); PG8_LDB(B1, 0, 1); PG8_SCHED; PG8_LDA(At, 0, 0); PG8_STAGE(PG8_SA(1, 1), a1 + hstepA, voffA);
            PG8_WAIT_V(8); PG8_WAIT_L(0); PG8_BAR; PG8_MMA(0, 0, At, B0); PG8_MMA(0, 1, At, B1); PG8_BAR; PG8_SCHED;
            PG8_LDA(At, 0, 1); PG8_STAGE(PG8_SB(0, 0), b2, voffB); PG8_STAGE(PG8_SB(0, 1), b2 + hstepB, voffB); PG8_STAGE(PG8_SA(0, 0), a2, voffA);
            PG8_WAIT_V(8); PG8_WAIT_L(0); PG8_BAR; PG8_MMA(1, 0, At, B0); PG8_MMA(1, 1, At, B1); PG8_BAR; PG8_SCHED;
            PG8_LDB(B0, 1, 0); PG8_LDB(B1, 1, 1); PG8_SCHED; PG8_LDA(At, 1, 0); PG8_STAGE(PG8_SA(0, 1), a2 + hstepA, voffA);
            PG8_WAIT_V(8); PG8_WAIT_L(0); PG8_BAR; PG8_MMA(0, 0, At, B0); PG8_MMA(0, 1, At, B1); PG8_BAR; PG8_SCHED;
            PG8_LDA(At, 1, 1); PG8_STAGE(PG8_SB(1, 0), b3, voffB); PG8_STAGE(PG8_SB(1, 1), b3 + hstepB, voffB); PG8_STAGE(PG8_SA(1, 0), a3, voffA);
            PG8_WAIT_V(8); PG8_WAIT_L(0); PG8_BAR; PG8_MMA(1, 0, At, B0); PG8_MMA(1, 1, At, B1); PG8_BAR; PG8_SCHED;
            } else {
            PG8_LDB(B0, 0, 0); PG8_SCHED; PG8_LDA(At, 0, 0); PG8_STAGE(PG8_SA(1, 1), a1 + hstepA, voffA);
            PG8_WAIT_L(8); PG8_BAR; PG8_WAIT_L(0); PG8_MMA(0, 0, At, B0); PG8_BAR; PG8_SCHED;
            PG8_LDB(B1, 0, 1); PG8_STAGE(PG8_SB(0, 0), b2, voffB);
            PG8_BAR; PG8_WAIT_L(0); PG8_MMA(0, 1, At, B1); PG8_BAR;
            PG8_LDA(At, 0, 1); PG8_STAGE(PG8_SA(0, 0), a2, voffA);
            PG8_BAR; PG8_WAIT_L(0); PG8_MMA(1, 0, At, B0); PG8_BAR; PG8_SCHED;
            PG8_STAGE(PG8_SB(0, 1), b2 + hstepB, voffB);
            PG8_WAIT_V(6); PG8_BAR; PG8_MMA(1, 1, At, B1); PG8_BAR;
            PG8_LDB(B0, 1, 0); PG8_SCHED; PG8_LDA(At, 1, 0); PG8_STAGE(PG8_SA(0, 1), a2 + hstepA, voffA);
            PG8_WAIT_L(8); PG8_BAR; PG8_WAIT_L(0); PG8_MMA(0, 0, At, B0); PG8_BAR; PG8_SCHED;
            PG8_LDB(B1, 1, 1); PG8_STAGE(PG8_SB(1, 0), b3, voffB);
            PG8_BAR; PG8_WAIT_L(0); PG8_MMA(0, 1, At, B1); PG8_BAR;
            PG8_LDA(At, 1, 1); PG8_STAGE(PG8_SA(1, 0), a3, voffA);
            PG8_BAR; PG8_WAIT_L(0); PG8_MMA(1, 0, At, B0); PG8_BAR; PG8_SCHED;
            PG8_STAGE(PG8_SB(1, 1), b3 + hstepB, voffB);
            PG8_WAIT_V(6); PG8_BAR; PG8_MMA(1, 1, At, B1); PG8_BAR;
            }
        }
        if constexpr (ALIGN_EPI) { if (wr == 0) PG8_BAR; }
        E(acc, cur, wr, wc, fr, fq); S.done(cur);
        if (!has_next) break;
#pragma unroll
        for (int a = 0; a < 2; ++a)
#pragma unroll
            for (int b = 0; b < 2; ++b)
#pragma unroll
                for (int m = 0; m < 4; ++m)
#pragma unroll
                    for (int n = 0; n < 2; ++n) acc[a][b][m][n] = (f32x4){0.f, 0.f, 0.f, 0.f};
        cur = nxt; cA = nA; cB = nB; ++ui;
        if constexpr (ALIGN_EPI) { if (wr == 1) PG8_BAR; }
    }
    PG8_WAIT_V(0);
    if constexpr (!ALIGN_EPI) { if (wr == 0) PG8_BAR; }
    PG8_BAR;
#undef PG8_KOA
#undef PG8_SA
#undef PG8_SB
#undef PG8_STAGE
#undef PG8_LDA
#undef PG8_LDB
#undef PG8_MMA
#undef PG8_WAIT_V
#undef PG8_WAIT_L
#undef PG8_BAR
#undef PG8_SCHED
}
}

constexpr int NWAVES = 8;
constexpr int S = 16384, D = 2048, FF = 5632;
constexpr int MEM_LEN = 256, MEM_W = 512;
constexpr int MAIN_W = 1536;
constexpr int ML_H = 4, ML_DQK = 192, ML_DV = 384, ML_L = 64, ML_NC = S / ML_L;
constexpr int A_INW = 5128, A_N = 5120;
constexpr int B_INW = 2084, B_N = 2048;
constexpr int KVW = 1536;
constexpr int NCMP = 1023;
constexpr float EPS = 1e-6f;

constexpr size_t MiB = 1u << 20;
constexpr size_t WS_CTL = 0, CTL_ZERO_BYTES = 64 * 1024;
constexpr size_t WS_MEMN  = 1 * MiB;
constexpr size_t WS_MEMKV = 3 * MiB;
constexpr size_t WS_GA    = 4 * MiB;
constexpr size_t WS_RINV  = 5 * MiB;
constexpr size_t WS_SLOT  = 6 * MiB;
constexpr size_t WS_WGA   = 8 * MiB;
constexpr size_t WS_CB1   = 8 * MiB + 512 * 1024;
constexpr size_t WS_B63   = 8 * MiB + 520 * 1024;
constexpr size_t WS_MLOC  = 8 * MiB + 524 * 1024;
constexpr size_t WS_MST   = 8 * MiB + 528 * 1024;
constexpr size_t WS_DN    = 9 * MiB;
constexpr size_t WS_KVC   = 10 * MiB;
constexpr size_t WS_CMPH  = 11 * MiB;
constexpr size_t WS_ROPE  = 13 * MiB;
constexpr size_t WS_SEL   = 21 * MiB;
constexpr size_t WS_W     = 24 * MiB;
constexpr size_t WS_WGU   = WS_W;
constexpr size_t WS_WD    = WS_WGU + 176 * MiB;
constexpr size_t WS_WAIN  = WS_WD + 88 * MiB;
constexpr size_t WS_WOUT  = WS_WAIN + 20 * MiB;
constexpr size_t WS_WKV   = WS_WOUT + 16 * MiB;
constexpr size_t WS_WBIN  = WS_WKV + 6 * MiB;
constexpr size_t WS_WMKV  = WS_WBIN + 10 * MiB;
constexpr size_t WS_WC1   = WS_WMKV + 8 * MiB;
constexpr size_t WS_WC2   = WS_WC1 + 4 * MiB;
constexpr size_t WS_XN    = WS_WC2 + 1 * MiB;
constexpr size_t WS_SCR   = WS_XN + 64 * MiB;
constexpr size_t WS_H     = WS_SCR;
constexpr size_t WS_Y     = WS_SCR + 176 * MiB;
constexpr size_t WS_PG    = WS_SCR + 240 * MiB;
constexpr size_t WS_X16B  = WS_SCR + 240 * MiB;
constexpr size_t WS_PART  = WS_SCR + 240 * MiB;
constexpr size_t WS_KCS   = WS_SCR + 272 * MiB;
constexpr size_t WS_CT    = WS_SCR;
constexpr size_t WS_AOUT  = WS_SCR + 144 * MiB;
constexpr size_t WS_XKV   = WS_SCR;
constexpr size_t WS_BOUT  = WS_SCR;
constexpr size_t WS_KST   = WS_SCR + 72 * MiB;
constexpr size_t WS_VST   = WS_SCR + 76 * MiB;
constexpr size_t WS_KWT   = WS_SCR + 80 * MiB;
constexpr size_t WS_VWT   = WS_SCR + 88 * MiB;
constexpr size_t WS_KVRAW = WS_SCR + 304 * MiB;
constexpr size_t WS_END   = WS_KVRAW + 48 * MiB + 128 * 1024;
constexpr int CW_TMO = 0;
constexpr int CW_BAR = 4096;
constexpr int CW_RN = 12288;
constexpr int CW_SLC = 8192;

constexpr int LDSCTL_OFF = 0, LDSCTL_BYTES = 512, MISC_OFF = 320;
constexpr int RING_OFF = 512, RING_BYTES = 146944;
constexpr int LDS_BYTES = 147456;
constexpr int WAVE_LDS = 18368;

typedef GAS unsigned gu32;
#define RLX_AGENT __ATOMIC_RELAXED, __HIP_MEMORY_SCOPE_AGENT
#define LDS_WAIT() asm volatile("s_waitcnt lgkmcnt(0)" ::: "memory")
#define VM_WAIT() asm volatile("s_waitcnt vmcnt(0)" ::: "memory")

#define XB_TMO      128
#define XB_XCNT(j)  (256  + 64 * (j))
#define XB_XSUB(j)  (1280 + 64 * (j))
#define XB_XGEN(j)  (2304 + 64 * (j))
#define XB_TOP      3328
#define XB_TOPGEN   3392
#define XCD_BAR_WORDS 3456
#define XB_SPIN_CAP (1u << 18)

__device__ __forceinline__ unsigned xb_ld(unsigned* p)              { return __hip_atomic_load(p, __ATOMIC_RELAXED, __HIP_MEMORY_SCOPE_AGENT); }
__device__ __forceinline__ unsigned xb_add(unsigned* p, unsigned v) { return __hip_atomic_fetch_add(p, v, __ATOMIC_RELAXED, __HIP_MEMORY_SCOPE_AGENT); }
__device__ __forceinline__ unsigned xb_xcc_id() { return (unsigned)__builtin_amdgcn_s_getreg((3 << 11) | 20) & 0xFu; }
#define XB_SPIN(cond, bar) do { unsigned _sp = 0; while (cond) { __builtin_amdgcn_s_sleep(1); \
    if ((++_sp & 255u) == 0u) { if (xb_ld(&(bar)[XB_TMO])) break; if (_sp > XB_SPIN_CAP) { atomicAdd(&(bar)[XB_TMO], 1u); break; } } } } while (0)

struct XcdBarrier { unsigned* bar; unsigned x; volatile LAS unsigned* st; };

__device__ __forceinline__ XcdBarrier xcd_barrier_post(unsigned* bar, volatile LAS unsigned* st, const int tid) {
    XcdBarrier b; b.bar = bar; b.x = xb_xcc_id(); b.st = st;
    if (tid == 0) (void)xb_add(&bar[XB_XCNT(b.x)], 1u);
    return b;
}
__device__ __forceinline__ void xcd_barrier_complete(unsigned* bar, unsigned x, unsigned& nloc, unsigned& nx) {
    const unsigned G = gridDim.x * gridDim.y * gridDim.z;
    unsigned sum, cnt, mine, sp = 0u;
    for (;;) {
        sum = 0u; cnt = 0u; mine = 0u;
#pragma unroll
        for (unsigned j = 0; j < 16; ++j) { const unsigned c = xb_ld(&bar[XB_XCNT(j)]); sum += c; cnt += (c > 0u) ? 1u : 0u; mine = (j == x) ? c : mine; }
        if (sum == G) break;
        __builtin_amdgcn_s_sleep(1);
        if ((++sp & 255u) == 0u) { if (xb_ld(&bar[XB_TMO])) break; if (sp > XB_SPIN_CAP) { atomicAdd(&bar[XB_TMO], 1u); break; } }
    }
    nloc = mine > 0u ? mine : 1u; nx = cnt > 0u ? cnt : 1u;
}
__device__ __forceinline__ void xcd_barrier(const XcdBarrier& b, const int tid) {
    asm volatile("s_waitcnt vmcnt(0)" ::: "memory");
    __syncthreads();
    if (tid == 0) {
        unsigned* bar = b.bar;
        __builtin_amdgcn_s_waitcnt(0);
        unsigned nloc = b.st[0], nx = b.st[1];
        if (nloc == 0u) { xcd_barrier_complete(bar, b.x, nloc, nx); b.st[0] = nloc; b.st[1] = nx; }
        const unsigned old = xb_add(&bar[XB_XSUB(b.x)], 1u);
        const unsigned gen = old / nloc;
        if (old + 1u == (gen + 1u) * nloc) {
            __builtin_amdgcn_fence(__ATOMIC_RELEASE, "agent");
            asm volatile("s_waitcnt vmcnt(0)" ::: "memory");
            const unsigned og = xb_add(&bar[XB_TOP], 1u);
            const unsigned tg = og / nx;
            if (og + 1u == (tg + 1u) * nx) xb_add(&bar[XB_TOPGEN], 1u);
            else XB_SPIN(xb_ld(&bar[XB_TOPGEN]) == tg, bar);
            __builtin_amdgcn_fence(__ATOMIC_ACQUIRE, "agent");
            xb_add(&bar[XB_XGEN(b.x)], 1u);
            asm volatile("s_waitcnt vmcnt(0)" ::: "memory");
        } else {
            XB_SPIN(xb_ld(&bar[XB_XGEN(b.x)]) == gen, bar);
            __builtin_amdgcn_fence(__ATOMIC_ACQUIRE, "agent");
            asm volatile("s_waitcnt vmcnt(0)" ::: "memory");
        }
    }
    __syncthreads();
}

__device__ __forceinline__ float wave_sum(float v) {
#pragma unroll
    for (int o = 1; o < 64; o <<= 1) v += __shfl_xor(v, o);
    return v;
}
__device__ __forceinline__ float wave_max(float v) {
#pragma unroll
    for (int o = 1; o < 64; o <<= 1) v = fmaxf(v, __shfl_xor(v, o));
    return v;
}
__device__ __forceinline__ float wave_scan_add(float v, int lane) {
#pragma unroll
    for (int o = 1; o < 64; o <<= 1) { const float y = __shfl_up(v, o); if (lane >= o) v += y; }
    return v;
}
__device__ __forceinline__ float wave_scan_max(float v, int lane) {
#pragma unroll
    for (int o = 1; o < 64; o <<= 1) { const float y = __shfl_up(v, o); if (lane >= o) v = fmaxf(v, y); }
    return v;
}
__device__ __forceinline__ float sigmoidf_(float x) { return 1.0f / (1.0f + __expf(-x)); }
__device__ __forceinline__ float log_sigmoidf_(float x) { return fminf(x, 0.f) - log1pf(__expf(-fabsf(x))); }

__device__ __forceinline__ void cvt_item(const float* W, int ldw, int col0, int k0, u16* WT, int Kdst, int drow0, float scale, const float* gk, LAS float* scr_, int lane) {
    LAS unsigned* scr = (LAS unsigned*)scr_;
    const float* src = W + (size_t)k0 * ldw + col0; const unsigned so = (unsigned)((lane >> 4) * 2 * ldw + (lane & 15) * 4);
#pragma unroll
    for (int h = 0; h < 2; ++h) { f32x4 v[8][2];
#pragma unroll
        for (int j = 0; j < 8; ++j)
#pragma unroll
            for (int e = 0; e < 2; ++e) { v[j][e] = *(const f32x4*)(src + (so + (unsigned)((8 * (h * 8 + j) + e) * ldw))); v[j][e] = v[j][e] * (gk ? scale * gk[k0 + 8 * (h * 8 + j) + 2 * (lane >> 4) + e] : scale); }
#pragma unroll
        for (int j = 0; j < 8; ++j) { LAS unsigned* d = scr + (4 * (h * 8 + j) + (lane >> 4)) * 65 + (lane & 15) * 4;
            d[0] = pkh(v[j][0].x, v[j][1].x); d[1] = pkh(v[j][0].y, v[j][1].y); d[2] = pkh(v[j][0].z, v[j][1].z); d[3] = pkh(v[j][0].w, v[j][1].w); } }
    LDS_WAIT(); asm volatile("" ::: "memory");
    const int c = lane & 15;
#pragma unroll
    for (int j = 0; j < 16; ++j) { const int n = (lane >> 4) + 4 * j; const LAS unsigned* s = scr + (4 * c) * 65 + n;
        u32x4 o; o.x = s[0 * 65]; o.y = s[1 * 65]; o.z = s[2 * 65]; o.w = s[3 * 65];
        *(GAS u32x4*)(WT + (size_t)(drow0 + n) * Kdst + k0 + 8 * c) = o; }
    LDS_WAIT(); asm volatile("" ::: "memory");
}

template <int NG, bool XI16, bool XO16>
__device__ __forceinline__ void thin_rows(const u16* Y, float alpha, const float* gpost, const void* Xin, void* Xout, float* RINV,
                                          const LAS float* wg, const float* gbias, float* gates, int gw, int NGW, int lane) {
    u32x2 xh_c[8], xh_n[8]; f32x4 xf_c[8], xf_n[8]; u32x2 yr_c[8], yr_n[8];
#define THIN_LOAD(xh_, xf_, yr_, row_) do { \
        if constexpr (XI16) { const GAS u32x2* p_ = (const GAS u32x2*)((const u16*)Xin + (size_t)(row_) * D) + lane; _Pragma("unroll") for (int j = 0; j < 8; ++j) xh_[j] = p_[64 * j]; } \
        else { const GAS f32x4* p_ = (const GAS f32x4*)((const float*)Xin + (size_t)(row_) * D) + lane; _Pragma("unroll") for (int j = 0; j < 8; ++j) xf_[j] = p_[64 * j]; } \
        if (Y) { const GAS u32x2* q_ = (const GAS u32x2*)(Y + (size_t)(row_) * D) + lane; _Pragma("unroll") for (int j = 0; j < 8; ++j) yr_[j] = q_[64 * j]; } } while (0)
    int row = gw;
    if (row < S) THIN_LOAD(xh_c, xf_c, yr_c, row);
    for (; row < S; row += NGW) {
        const int nrow = row + NGW;
        if (nrow < S) THIN_LOAD(xh_n, xf_n, yr_n, nrow);
        f32x4 x[8];
#pragma unroll
        for (int j = 0; j < 8; ++j) { if constexpr (XI16) x[j] = __builtin_convertvector(__builtin_bit_cast(h4, xh_c[j]), f32x4); else x[j] = xf_c[j]; }
        if (Y) {
            f32x4 y[8]; float ss = 0.f;
#pragma unroll
            for (int j = 0; j < 8; ++j) { y[j] = __builtin_convertvector(__builtin_bit_cast(h4, yr_c[j]), f32x4); ss += (y[j].x * y[j].x + y[j].y * y[j].y) + (y[j].z * y[j].z + y[j].w * y[j].w); }
            const float r = alpha * rsqrtf(wave_sum(ss) * (1.0f / D) + EPS);
#pragma unroll
            for (int j = 0; j < 8; ++j) { const f32x4 g = ((const GAS f32x4*)gpost)[lane + 64 * j]; x[j] = x[j] + y[j] * g * r; }
        }
        if (Xout) {
            if constexpr (XO16) { GAS u32x2* xo = (GAS u32x2*)((u16*)Xout + (size_t)row * D) + lane;
#pragma unroll
                for (int j = 0; j < 8; ++j) { u32x2 w; w.x = pkh(x[j].x, x[j].y); w.y = pkh(x[j].z, x[j].w); xo[64 * j] = w; } }
            else { GAS f32x4* xo = (GAS f32x4*)((float*)Xout + (size_t)row * D) + lane;
#pragma unroll
                for (int j = 0; j < 8; ++j) xo[64 * j] = x[j]; } }
        if (RINV) {
            float ss = 0.f;
#pragma unroll
            for (int j = 0; j < 8; ++j) ss += (x[j].x * x[j].x + x[j].y * x[j].y) + (x[j].z * x[j].z + x[j].w * x[j].w);
            const float sst = wave_sum(ss); const float r = rsqrtf(sst * (1.0f / D) + EPS);
            if (lane < 8) RINV[(size_t)row * 8 + lane] = lane == 0 ? sst : 0.f;
            if constexpr (NG == 8) {
                float a[8];
#pragma unroll
                for (int gi = 0; gi < 8; ++gi) { const LAS f32x4* wr = (const LAS f32x4*)(wg + gi * D) + lane; float acc = 0.f;
#pragma unroll
                    for (int j = 0; j < 8; ++j) { const f32x4 w = wr[64 * j]; acc += (x[j].x * w.x + x[j].y * w.y) + (x[j].z * w.z + x[j].w * w.w); }
                    a[gi] = acc; asm volatile("" ::: "memory"); }
                float b4[4], b2[2], b1;
                { const bool hi = (lane & 32) != 0;
#pragma unroll
                  for (int i = 0; i < 4; ++i) { const float send = hi ? a[i] : a[i + 4], keep = hi ? a[i + 4] : a[i]; b4[i] = keep + __shfl_xor(send, 32); } }
                { const bool hi = (lane & 16) != 0;
#pragma unroll
                  for (int i = 0; i < 2; ++i) { const float send = hi ? b4[i] : b4[i + 2], keep = hi ? b4[i + 2] : b4[i]; b2[i] = keep + __shfl_xor(send, 16); } }
                { const bool hi = (lane & 8) != 0; const float send = hi ? b2[0] : b2[1], keep = hi ? b2[1] : b2[0]; b1 = keep + __shfl_xor(send, 8); }
                b1 += __shfl_xor(b1, 4); b1 += __shfl_xor(b1, 2); b1 += __shfl_xor(b1, 1);
                if ((lane & 7) == 0) { const int gi = lane >> 3; gates[(size_t)row * 8 + gi] = b1 * r + gbias[gi]; }
            }
        }
#pragma unroll
        for (int j = 0; j < 8; ++j) { if constexpr (XI16) xh_c[j] = xh_n[j]; else xf_c[j] = xf_n[j]; yr_c[j] = yr_n[j]; }
    }
#undef THIN_LOAD
}

__device__ __forceinline__ float quad_max(float x) { float a = x, b = x;
    asm("s_nop 1\n\tv_permlane16_swap_b32 %0, %1\n\tv_max_f32 %0, %0, %1\n\tv_mov_b32 %1, %0\n\ts_nop 1\n\tv_permlane32_swap_b32 %0, %1\n\tv_max_f32 %0, %0, %1" : "+v"(a), "+v"(b)); return a; }
__device__ __forceinline__ float quad_sum(float x) { float a = x, b = x;
    asm volatile("s_nop 1\n\tv_permlane16_swap_b32 %0, %1\n\tv_add_f32 %0, %0, %1\n\tv_mov_b32 %1, %0\n\ts_nop 1\n\tv_permlane32_swap_b32 %0, %1\n\tv_add_f32 %0, %0, %1" : "+v"(a), "+v"(b)); return a; }

__device__ __forceinline__ f32x4 mma16(h8 a, h8 b, f32x4 c) { return __builtin_amdgcn_mfma_f32_16x16x32_f16(a, b, c, 0, 0, 0); }
__device__ __forceinline__ h8 cat44(h4 a, h4 b) { return __builtin_shufflevector(a, b, 0, 1, 2, 3, 4, 5, 6, 7); }
__device__ __forceinline__ h4 cvt4(f32x4 v) { return __builtin_convertvector(v, h4); }
__device__ __forceinline__ h8 cvt8(f32x4 a, f32x4 b) { return cat44(cvt4(a), cvt4(b)); }
typedef long i64_t;
__device__ __forceinline__ i64_t pk8_fp8(f32x4 a, f32x4 b) { int lo = 0, hi = 0;
    lo = __builtin_amdgcn_cvt_pk_fp8_f32(a[0], a[1], lo, false); lo = __builtin_amdgcn_cvt_pk_fp8_f32(a[2], a[3], lo, true);
    hi = __builtin_amdgcn_cvt_pk_fp8_f32(b[0], b[1], hi, false); hi = __builtin_amdgcn_cvt_pk_fp8_f32(b[2], b[3], hi, true);
    return (i64_t)(((unsigned long long)(unsigned)hi << 32) | (unsigned)lo); }
__device__ __forceinline__ f32x4 mma8(i64_t a, i64_t b, f32x4 c) { return __builtin_amdgcn_mfma_f32_16x16x32_fp8_fp8(a, b, c, 0, 0, 0); }
typedef long i64x2_ __attribute__((ext_vector_type(2)));
typedef long i64x4_ __attribute__((ext_vector_type(4)));
typedef int i32x8_ __attribute__((ext_vector_type(8)));
__device__ __forceinline__ f32x4 mma8k128(i64x2_ a01, i64x2_ a23, i64_t b0, i64_t b1, i64_t b2, i64_t b3, f32x4 c) {
    const i64x4_ A = __builtin_shufflevector(a01, a23, 0, 1, 2, 3); const i64x4_ B = {b0, b1, b2, b3};
    return __builtin_amdgcn_mfma_scale_f32_16x16x128_f8f6f4(__builtin_bit_cast(i32x8_, A), __builtin_bit_cast(i32x8_, B), c, 0, 0, 0, 0, 0, 0); }

__device__ __forceinline__ void mem_attn_mfma(const u16* Q, int ldq, int qoff, const u16* MKV, u16* HEADS, LAS unsigned char* ring, int tid, int G) {
    const int lane = tid & 63, wave = __builtin_amdgcn_readfirstlane(tid >> 6), fr = lane & 15, fq = lane >> 4;
    const int hd = blockIdx.x & 3, rank = blockIdx.x >> 2, nbh = (G - hd + 3) >> 2;
    LAS f16* Ks = (LAS f16*)ring;
    LAS f16* Vt = (LAS f16*)(ring + 69632);
    __syncthreads();
    for (int e = tid; e < 4096; e += 512) { const int key = e & 255, cc = e >> 8;
        *(LAS h8*)(Ks + key * 136 + cc * 8) = *(const h8*)(MKV + (size_t)key * 1024 + hd * 128 + cc * 8);
        const h8 vv = *(const h8*)(MKV + (size_t)key * 1024 + 512 + hd * 128 + cc * 8);
#pragma unroll
        for (int j = 0; j < 8; ++j) Vt[(cc * 8 + j) * 264 + key] = vv[j]; }
    __syncthreads();
    const float sc = 0.08838834764831845f * 1.4426950408889634f;
    for (int tile = rank * 8 + wave; tile < S / 16; tile += nbh * 8) {
        const int t0 = tile * 16;
        h8 qf[4];
#pragma unroll
        for (int ks = 0; ks < 4; ++ks) qf[ks] = *(const h8*)(Q + (size_t)(t0 + fr) * ldq + qoff + hd * 128 + ks * 32 + fq * 8);
        f32x4 st[16]; float m = -3.0e38f;
#pragma unroll
        for (int kt = 0; kt < 16; ++kt) { f32x4 a = {0.f, 0.f, 0.f, 0.f};
#pragma unroll
            for (int ks = 0; ks < 4; ++ks) a = mma16(*(const LAS h8*)(Ks + (kt * 16 + fr) * 136 + ks * 32 + fq * 8), qf[ks], a);
            st[kt] = a; m = fmaxf(m, fmaxf(fmaxf(a[0], a[1]), fmaxf(a[2], a[3]))); asm volatile("" ::: "memory"); }
        m = quad_max(m);
        float l = 0.f; h8 pf[8];
#pragma unroll
        for (int kb = 0; kb < 8; ++kb) { f32x4 p0, p1;
#pragma unroll
            for (int r = 0; r < 4; ++r) { p0[r] = __builtin_amdgcn_exp2f((st[2 * kb][r] - m) * sc); p1[r] = __builtin_amdgcn_exp2f((st[2 * kb + 1][r] - m) * sc); }
            l += (p0[0] + p0[1]) + (p0[2] + p0[3]) + (p1[0] + p1[1]) + (p1[2] + p1[3]); pf[kb] = cvt8(p0, p1); }
        l = quad_sum(l);
        const float il = 1.0f / l;
#pragma unroll
        for (int dt = 0; dt < 8; ++dt) { f32x4 o = {0.f, 0.f, 0.f, 0.f};
#pragma unroll
            for (int kb = 0; kb < 8; ++kb) { const LAS f16* vp = Vt + (dt * 16 + fr) * 264 + kb * 32 + 4 * fq;
                o = mma16(cat44(*(const LAS h4*)vp, *(const LAS h4*)(vp + 16)), pf[kb], o); }
            *(h4*)(HEADS + (size_t)(t0 + fr) * D + MAIN_W + hd * 128 + dt * 16 + 4 * fq) = cvt4(o * il); asm volatile("" ::: "memory"); }
    }
    __syncthreads();
}

#define NSA_NEG (-1.0e30f)
constexpr int NSA_NH = 3;
__device__ __forceinline__ float nsa_gate(const float* PG, int t, int col, const float* BGB) {
    const float* p = PG + (size_t)t * 256 + col; return sigmoidf_(((p[0] + p[(size_t)S * 256]) + (p[(size_t)2 * S * 256] + p[(size_t)3 * S * 256])) + BGB[col]); }
__device__ __forceinline__ void nsa_tile(const int t0, const int g, const u16* BOUT, const unsigned char* KWT, const u16* KC, const unsigned char* VCT, const unsigned char* VWT,
                                         const float* PG, const float* BGB, const float* ROPE, u16* XN, int* SEL, LAS float* psl, const int lane) {
    const int fr = lane & 15, fq = lane >> 4;
    const float sc2 = 0.08838834764831845f * 1.4426950408889634f;
    const int cur = t0 >> 6;
    const int nvmax = t0 >> 4;
    const int nvl = (t0 >> 4) - 1 + (fr == 15 ? 1 : 0);
    const int nsteps = (nvmax + 31) >> 5;
    const int t = t0 + fr;
#pragma unroll
    for (int kt = 0; kt < 64; ++kt) psl[kt * 64 + lane] = 0.f;
    for (int hb = 0; hb < 6 / NSA_NH; ++hb) {
        const int hh0 = g * 6 + hb * NSA_NH;
        f32x4 o[NSA_NH][8];
#pragma unroll
        for (int j = 0; j < NSA_NH; ++j)
#pragma unroll
            for (int dt = 0; dt < 8; ++dt) o[j][dt] = (f32x4){0.f, 0.f, 0.f, 0.f};
        h8 qf[NSA_NH][4]; i64_t qb[NSA_NH][4];
        typedef i64_t i64x2 __attribute__((ext_vector_type(2)));
        { const int ln = lane_id_v(), fr_ = ln & 15, fq_ = ln >> 4;
          const float* cp = ROPE + (size_t)(t0 + fr_) * 64 + fq_ * 8; const float* sp = cp + (size_t)S * 64; const u16* qrow = BOUT + (size_t)(t0 + fr_) * B_N + fq_ * 8;
#pragma unroll
          for (int ks = 0; ks < 2; ++ks) { const f32x4 c0 = *(const f32x4*)(cp + ks * 32), c1 = *(const f32x4*)(cp + ks * 32 + 4), s0 = *(const f32x4*)(sp + ks * 32), s1 = *(const f32x4*)(sp + ks * 32 + 4);
#pragma unroll
              for (int j = 0; j < NSA_NH; ++j) { const h8 qa = *(const h8*)(qrow + (hh0 + j) * 128 + ks * 32), qb_ = *(const h8*)(qrow + (hh0 + j) * 128 + (ks + 2) * 32);
                  f32x4 a0, a1, b0, b1;
#pragma unroll
                  for (int e = 0; e < 8; ++e) { const float c = e < 4 ? c0[e & 3] : c1[e & 3], s = e < 4 ? s0[e & 3] : s1[e & 3]; const float x1 = (float)qa[e], x2 = (float)qb_[e]; const float r1 = x1 * c - x2 * s, r2 = x2 * c + x1 * s;
                      if (e < 4) { a0[e] = r1; b0[e] = r2; } else { a1[e - 4] = r1; b1[e - 4] = r2; } }
                  qb[j][ks] = pk8_fp8(a0, a1); qb[j][ks + 2] = pk8_fp8(b0, b1); } } }
        float m[NSA_NH], l[NSA_NH];
#pragma unroll
        for (int j = 0; j < NSA_NH; ++j) { m[j] = NSA_NEG; l[j] = 0.f; }
        const int klo = (t0 - 511 > 0 ? t0 - 511 : 0) & ~31;
        for (int kp = klo; kp <= t0 + 15; kp += 32) {
            const bool inner = (kp + 31 <= t0) && (kp >= t0 - 496);
            i64x2 vf[4], kf[4];
            { const int ln = lane_id_v(); const unsigned char* vp_ = VWT + (((size_t)g * 512 + (kp >> 5)) * 4 * 64 + ln) * 16; const unsigned char* kp_ = KWT + (((size_t)g * 1024 + (kp >> 4)) * 2 * 64 + ln) * 16;
#pragma unroll
              for (int i = 0; i < 4; ++i) { vf[i] = *(const i64x2*)(vp_ + i * 1024); kf[i] = *(const i64x2*)(kp_ + i * 1024); } }
            f32x4 p[NSA_NH][2];
#pragma unroll
            for (int k2 = 0; k2 < 2; ++k2) {
                const int k0 = kp + k2 * 16 + 4 * fq;
#pragma unroll
                for (int j = 0; j < NSA_NH; ++j) { f32x4 s = {0.f, 0.f, 0.f, 0.f};
                    s = mma8k128(kf[k2 * 2], kf[k2 * 2 + 1], qb[j][0], qb[j][1], qb[j][2], qb[j][3], s);
                    if (!inner) {
#pragma unroll
                        for (int r = 0; r < 4; ++r) s[r] = (k0 + r <= t && k0 + r > t - 512) ? s[r] : NSA_NEG; }
                    p[j][k2] = s; } }
            i64_t pf[NSA_NH];
#pragma unroll
            for (int j = 0; j < NSA_NH; ++j) { float bm = NSA_NEG;
#pragma unroll
                for (int k2 = 0; k2 < 2; ++k2)
#pragma unroll
                    for (int r = 0; r < 4; ++r) bm = fmaxf(bm, p[j][k2][r]);
                bm = quad_max(bm) * sc2;
                const float mn = fmaxf(m[j], bm), mn8 = mn - 8.0f; float ps = 0.f;
                if (__ballot(mn > m[j]) != 0ull) {
                    const float corr = __builtin_amdgcn_exp2f(m[j] - mn); l[j] *= corr;
#pragma unroll
                    for (int dt = 0; dt < 8; ++dt) o[j][dt] = o[j][dt] * corr; }
                m[j] = mn;
                if (inner) {
#pragma unroll
                    for (int k2 = 0; k2 < 2; ++k2)
#pragma unroll
                        for (int r = 0; r < 4; ++r) { const float pv = __builtin_amdgcn_exp2f(__builtin_fmaf(p[j][k2][r], sc2, -mn8)); p[j][k2][r] = pv; ps += pv; } }
                else {
#pragma unroll
                    for (int k2 = 0; k2 < 2; ++k2)
#pragma unroll
                        for (int r = 0; r < 4; ++r) { const float pv = (p[j][k2][r] > -1.0e29f) ? __builtin_amdgcn_exp2f(__builtin_fmaf(p[j][k2][r], sc2, -mn8)) : 0.f; p[j][k2][r] = pv; ps += pv; } }
                l[j] += ps; pf[j] = pk8_fp8(p[j][0], p[j][1]); }
#pragma unroll
            for (int dt = 0; dt < 8; ++dt)
#pragma unroll
                for (int j = 0; j < NSA_NH; ++j) o[j][dt] = mma8(vf[dt >> 1][dt & 1], pf[j], o[j][dt]);
        }
#pragma unroll
        for (int j = 0; j < NSA_NH; ++j) { const float lt = quad_sum(l[j]);
            const float gwv = 256.0f * nsa_gate(PG, t, (hh0 + j) * 3 + 2, BGB) / lt;
#pragma unroll
            for (int dt = 0; dt < 8; ++dt) o[j][dt] = o[j][dt] * gwv; }
#pragma unroll
        for (int j = 0; j < NSA_NH; ++j)
#pragma unroll
            for (int ks = 0; ks < 4; ++ks) qf[j][ks] = *(const h8*)(BOUT + (size_t)(t0 + (lane_id_v() & 15)) * B_N + (hh0 + j) * 128 + ks * 32 + (lane_id_v() >> 4) * 8);
#pragma unroll
        for (int j = 0; j < NSA_NH; ++j) { m[j] = NSA_NEG; l[j] = 0.f; }
        for (int st = 0; st < nsteps * 2; st += 2) {
            h8 kf[2][4]; const int lnA = lane_id_v();
#pragma unroll
            for (int u = 0; u < 2; ++u)
#pragma unroll
                for (int ks = 0; ks < 4; ++ks) kf[u][ks] = *(const h8*)(KC + ((((size_t)g * 64 + st + u) * 4 + ks) * 64 + lnA) * 8);
            const bool innerA = ((st + 1) * 16 + 15 < (t0 >> 4) - 1);
#pragma unroll
            for (int u = 0; u < 2; ++u) { const int n0 = (st + u) * 16 + 4 * fq;
#pragma unroll
                for (int j = 0; j < NSA_NH; ++j) { f32x4 s = {0.f, 0.f, 0.f, 0.f};
#pragma unroll
                    for (int ks = 0; ks < 4; ++ks) s = mma16(kf[u][ks], qf[j][ks], s);
                    float bm = NSA_NEG, ps = 0.f;
                    if (innerA) {
#pragma unroll
                        for (int r = 0; r < 4; ++r) { s[r] = s[r] * sc2; bm = fmaxf(bm, s[r]); }
                        const float mn = fmaxf(m[j], bm);
#pragma unroll
                        for (int r = 0; r < 4; ++r) ps += __builtin_amdgcn_exp2f(s[r] - mn);
                        l[j] = l[j] * __builtin_amdgcn_exp2f(m[j] - mn) + ps; m[j] = mn; }
                    else {
#pragma unroll
                        for (int r = 0; r < 4; ++r) { s[r] = (n0 + r < nvl) ? s[r] * sc2 : NSA_NEG; bm = fmaxf(bm, s[r]); }
                        const float mn = fmaxf(m[j], bm);
#pragma unroll
                        for (int r = 0; r < 4; ++r) ps += (n0 + r < nvl) ? __builtin_amdgcn_exp2f(s[r] - mn) : 0.f;
                        l[j] = l[j] * __builtin_amdgcn_exp2f(m[j] - mn) + ps; m[j] = mn; } } }
        }
        float il[NSA_NH], gcv[NSA_NH];
#pragma unroll
        for (int j = 0; j < NSA_NH; ++j) { const float mt = quad_max(m[j]);
            const float lt = quad_sum(l[j] * __builtin_amdgcn_exp2f(m[j] - mt));
            m[j] = mt; il[j] = lt > 0.f ? 1.0f / lt : 0.f; gcv[j] = nsa_gate(PG, t, (hh0 + j) * 3 + 0, BGB); }
        float rot_prev = 0.f; float g256[NSA_NH];
#pragma unroll
        for (int j = 0; j < NSA_NH; ++j) g256[j] = gcv[j] * 256.0f;
        for (int st = 0; st < nsteps; ++st) {
            const bool innerB = (st * 32 + 31 < (t0 >> 4) - 1);
            const int lnB = lane_id_v();
            int pk[NSA_NH][2];
#pragma unroll
            for (int k2 = 0; k2 < 2; ++k2) { h8 kf[4];
#pragma unroll
                for (int ks = 0; ks < 4; ++ks) kf[ks] = *(const h8*)(KC + ((((size_t)g * 64 + st * 2 + k2) * 4 + ks) * 64 + lnB) * 8);
                const int n0 = st * 32 + k2 * 16 + 4 * fq; f32x4 ps = {0.f, 0.f, 0.f, 0.f};
#pragma unroll
                for (int j = 0; j < NSA_NH; ++j) { f32x4 sv = {0.f, 0.f, 0.f, 0.f};
#pragma unroll
                    for (int ks = 0; ks < 4; ++ks) sv = mma16(kf[ks], qf[j][ks], sv);
                    if (innerB) {
#pragma unroll
                        for (int r = 0; r < 4; ++r) sv[r] = __builtin_amdgcn_exp2f(sv[r] * sc2 - m[j]) * il[j]; }
                    else {
#pragma unroll
                        for (int r = 0; r < 4; ++r) sv[r] = (n0 + r < nvl) ? __builtin_amdgcn_exp2f(sv[r] * sc2 - m[j]) * il[j] : 0.f; }
                    ps = ps + sv; const f32x4 sg = sv * g256[j];
                    int w = __builtin_amdgcn_cvt_pk_fp8_f32(sg[0], sg[1], 0, false); pk[j][k2] = __builtin_amdgcn_cvt_pk_fp8_f32(sg[2], sg[3], w, true); }
                const float rot = __shfl(ps[3], (lane + 48) & 63);
                const float prev = (fq == 0) ? rot_prev : rot; rot_prev = rot;
                const int kt = st * 2 + k2;
                psl[kt * 64 + lane] += 2.f * (ps[0] + ps[1] + ps[2]) + ps[3] + prev;
            }
            i64x2 vf[4];
#pragma unroll
            for (int i = 0; i < 4; ++i) vf[i] = *(const i64x2*)(VCT + ((((size_t)g * 32 + st) * 4 + i) * 64 + lnB) * 16);
#pragma unroll
            for (int dt = 0; dt < 8; ++dt)
#pragma unroll
                for (int j = 0; j < NSA_NH; ++j) o[j][dt] = mma8(vf[dt >> 1][dt & 1], (i64_t)(((unsigned long long)(unsigned)pk[j][1] << 32) | (unsigned)pk[j][0]), o[j][dt]);
        }
#pragma unroll
        for (int j = 0; j < NSA_NH; ++j)
#pragma unroll
            for (int dt = 0; dt < 8; ++dt) *(h4*)(XN + (size_t)(t0 + (lane_id_v() & 15)) * D + (hh0 + j) * 128 + dt * 16 + 4 * (lane_id_v() >> 4)) = cvt4(o[j][dt] * (1.0f / 256.0f));
        asm volatile("" ::: "memory");
    }
    LDS_WAIT();
    int* selp = SEL + ((size_t)t * 2 + g) * 16;
    if (cur <= 15) { int z = 0; asm volatile("" : "+v"(z));
        if (fq == 0) {
#pragma unroll
            for (int b = 0; b < 16; ++b) selp[b] = z + b; } }
    else {
        float v[64];
#pragma unroll
        for (int kt = 0; kt < 64; ++kt) { const int jb = 4 * kt + fq; v[kt] = (jb >= 1 && jb <= cur - 2) ? psl[kt * 64 + lane] : -1.f; }
        if (fq == 0) { selp[0] = 0; selp[1] = cur - 1; selp[2] = cur; }
        for (int r = 0; r < 13; ++r) { float bv = -3.f; int bi = 0;
#pragma unroll
            for (int kt = 0; kt < 64; ++kt) if (v[kt] > bv) { bv = v[kt]; bi = 4 * kt + fq; }
#pragma unroll
            for (int off = 16; off < 64; off <<= 1) { const float ov = __shfl_xor(bv, off); const int oi = __shfl_xor(bi, off); if (ov > bv || (ov == bv && oi < bi)) { bv = ov; bi = oi; } }
            if (fq == 0) selp[3 + r] = bi;
#pragma unroll
            for (int kt = 0; kt < 64; ++kt) v[kt] = (4 * kt + fq == bi) ? -2.f : v[kt]; }
    }
}

__device__ __forceinline__ void nsa_slc_token(const int t, const int g, const u16* BOUT, const unsigned char* KST, const unsigned char* VST, const float* PG, const float* BGB, const float* ROPE, u16* XN, const int* SEL, const int lane) {
    const int fr = lane & 15, fq = lane >> 4;
    const unsigned l16 = (unsigned)lane * 16u;
    const float sc2 = 0.08838834764831845f * 1.4426950408889634f;
    const int cur = t >> 6, nsel = cur <= 15 ? cur + 1 : 16;
    const int myblk = (SEL + (size_t)t * 32 + g * 16)[fr];
    const unsigned char* ksg = KST + (size_t)g * 1024 * 2048; const unsigned char* vsg = VST + (size_t)g * 256 * 8192;
    const int frc = fr < 6 ? fr : 0;
    i64_t qb[4];
    { const u16* qrow = BOUT + (size_t)t * B_N + g * 768; const float* crow = ROPE + (size_t)t * 64; h8 q[4];
#pragma unroll
      for (int ks = 0; ks < 4; ++ks) { q[ks] = *(const h8*)(qrow + (unsigned)(frc * 128 + ks * 32 + fq * 8)); if (fr >= 6) q[ks] = (h8){0, 0, 0, 0, 0, 0, 0, 0}; }
#pragma unroll
      for (int ks = 0; ks < 2; ++ks) { const unsigned co = (unsigned)(ks * 32 + fq * 8);
          const f32x4 c0 = *(const f32x4*)(crow + co), c1 = *(const f32x4*)(crow + co + 4), s0 = *(const f32x4*)(crow + S * 64 + co), s1 = *(const f32x4*)(crow + S * 64 + co + 4);
          f32x4 a0, a1, b0, b1;
#pragma unroll
          for (int e = 0; e < 8; ++e) { const float c = e < 4 ? c0[e & 3] : c1[e & 3], sn = e < 4 ? s0[e & 3] : s1[e & 3]; const float x1 = (float)q[ks][e], x2 = (float)q[ks + 2][e]; const float r1 = x1 * c - x2 * sn, r2 = x2 * c + x1 * sn;
              if (e < 4) { a0[e] = r1; b0[e] = r2; } else { a1[e - 4] = r1; b1[e - 4] = r2; } }
          qb[ks] = pk8_fp8(a0, a1); qb[ks + 2] = pk8_fp8(b0, b1); } }
    float m = NSA_NEG, l = 0.f; f32x4 o[8];
#pragma unroll
    for (int dt = 0; dt < 8; ++dt) o[dt] = (f32x4){0.f, 0.f, 0.f, 0.f};
    typedef i64_t i64x2 __attribute__((ext_vector_type(2)));
    i64x2 kf[8];
    { const unsigned char* kb0 = ksg + (size_t)__builtin_amdgcn_readlane(myblk, 0) * 8192;
#pragma unroll
      for (int i = 0; i < 8; ++i) kf[i] = *(const i64x2*)(kb0 + (l16 + i * 1024u)); }
    for (int b = 0; b < nsel; ++b) {
        const int blk = __builtin_amdgcn_readlane(myblk, b); const int kbase = blk * 64;
        i64x2 vf[8];
        { const unsigned char* vb = vsg + (size_t)blk * 8192;
#pragma unroll
          for (int i = 0; i < 8; ++i) vf[i] = *(const i64x2*)(vb + (l16 + i * 1024u)); }
        const bool full = (kbase + 63 <= t);
        f32x4 s[4]; float bm = NSA_NEG;
#pragma unroll
        for (int kt = 0; kt < 4; ++kt) { f32x4 a = {0.f, 0.f, 0.f, 0.f};
            a = mma8k128(kf[kt * 2], kf[kt * 2 + 1], qb[0], qb[1], qb[2], qb[3], a);
            if (full) {
#pragma unroll
                for (int r = 0; r < 4; ++r) bm = fmaxf(bm, a[r]); }
            else {
#pragma unroll
                for (int r = 0; r < 4; ++r) { a[r] = (kbase + kt * 16 + 4 * fq + r <= t) ? a[r] : NSA_NEG; bm = fmaxf(bm, a[r]); } }
            s[kt] = a; }
        if (b + 1 < nsel) { const unsigned char* kb1 = ksg + (size_t)__builtin_amdgcn_readlane(myblk, b + 1) * 8192;
#pragma unroll
            for (int i = 0; i < 8; ++i) kf[i] = *(const i64x2*)(kb1 + (l16 + i * 1024u)); }
        bm = quad_max(bm) * sc2;
        const float mn = fmaxf(m, bm); float ps = 0.f;
        if (__ballot(mn > m) != 0ull) {
            const float corr = __builtin_amdgcn_exp2f(m - mn); l *= corr;
#pragma unroll
            for (int dt = 0; dt < 8; ++dt) o[dt] = o[dt] * corr; }
        m = mn;
        const float mn8 = mn - 8.0f;
        if (full) {
#pragma unroll
            for (int kt = 0; kt < 4; ++kt)
#pragma unroll
                for (int r = 0; r < 4; ++r) { const float pv = __builtin_amdgcn_exp2f(__builtin_fmaf(s[kt][r], sc2, -mn8)); s[kt][r] = pv; ps += pv; } }
        else {
#pragma unroll
            for (int kt = 0; kt < 4; ++kt)
#pragma unroll
                for (int r = 0; r < 4; ++r) { const float pv = (s[kt][r] > -1.0e29f) ? __builtin_amdgcn_exp2f(__builtin_fmaf(s[kt][r], sc2, -mn8)) : 0.f; s[kt][r] = pv; ps += pv; } }
        l += ps;
        const i64_t pf0 = pk8_fp8(s[0], s[1]), pf1 = pk8_fp8(s[2], s[3]);
#pragma unroll
        for (int dt = 0; dt < 8; ++dt) { f32x4 a = o[dt];
            a = mma8(vf[dt][0], pf0, a);
            a = mma8(vf[dt][1], pf1, a);
            o[dt] = a; }
    }
    l = quad_sum(l);
    if (fr < 6) { const float gs = nsa_gate(PG, t, (g * 6 + fr) * 3 + 1, BGB) / l; u16* xrow = XN + (size_t)t * D + g * 768;
#pragma unroll
        for (int dt = 0; dt < 8; ++dt) { h4* op = (h4*)(xrow + (unsigned)(fr * 128 + dt * 16 + 4 * fq));
            const f32x4 old = __builtin_convertvector(*op, f32x4); *op = cvt4(old + o[dt] * gs); } }
}

struct Args { const float* in[19]; float* out; unsigned char* ws; int ph_lo, ph_hi, li, pad; };
typedef const Args __attribute__((address_space(4))) CArgs;
#define I_X 0
#define I_MEM 1
#define I_NG 2
#define I_WG 3
#define I_WU 4
#define I_WDN 5
#define I_MEMNORM 6
#define I_MEMWKV 7
#define I_WOUT 8
#define I_AWIN 9
#define I_AGB 10
#define I_AHN 11
#define I_KVN 12
#define I_WKV 13
#define I_CPOS 14
#define I_CW1 15
#define I_CW2 16
#define I_BWIN 17
#define I_BGB 18
#define WSP(T, off) ((T*)(ws + (off)))


struct Ctx { LAS unsigned char* lds; unsigned char* ws0; int G, lo, hi, wave_id; XcdBarrier bar; };
#define PH_BEGIN if (lo <= ph && ph < hi) { \
        const unsigned long long _pt0 = (PROBE_MASK != 0u) ? __builtin_amdgcn_s_memrealtime() : 0ull; \
        int tid = wave_id * 64 + lane_id_v(); \
        const int lane = tid & 63, wave = __builtin_amdgcn_readfirstlane(tid >> 6); \
        const int gw = (int)blockIdx.x * NWAVES + wave, NGW = G * NWAVES; \
        CArgs* ap = (CArgs*)__builtin_amdgcn_kernarg_segment_ptr(); asm volatile("" : "+s"(ap)); \
        unsigned char* ws = ap->ws; (void)lane; (void)gw; (void)NGW; (void)ws;
#define PH_END   if (ph + 1 < hi) { const int tid_e = wave_id * 64 + lane_id_v(); if (MK_PER_PHASE) { if (tid_e == 0) __hip_atomic_store((gu32*)(ws0 + WS_CTL) + CW_TMO, 0xBADBA0u, RLX_AGENT); } else xcd_barrier(bar, tid_e); } \
        if ((PROBE_MASK >> ph) & 1u) probe_acc += __builtin_amdgcn_s_memrealtime() - _pt0; } ++ph;


template <int F> __device__ __forceinline__ void ffn_stage(const Ctx& cx, int& ph, unsigned long long& probe_acc) {
    LAS unsigned char* const lds = cx.lds; unsigned char* const ws0 = cx.ws0; const int G = cx.G, lo = cx.lo, hi = cx.hi, wave_id = cx.wave_id; const XcdBarrier bar = cx.bar;
        constexpr int f = F; constexpr int layer = F >> 1;
        PH_BEGIN
        {
            if constexpr (F == 2) {
                const int b = blockIdx.x, idx = (b >> 2) & 3, sp = (b >> 4) & 7, c = idx >> 1, gg = idx & 1;
                pg8::Gemm g3{WSP(u16, WS_KCS) + (size_t)idx * (S + 32) * 128 + sp * 512, WSP(u16, WS_WC1) + (size_t)c * 256 * 4096 + sp * 512, 1024, 256, 512, 16 * 128, 4096}; pg8::StaticOrder S3; S3.init(1024, 256, G, b < 128 ? (b & 3) : 1 << 20);
                pg8::EpiF32 E3{WSP(float, WS_PART) + (size_t)(sp * 4 + idx) * 1024 * 256, 256};
                pg8::gemm_phase<pg8::EpiF32, pg8::StaticOrder, true, true, false>(lds + RING_OFF, g3, S3, E3, tid);
            }
            pg8::Gemm g{F == 3 ? WSP(u16, WS_X16B) : (const u16*)(ap->out + (size_t)S * D / 2), WSP(u16, WS_WGU) + (size_t)f * 2 * FF * D, S, 2 * FF, D, D, D}; pg8::StaticOrder So; So.init(S, 2 * FF, G, (int)blockIdx.x, 4);
            pg8::EpiSwiGLU E{WSP(u16, WS_H), FF, WSP(float, WS_RINV)};
            pg8::gemm_phase<pg8::EpiSwiGLU, pg8::StaticOrder, true, true, false>(lds + RING_OFF, g, So, E, tid);
            if constexpr (F == 0) {
                const int b = blockIdx.x, l = (b >> 4) & 1, sp = (b >> 2) & 3;
                pg8::Gemm g2{WSP(u16, WS_MEMN) + (size_t)l * MEM_LEN * D + sp * 512, WSP(u16, WS_WMKV) + (size_t)l * 1024 * D + sp * 512, 256, 1024, 512, D, D}; pg8::StaticOrder S2; S2.init(256, 1024, G, b < 32 ? (b & 3) : 1 << 20);
                pg8::EpiF32 E2{WSP(float, WS_PART) + (size_t)(sp * 2 + l) * MEM_LEN * 1024, 1024};
                pg8::gemm_phase<pg8::EpiF32, pg8::StaticOrder, true, true, false>(lds + RING_OFF, g2, S2, E2, tid);
            }
        }
        PH_END
        PH_BEGIN
        {
            pg8::Gemm g{WSP(u16, WS_H), WSP(u16, WS_WD) + (size_t)f * D * FF, S, D, FF, FF, FF}; pg8::StaticOrder So; So.init(S, D, G, (int)blockIdx.x, 4);
            if constexpr (F == 0) {
                pg8::EpiF16<0> E{WSP(u16, WS_Y), D, nullptr, nullptr};
                pg8::gemm_phase<pg8::EpiF16<0>, pg8::StaticOrder, true, true, false>(lds + RING_OFF, g, So, E, tid); }
            else {
                const float* gpost = ap->in[I_NG] + (size_t)(layer * 6 + ((f & 1) ? 5 : 1)) * D; u16* X = (u16*)(ap->out + (size_t)S * D / 2);
                pg8::EpiResNorm<F == 3> E{F == 3 ? WSP(u16, WS_X16B) : X, F == 3 ? (void*)ap->out : (void*)X, gpost, 0.5f, WSP(unsigned, WS_SLOT), WSP(unsigned, WS_CTL) + CW_RN + (F - 1) * 512, WSP(float, WS_RINV), lds + RING_OFF + 131072};
                pg8::gemm_phase<pg8::EpiResNorm<F == 3>, pg8::StaticOrder, true, true, false>(lds + RING_OFF, g, So, E, tid); }
            if constexpr (F == 0) {
                const f32x4* pm = (const f32x4*)WSP(float, WS_PART);
                for (int e = blockIdx.x * 512 + tid; e < 2 * MEM_LEN * 1024 / 4; e += G * 512) { const f32x4 v = (pm[e] + pm[e + 131072]) + (pm[e + 2 * 131072] + pm[e + 3 * 131072]);
                    u32x2 w; w.x = pkh(v.x, v.y); w.y = pkh(v.z, v.w); ((u32x2*)WSP(u16, WS_MEMKV))[e] = w; }
            }
            if constexpr (F == 2) {
                const f32x4* pc = (const f32x4*)WSP(float, WS_PART);
                for (int e = blockIdx.x * 512 + tid; e < 4 * 1024 * 256 / 4; e += G * 512) { f32x4 v = pc[e];
#pragma unroll
                    for (int sp = 1; sp < 8; ++sp) v = v + pc[e + sp * 262144];
                    const int idx = e >> 16, k4 = (e & 63) * 4; const f32x4 bb = *(const f32x4*)(WSP(float, WS_CB1) + (idx >> 1) * 256 + k4); v = v + bb;
                    u32x2 w; w.x = pkh(pg8::gelu_tanh(v.x), pg8::gelu_tanh(v.y)); w.y = pkh(pg8::gelu_tanh(v.z), pg8::gelu_tanh(v.w)); ((u32x2*)WSP(u16, WS_CMPH))[e] = w; }
            }
        }
        PH_END
        if constexpr (F == 0) {
        PH_BEGIN
        {
            const float* gl = ap->in[I_NG] + (size_t)layer * 6 * D;
            const float* gpost = gl + (size_t)1 * D;
            u16* X = (u16*)(ap->out + (size_t)S * D / 2); const u16* Y = WSP(u16, WS_Y);
            LAS float* wgl = (LAS float*)(lds + RING_OFF);
            for (int e = tid; e < 8 * D / 4; e += 512) ((LAS f32x4*)wgl)[e] = ((const f32x4*)WSP(float, WS_WGA))[e];
            __syncthreads();
            thin_rows<8, true, true>(Y, 0.5f, gpost, X, X, WSP(float, WS_RINV), wgl, ap->in[I_AGB], WSP(float, WS_GA), gw, NGW, lane);
        }
        PH_END
        }

        if constexpr (F == 1) {
            PH_BEGIN
            {
                pg8::Gemm g{(const u16*)(ap->out + (size_t)S * D / 2), WSP(u16, WS_WKV), S, KVW, D, D, D}; pg8::StaticOrder So; So.init(S, KVW, G, (int)blockIdx.x);
                pg8::EpiKV E{WSP(u16, WS_KVRAW), KVW, WSP(u16, WS_KCS), S + 32, WSP(float, WS_RINV)};
                pg8::gemm_phase<pg8::EpiKV, pg8::StaticOrder, true, true, false>(lds + RING_OFF, g, So, E, tid);
                for (int e = blockIdx.x * 512 + tid; e < 4 * 32 * 128 / 2; e += G * 512) WSP(unsigned, WS_KCS)[((size_t)(e >> 11) * (S + 32) + S) * 64 + (e & 2047)] = 0u;
            }
            PH_END
        }
        if constexpr (F == 0 || F == 2) {
            constexpr bool isA = (F == 0);
            PH_BEGIN
            {
                const int ldq = isA ? A_N : B_N;
                pg8::Gemm g{(const u16*)(ap->out + (size_t)S * D / 2), isA ? WSP(u16, WS_WAIN) : WSP(u16, WS_WBIN), S, ldq, D, D, D}; pg8::StaticOrder So; So.init(S, ldq, G, (int)blockIdx.x);
                pg8::EpiF16<0, true> E{isA ? WSP(u16, WS_AOUT) : WSP(u16, WS_BOUT), ldq, nullptr, WSP(float, WS_RINV)};
                pg8::gemm_phase<pg8::EpiF16<0, true>, pg8::StaticOrder, true, true, false>(lds + RING_OFF, g, So, E, tid);
                if constexpr (!isA) {
                    const int b = blockIdx.x, sp = b & 3;
                    pg8::Gemm gg{(const u16*)(ap->out + (size_t)S * D / 2) + sp * 512, WSP(u16, WS_WBIN) + (size_t)2048 * D + sp * 512, S, 256, 512, D, D}; pg8::StaticOrder Sg; Sg.init(S, 256, G, b < 256 ? (b >> 2) : 1 << 20);
                    pg8::EpiF32S<true> Eg{WSP(float, WS_PG) + (size_t)sp * S * 256, 256, WSP(float, WS_RINV)};
                    pg8::gemm_phase<pg8::EpiF32S<true>, pg8::StaticOrder, true, true, false>(lds + RING_OFF, gg, Sg, Eg, tid);
                }
                if constexpr (!isA) {
                {
                    const int fr = lane & 15, fq = lane >> 4;
                    for (int item = wave * G + (int)blockIdx.x; item < 4 * 64; item += NGW) { const int idx = item >> 6, nt = item & 63, c = idx >> 1, gg = idx & 1;
                        h8 hb[8];
#pragma unroll
                        for (int ks = 0; ks < 8; ++ks) hb[ks] = *(const h8*)(WSP(u16, WS_CMPH) + ((size_t)idx * 1024 + nt * 16 + fr) * 256 + ks * 32 + fq * 8);
#pragma unroll
                        for (int dt = 0; dt < 8; ++dt) { f32x4 acc = {0.f, 0.f, 0.f, 0.f};
#pragma unroll
                            for (int ks = 0; ks < 8; ++ks) acc = mma16(*(const h8*)(WSP(u16, WS_WC2) + ((size_t)c * 128 + dt * 16 + fr) * 256 + ks * 32 + fq * 8), hb[ks], acc);
                            if (c == 0) *(h4*)(WSP(u16, WS_KVC) + ((((size_t)gg * 64 + nt) * 4 + (dt >> 1)) * 64 + (2 * (dt & 1) + (fq >> 1)) * 16 + fr) * 8 + 4 * (fq & 1)) = cvt4(acc);
                            else {
#pragma unroll
                                for (int r = 0; r < 4; ++r) WSP(unsigned char, WS_KVC)[(size_t)2 * 1024 * 128 * 2 + ((((size_t)gg * 32 + (nt >> 1)) * 4 + (dt >> 1)) * 64 + (fr >> 2) * 16 + 4 * fq + r) * 16 + (dt & 1) * 8 + (fr & 3) + 4 * (nt & 1)] =
                                    (unsigned char)(__builtin_amdgcn_cvt_pk_fp8_f32(acc[r], acc[r], 0, false) & 0xff); }
                            asm volatile("" ::: "memory"); } }
                }
                    const u16* KVRAW = WSP(u16, WS_KVRAW); const float* ROPE = WSP(float, WS_ROPE);
                    for (int e = blockIdx.x * 512 + tid; e < 2 * 2 * 1024 * 64; e += G * 512) {
                        const int ln = e & 63, kt = (e >> 6) & 1023, gg = (e >> 16) & 1, wh = e >> 17, fr_ = ln & 15, fq_ = ln >> 4, key = kt * 16 + fr_;
                        const u16* src = KVRAW + (size_t)key * KVW + (wh ? 1024 : 512) + gg * 128 + fq_ * 8; const float* cp = ROPE + (size_t)key * 64 + fq_ * 8; const float* sp = cp + (size_t)S * 64;
                        i64_t fr8[4];
#pragma unroll
                        for (int ks = 0; ks < 2; ++ks) { const h8 x1 = *(const h8*)(src + ks * 32), x2 = *(const h8*)(src + ks * 32 + 64); f32x4 a0, a1, b0, b1;
#pragma unroll
                            for (int j = 0; j < 8; ++j) { const float c = cp[ks * 32 + j], sn = sp[ks * 32 + j], v1 = (float)x1[j], v2 = (float)x2[j]; const float r1 = v1 * c - v2 * sn, r2 = v2 * c + v1 * sn;
                                if (j < 4) { a0[j] = r1; b0[j] = r2; } else { a1[j - 4] = r1; b1[j - 4] = r2; } }
                            fr8[ks] = pk8_fp8(a0, a1); fr8[ks + 2] = pk8_fp8(b0, b1); }
                        i64_t* dst = (i64_t*)((wh ? WSP(unsigned char, WS_KWT) : WSP(unsigned char, WS_KST)) + ((((size_t)gg * 1024 + kt) * 2) * 64 + ln) * 16);
                        dst[0] = fr8[0]; dst[1] = fr8[1]; dst[128] = fr8[2]; dst[129] = fr8[3]; }
                    for (int e = blockIdx.x * 512 + tid; e < 2 * 512 * 4 * 64; e += G * 512) {
                        const int ln = e & 63, dp = (e >> 6) & 3, kb = (e >> 8) & 511, gg = e >> 17, fr_ = ln & 15, fq_ = ln >> 4; i64_t o2[2];
#pragma unroll
                        for (int h2_ = 0; h2_ < 2; ++h2_) { const int d = (2 * dp + h2_) * 16 + fr_; const u16* src = KVRAW + (size_t)(kb * 32 + 4 * fq_) * KVW + 1280 + gg * 128 + d; f32x4 a, b2;
#pragma unroll
                            for (int j = 0; j < 4; ++j) { a[j] = (float)*(const f16*)(src + (size_t)j * KVW); b2[j] = (float)*(const f16*)(src + (size_t)(16 + j) * KVW); }
                            o2[h2_] = pk8_fp8(a, b2); }
                        i64_t* dst = (i64_t*)(WSP(unsigned char, WS_VWT) + ((((size_t)gg * 512 + kb) * 4 + dp) * 64 + ln) * 16); dst[0] = o2[0]; dst[1] = o2[1]; }
                    for (int e = blockIdx.x * 512 + tid; e < 2 * 256 * 8 * 64; e += G * 512) {
                        const int ln = e & 63, dt = (e >> 6) & 7, blk = (e >> 9) & 255, gg = e >> 17, fr_ = ln & 15, fq_ = ln >> 4, d = dt * 16 + fr_;
                        const u16* src = KVRAW + (size_t)(blk * 64 + 4 * fq_) * KVW + 768 + gg * 128 + d; i64_t o2[2];
#pragma unroll
                        for (int kb = 0; kb < 2; ++kb) { f32x4 a, b2;
#pragma unroll
                            for (int j = 0; j < 4; ++j) { a[j] = (float)*(const f16*)(src + (size_t)(kb * 32 + j) * KVW); b2[j] = (float)*(const f16*)(src + (size_t)(kb * 32 + 16 + j) * KVW); }
                            o2[kb] = pk8_fp8(a, b2); }
                        i64_t* dst = (i64_t*)(WSP(unsigned char, WS_VST) + ((((size_t)gg * 256 + blk) * 8 + dt) * 64 + ln) * 16); dst[0] = o2[0]; dst[1] = o2[1]; }
                }
            }
            PH_END
            if constexpr (isA) {
                PH_BEGIN
                {
                    const u16* AOUT = WSP(u16, WS_AOUT); const float* GA = WSP(float, WS_GA); u16* CT = WSP(u16, WS_CT);
                    mem_attn_mfma(AOUT, A_N, 4608, WSP(u16, WS_MEMKV), WSP(u16, WS_XN), lds + RING_OFF, tid, G);
                    const int fr = lane & 15, fq = lane >> 4;
                    LAS f16* KT = (LAS f16*)(lds + RING_OFF);
                    LAS f16* VT = (LAS f16*)(lds + RING_OFF + 27648);
                    LAS float* fv = (LAS float*)(lds + RING_OFF + 27648 + 55296);
                    h8 pk_[3], pv_[6];
#define ML_LOC_LOAD(u_) do { const int h_ = (u_) >> 8, t0_ = ((u_) & 255) * ML_L; const int tid_ = wave * 64 + lane_id_v();     \
                        _Pragma("unroll") for (int i = 0; i < 3; ++i) { const int e = tid_ + i * 512, s_ = e & 63, cc = e >> 6; pk_[i] = *(const h8*)(AOUT + (size_t)(t0_ + s_) * A_N + 768 + h_ * 192 + cc * 8); } \
                        _Pragma("unroll") for (int i = 0; i < 6; ++i) { const int e = tid_ + i * 512, s_ = e & 63, cc = e >> 6; pv_[i] = *(const h8*)(AOUT + (size_t)(t0_ + s_) * A_N + 1536 + h_ * 384 + cc * 8); } } while (0)
                    if ((int)blockIdx.x < ML_H * ML_NC) ML_LOC_LOAD((int)blockIdx.x);
                    for (int u = blockIdx.x; u < ML_H * ML_NC; u += G) {
                        const int h = u >> 8, c = u & 255, t0 = c * ML_L;
                        __syncthreads();
                        if (tid < 64) { const int t = t0 + tid;
                            const float b = wave_scan_add(log_sigmoidf_(GA[(size_t)t * 8 + 4 + h]), tid), ic = GA[(size_t)t * 8 + h];
                            const float b63 = __shfl(b, 63), gsv = b63 - b + ic, ml = wave_max(gsv);
                            fv[128 + tid] = __expf(gsv - ml);
                            if (tid == 0) { WSP(float, WS_B63)[u] = b63; WSP(float, WS_MLOC)[u] = ml; } }
                        __syncthreads();
#pragma unroll
                        for (int i = 0; i < 3; ++i) { const int e = tid + i * 512, s = e & 63, cc = e >> 6; const float wsc = fv[128 + s]; const h8 kv = pk_[i];
#pragma unroll
                            for (int j = 0; j < 8; ++j) KT[(cc * 8 + j) * 72 + s] = (f16)((float)kv[j] * wsc); }
#pragma unroll
                        for (int i = 0; i < 6; ++i) { const int e = tid + i * 512, s = e & 63, cc = e >> 6; const h8 vv = pv_[i];
#pragma unroll
                            for (int j = 0; j < 8; ++j) VT[(cc * 8 + j) * 72 + s] = vv[j]; }
                        if (u + G < ML_H * ML_NC) ML_LOC_LOAD(u + G);
                        __syncthreads();
                        h8 bf[3][2];
#pragma unroll
                        for (int vi = 0; vi < 3; ++vi)
#pragma unroll
                            for (int ks = 0; ks < 2; ++ks) bf[vi][ks] = *(const LAS h8*)(VT + ((wave * 3 + vi) * 16 + fr) * 72 + ks * 32 + fq * 8);
                        u16* ctu = CT + (size_t)u * ML_DV * ML_DQK;
#pragma unroll 2
                        for (int di = 0; di < 12; ++di) {
                            const h8 a0 = *(const LAS h8*)(KT + (di * 16 + fr) * 72 + fq * 8), a1 = *(const LAS h8*)(KT + (di * 16 + fr) * 72 + 32 + fq * 8);
#pragma unroll
                            for (int vi = 0; vi < 3; ++vi) { f32x4 acc = {0.f, 0.f, 0.f, 0.f}; acc = mma16(a0, bf[vi][0], acc); acc = mma16(a1, bf[vi][1], acc);
                                *(h4*)(ctu + ((size_t)((wave * 3 + vi) * 6 + (di >> 1)) * 64 + (2 * (di & 1) + (fq >> 1)) * 16 + fr) * 8 + 4 * (fq & 1)) = cvt4(acc); } }
                        if (tid < ML_DQK) { float a = 0.f; for (int s = 0; s < 64; ++s) a += (float)KT[tid * 72 + s]; WSP(float, WS_DN)[(size_t)u * ML_DQK + tid] = a; }
                    }
                }
                PH_END
                PH_BEGIN
                {
                    const float* B63 = WSP(float, WS_B63); const float* MLOC = WSP(float, WS_MLOC);
                    LAS float* dec = (LAS float*)(lds + RING_OFF); LAS float* scl = dec + 256;
                    constexpr int PER_HEAD = ML_DV * ML_DQK / 4;
                    for (int e0 = blockIdx.x * 512; e0 < ML_H * PER_HEAD; e0 += G * 512) {
                        const int h = e0 / PER_HEAD;
                        __syncthreads();
#define WRITE_MST (e0 % PER_HEAD == 0)
                        if (tid < 64) {
                            float bb[4], mm[4], A = -3.0e38f, B = 0.f;
#pragma unroll
                            for (int j = 0; j < 4; ++j) { bb[j] = B63[h * 256 + 4 * tid + j]; mm[j] = MLOC[h * 256 + 4 * tid + j]; A = fmaxf(mm[j], bb[j] + A); B += bb[j]; }
#pragma unroll
                            for (int o = 1; o < 64; o <<= 1) { const float Ae = __shfl_up(A, o), Be = __shfl_up(B, o); if (tid >= o) { A = fmaxf(A, B + Ae); B += Be; } }
                            float Ax = __shfl_up(A, 1), Bx = __shfl_up(B, 1); if (tid == 0) { Ax = -3.0e38f; Bx = 0.f; }
                            float m = fmaxf(Ax, Bx);
#pragma unroll
                            for (int j = 0; j < 4; ++j) { const float mn = fmaxf(mm[j], bb[j] + m); dec[4 * tid + j] = __expf(bb[j] + m - mn); scl[4 * tid + j] = __expf(mm[j] - mn);
                                if (WRITE_MST) WSP(float, WS_MST)[h * 256 + 4 * tid + j] = m; m = mn; } }
                        __syncthreads();
#undef WRITE_MST
                        u32x2* p = WSP(u32x2, WS_CT) + (size_t)h * ML_NC * PER_HEAD + (e0 - h * PER_HEAD) + tid;
                        f32x4 cs = {0.f, 0.f, 0.f, 0.f};
                        for (int c = 0; c < ML_NC; c += 32) { u32x2 dv[32];
#pragma unroll
                            for (int j = 0; j < 32; ++j) dv[j] = p[(size_t)(c + j) * PER_HEAD];
#pragma unroll
                            for (int j = 0; j < 32; ++j) { const f32x4 d4 = __builtin_convertvector(__builtin_bit_cast(h4, dv[j]), f32x4); u32x2 w; w.x = pkh(cs.x, cs.y); w.y = pkh(cs.z, cs.w); p[(size_t)(c + j) * PER_HEAD] = w;
                                cs = cs * dec[c + j] + d4 * scl[c + j]; } }
                    }
                    if (blockIdx.x < ML_H) { const int h = blockIdx.x;
                        __syncthreads();
#define WRITE_MST false
                        if (tid < 64) {
                            float bb[4], mm[4], A = -3.0e38f, B = 0.f;
#pragma unroll
                            for (int j = 0; j < 4; ++j) { bb[j] = B63[h * 256 + 4 * tid + j]; mm[j] = MLOC[h * 256 + 4 * tid + j]; A = fmaxf(mm[j], bb[j] + A); B += bb[j]; }
#pragma unroll
                            for (int o = 1; o < 64; o <<= 1) { const float Ae = __shfl_up(A, o), Be = __shfl_up(B, o); if (tid >= o) { A = fmaxf(A, B + Ae); B += Be; } }
                            float Ax = __shfl_up(A, 1), Bx = __shfl_up(B, 1); if (tid == 0) { Ax = -3.0e38f; Bx = 0.f; }
                            float m = fmaxf(Ax, Bx);
#pragma unroll
                            for (int j = 0; j < 4; ++j) { const float mn = fmaxf(mm[j], bb[j] + m); dec[4 * tid + j] = __expf(bb[j] + m - mn); scl[4 * tid + j] = __expf(mm[j] - mn);
                                if (WRITE_MST) WSP(float, WS_MST)[h * 256 + 4 * tid + j] = m; m = mn; } }
                        __syncthreads();
#undef WRITE_MST
                        if (tid < ML_DQK) { float n = 0.f; float* q = WSP(float, WS_DN) + (size_t)h * 256 * ML_DQK + tid;
                            for (int c = 0; c < ML_NC; c += 16) { float dv[16];
#pragma unroll
                                for (int j = 0; j < 16; ++j) dv[j] = q[(size_t)(c + j) * ML_DQK];
#pragma unroll
                                for (int j = 0; j < 16; ++j) { q[(size_t)(c + j) * ML_DQK] = n; n = dec[c + j] * n + scl[c + j] * dv[j]; } } }
                    }
                }
                PH_END
                PH_BEGIN
                {
                    const u16* AOUT = WSP(u16, WS_AOUT); const float* GA = WSP(float, WS_GA); u16* XN = WSP(u16, WS_XN);
                    const int fr = lane & 15, fq = lane >> 4;
                    LAS f16* Qs = (LAS f16*)(lds + RING_OFF);
                    LAS f16* Ks = (LAS f16*)(lds + RING_OFF + 25600);
                    LAS f16* VT = (LAS f16*)(lds + RING_OFF + 51200);
                    LAS f16* Sm = (LAS f16*)(lds + RING_OFF + 106496);
                    LAS float* fv = (LAS float*)(lds + RING_OFF + 115712);
                    h8 rq[3], rk[3], rv[6];
#define ML_OUT_LOAD(u_) do { const int h_ = (u_) >> 8, t0_ = ((u_) & 255) * ML_L; const int tid_ = wave * 64 + lane_id_v();     \
                        _Pragma("unroll") for (int i = 0; i < 3; ++i) { const int e = tid_ + i * 512, s_ = e / 24, cc = e % 24; \
                            rq[i] = *(const h8*)(AOUT + (size_t)(t0_ + s_) * A_N + h_ * 192 + cc * 8); rk[i] = *(const h8*)(AOUT + (size_t)(t0_ + s_) * A_N + 768 + h_ * 192 + cc * 8); } \
                        _Pragma("unroll") for (int i = 0; i < 6; ++i) { const int e = tid_ + i * 512, s_ = e & 63, cc = e >> 6; \
                            rv[i] = *(const h8*)(AOUT + (size_t)(t0_ + s_) * A_N + 1536 + h_ * 384 + cc * 8); } } while (0)
                    if ((int)blockIdx.x < ML_H * ML_NC) ML_OUT_LOAD((int)blockIdx.x);
                    for (int u = blockIdx.x; u < ML_H * ML_NC; u += G) {
                        const int h = u >> 8, c = u & 255, t0 = c * ML_L;
                        const u16* ctp = WSP(u16, WS_CT) + (size_t)u * ML_DV * ML_DQK;
                        h8 aCall[3][6];
#pragma unroll
                        for (int vi = 0; vi < 3; ++vi)
#pragma unroll
                            for (int ks = 0; ks < 6; ++ks) aCall[vi][ks] = *(const h8*)(ctp + ((size_t)((wave * 3 + vi) * 6 + ks) * 64 + lane) * 8);
                        __syncthreads();
                        if (tid < 64) { const int t = t0 + tid; const float mc = WSP(float, WS_MST)[u];
                            const float b = wave_scan_add(log_sigmoidf_(GA[(size_t)t * 8 + 4 + h]), tid), a = GA[(size_t)t * 8 + h] - b;
                            const float mx = fmaxf(wave_scan_max(a, tid), mc);
                            fv[tid] = b; fv[64 + tid] = a; fv[128 + tid] = mx; fv[192 + tid] = __expf(mc - mx); fv[320 + tid] = 0.f; }
#pragma unroll
                        for (int i = 0; i < 3; ++i) { const int e = tid + i * 512, s = e / 24, cc = e % 24;
                            *(LAS h8*)(Qs + s * 200 + cc * 8) = rq[i]; *(LAS h8*)(Ks + s * 200 + cc * 8) = rk[i]; }
#pragma unroll
                        for (int i = 0; i < 6; ++i) { const int e = tid + i * 512, s = e & 63, cc = e >> 6; const h8 vv = rv[i];
#pragma unroll
                            for (int j = 0; j < 8; ++j) VT[(cc * 8 + j) * 72 + s] = vv[j]; }
                        if (u + G < ML_H * ML_NC) ML_OUT_LOAD(u + G);
                        __syncthreads();
#pragma unroll
                        for (int q2 = 0; q2 < 2; ++q2) { const int tl = wave * 2 + q2, si = tl >> 2, tj = tl & 3; f32x4 acc = {0.f, 0.f, 0.f, 0.f};
#pragma unroll
                            for (int ks = 0; ks < 6; ++ks) acc = mma16(*(const LAS h8*)(Ks + (si * 16 + fr) * 200 + ks * 32 + fq * 8), *(const LAS h8*)(Qs + (tj * 16 + fr) * 200 + ks * 32 + fq * 8), acc);
                            const int t = tj * 16 + fr; const float mxt = fv[128 + t];
#pragma unroll
                            for (int r = 0; r < 4; ++r) { const int sx = si * 16 + 4 * fq + r; acc[r] = (sx <= t) ? acc[r] * __expf(fv[64 + sx] - mxt) : 0.f; }
                            *(LAS h4*)(Sm + t * 72 + si * 16 + 4 * fq) = cvt4(acc); }
                        __syncthreads();
                        { const int t = tid >> 3, part = tid & 7; float den = 0.f, qn = 0.f; const float* np = WSP(float, WS_DN) + (size_t)u * ML_DQK;
#pragma unroll
                            for (int s8 = 0; s8 < 8; ++s8) den += (float)Sm[t * 72 + part * 8 + s8];
                            for (int d = part * 24; d < part * 24 + 24; ++d) qn += (float)Qs[t * 200 + d] * np[d];
                            den += fv[192 + t] * qn;
                            den += __shfl_xor(den, 1); den += __shfl_xor(den, 2); den += __shfl_xor(den, 4);
                            if (part == 0) { const float mvec = fv[t] + fv[128 + t]; fv[256 + t] = fmaxf(fabsf(den), __expf(-mvec)); } }
                        __syncthreads();
                        h4 hv[3][4]; float ssq[4] = {0.f, 0.f, 0.f, 0.f};
#pragma unroll
                        for (int vi = 0; vi < 3; ++vi) { const int vt = wave * 3 + vi; h8 aV[2]; const h8 (&aC)[6] = aCall[vi];
#pragma unroll
                            for (int ks = 0; ks < 2; ++ks) aV[ks] = *(const LAS h8*)(VT + (vt * 16 + fr) * 72 + ks * 32 + fq * 8);
#pragma unroll
                            for (int tj = 0; tj < 4; ++tj) { const int tt = tj * 16 + fr; f32x4 a1 = {0.f, 0.f, 0.f, 0.f}, a2 = {0.f, 0.f, 0.f, 0.f};
#pragma unroll
                                for (int ks = 0; ks < 2; ++ks) a1 = mma16(aV[ks], *(const LAS h8*)(Sm + tt * 72 + ks * 32 + fq * 8), a1);
#pragma unroll
                                for (int ks = 0; ks < 6; ++ks) a2 = mma16(aC[ks], *(const LAS h8*)(Qs + tt * 200 + ks * 32 + fq * 8), a2);
                                const f32x4 hx = (a1 + a2 * fv[192 + tt]) * (1.0f / fv[256 + tt]); hv[vi][tj] = cvt4(hx); ssq[tj] += (hx[0] * hx[0] + hx[1] * hx[1]) + (hx[2] * hx[2] + hx[3] * hx[3]); }
                            asm volatile("" ::: "memory"); }
#pragma unroll
                        for (int tj = 0; tj < 4; ++tj) { const float q = quad_sum(ssq[tj]); if (fq == 0) fv[384 + wave * 64 + tj * 16 + fr] = q; }
                        h4 ogv[4][3];
#pragma unroll
                        for (int tj = 0; tj < 4; ++tj)
#pragma unroll
                            for (int vi = 0; vi < 3; ++vi) ogv[tj][vi] = *(const h4*)(AOUT + (size_t)(t0 + tj * 16 + (lane_id_v() & 15)) * A_N + 3072 + h * ML_DV + (wave * 3 + vi) * 16 + 4 * (lane_id_v() >> 4));
                        __syncthreads();
                        if (tid < 64) { float q = 0.f;
#pragma unroll
                            for (int w8 = 0; w8 < 8; ++w8) q += fv[384 + w8 * 64 + tid];
                            fv[320 + tid] = q; }
                        __syncthreads();
#pragma unroll
                        for (int tj = 0; tj < 4; ++tj) { const int tt = tj * 16 + fr; const float rn = rsqrtf(fv[320 + tt] * (1.0f / ML_DV) + EPS);
#pragma unroll
                            for (int vi = 0; vi < 3; ++vi) { const int v0 = (wave * 3 + vi) * 16 + 4 * fq;
                                const h4 og = ogv[tj][vi]; const f32x4 hn = *(const f32x4*)(ap->in[I_AHN] + h * ML_DV + v0); f32x4 o;
#pragma unroll
                                for (int r = 0; r < 4; ++r) o[r] = (float)hv[vi][tj][r] * rn * hn[r] * sigmoidf_((float)og[r]);
                                *(h4*)(XN + (size_t)(t0 + tt) * D + h * ML_DV + v0) = cvt4(o); }
                            asm volatile("" ::: "memory"); }
                    }
                }
                PH_END
            } else {
                PH_BEGIN
                {
                    const u16* BOUT = WSP(u16, WS_BOUT); u16* XN = WSP(u16, WS_XN);
                    mem_attn_mfma(BOUT, B_N, 1536, WSP(u16, WS_MEMKV) + (size_t)MEM_LEN * 1024, XN, lds + RING_OFF, tid, G);
                    LAS float* psl = (LAS float*)(lds + RING_OFF + wave * WAVE_LDS);
                    const int wrank = wave < 4 ? wave : 11 - wave;
                    for (int item = wrank * G + (int)blockIdx.x; item < (S / 16) * 2; item += NGW)
                        nsa_tile((S / 16 - 1 - (item >> 1)) * 16, item & 1, BOUT, WSP(unsigned char, WS_KWT), WSP(u16, WS_KVC), WSP(unsigned char, WS_KVC) + (size_t)2 * 1024 * 128 * 2, WSP(unsigned char, WS_VWT),
                                 WSP(float, WS_PG), ap->in[I_BGB], WSP(float, WS_ROPE), XN, WSP(int, WS_SEL), psl, lane_id_v());
                }
                PH_END
                PH_BEGIN
                {
                    const int g = blockIdx.x & 1;
                    const int strm = (int)((blockIdx.x >> 1) + wave) & 7;
                    gu32* ctr = (gu32*)(ws + WS_CTL) + CW_SLC + (g * 8 + strm) * 64;
                    int n = 0; if (lane == 0) n = (int)__hip_atomic_fetch_add(ctr, 1u, RLX_AGENT); n = __builtin_amdgcn_readfirstlane(n);
                    while (n < S / 8) {
                        int nn = 0; if (lane == 0) nn = (int)__hip_atomic_fetch_add(ctr, 1u, RLX_AGENT);
                        nsa_slc_token(n * 8 + strm, g, WSP(u16, WS_BOUT), WSP(unsigned char, WS_KST), WSP(unsigned char, WS_VST), WSP(float, WS_PG), ap->in[I_BGB], WSP(float, WS_ROPE), WSP(u16, WS_XN), WSP(int, WS_SEL), lane_id_v());
                        n = __builtin_amdgcn_readfirstlane(nn); }
                }
                PH_END
            }
            PH_BEGIN
            {
                pg8::Gemm g{WSP(u16, WS_XN), WSP(u16, WS_WOUT) + (size_t)layer * D * D, S, D, D, D, D}; pg8::StaticOrder So; So.init(S, D, G, (int)blockIdx.x, 4);
                u16* X = (u16*)(ap->out + (size_t)S * D / 2);
                pg8::EpiResNorm<false> E{X, isA ? (void*)X : (void*)WSP(u16, WS_X16B), ap->in[I_NG] + (size_t)(layer * 6 + 3) * D, 1.0f, WSP(unsigned, WS_SLOT), WSP(unsigned, WS_CTL) + CW_RN + (isA ? 3 : 4) * 512, WSP(float, WS_RINV), lds + RING_OFF + 131072};
                pg8::gemm_phase<pg8::EpiResNorm<false>, pg8::StaticOrder, true, true, false>(lds + RING_OFF, g, So, E, tid);
            }
            PH_END
        }

}

__global__ void __launch_bounds__(NWAVES * 64, 2) yoco_fwd(Args args) {
    extern __shared__ __attribute__((aligned(16))) unsigned char lds_raw[];
    LAS unsigned char* lds = (LAS unsigned char*)lds_raw;
    const int G = gridDim.x;
    { volatile LAS unsigned* MISC0 = (volatile LAS unsigned*)(lds + LDSCTL_OFF);
      for (int u = threadIdx.x; u < LDSCTL_BYTES / 4; u += NWAVES * 64) MISC0[u] = 0u; }
    __syncthreads();
    const int wave_id = __builtin_amdgcn_readfirstlane((int)threadIdx.x >> 6);
    XcdBarrier bar; bar.bar = (unsigned*)(args.ws + WS_CTL) + CW_BAR; bar.x = 0; bar.st = nullptr;
    if (!MK_PER_PHASE) bar = xcd_barrier_post((unsigned*)(args.ws + WS_CTL) + CW_BAR, (volatile LAS unsigned*)(lds + MISC_OFF) + 8, wave_id * 64 + lane_id_v());

    const int lo = args.ph_lo, hi = args.ph_hi; unsigned char* const ws0 = args.ws;
    int ph = 0; unsigned long long probe_acc = 0ull;
    PH_BEGIN
    {
        LAS float* scr = (LAS float*)(lds + RING_OFF + wave * WAVE_LDS);
        constexpr int J_FF = 1408;
        constexpr int J_AIN = 16 * 80, J_WOUT = 512, J_WKVI = 16 * 24, J_BIN = 512, J_MKV = 256, J_C1 = 128, J_C2 = 4;
        constexpr int NIT = 12 * J_FF + J_AIN + 2 * J_WOUT + J_WKVI + J_BIN + 2 * J_MKV + 2 * J_C1 + 2 * J_C2;
        for (int it = gw; it < NIT; it += NGW) {
            int r = it;
            if (r < 12 * J_FF) { const int job = r / J_FF, idx = job / 3, kind = job % 3; r -= job * J_FF;
                if (kind < 2) { const int nblk = FF / 64, kb = r / nblk, nb = r % nblk, n0 = nb * 64;
                    cvt_item(ap->in[kind == 0 ? I_WG : I_WU] + (size_t)idx * D * FF, FF, n0, kb * 128, WSP(u16, WS_WGU) + (size_t)idx * 2 * FF * D, D, 256 * (n0 >> 7) + (n0 & 127) + (kind ? 128 : 0), 1.0f, ap->in[I_NG] + (size_t)((idx >> 1) * 6 + (idx & 1) * 4) * D, scr, lane); }
                else { const int nblk = D / 64, kb = r / nblk, nb = r % nblk;
                    cvt_item(ap->in[I_WDN] + (size_t)idx * FF * D, D, nb * 64, kb * 128, WSP(u16, WS_WD) + (size_t)idx * D * FF, FF, nb * 64, 1.0f, nullptr, scr, lane); }
                continue; }
            r -= 12 * J_FF;
            if (r < J_AIN) { const int nblk = A_N / 64, kb = r / nblk, nb = r % nblk, n0 = nb * 64;
                cvt_item(ap->in[I_AWIN], A_INW, n0 < 4608 ? n0 : n0 + 8, kb * 128, WSP(u16, WS_WAIN), D, n0, (n0 >= 768 && n0 < 1536) ? 0.07216878364870322f : 1.0f, ap->in[I_NG] + (size_t)2 * D, scr, lane); continue; }
            r -= J_AIN;
            if (r < 2 * J_WOUT) { const int l = r / J_WOUT; r -= l * J_WOUT; const int nblk = D / 64, kb = r / nblk, nb = r % nblk;
                cvt_item(ap->in[I_WOUT] + (size_t)l * D * D, D, nb * 64, kb * 128, WSP(u16, WS_WOUT) + (size_t)l * D * D, D, nb * 64, 1.0f, nullptr, scr, lane); continue; }
            r -= 2 * J_WOUT;
            if (r < J_WKVI) { const int nblk = KVW / 64, kb = r / nblk, nb = r % nblk;
                cvt_item(ap->in[I_WKV], KVW, nb * 64, kb * 128, WSP(u16, WS_WKV), D, nb * 64, 1.0f, ap->in[I_KVN], scr, lane); continue; }
            r -= J_WKVI;
            if (r < J_BIN) { const int nblk = 2048 / 64, kb = r / nblk, nb = r % nblk, n0 = nb * 64;
                cvt_item(ap->in[I_BWIN], B_INW, n0 < 1536 ? n0 : n0 + 36, kb * 128, WSP(u16, WS_WBIN), D, n0, 1.0f, ap->in[I_NG] + (size_t)8 * D, scr, lane); continue; }
            r -= J_BIN;
            if (r < 2 * J_MKV) { const int l = r / J_MKV; r -= l * J_MKV; const int nblk = 1024 / 64, kb = r / nblk, nb = r % nblk;
                cvt_item(ap->in[I_MEMWKV] + (size_t)l * D * 1024, 1024, nb * 64, kb * 128, WSP(u16, WS_WMKV) + (size_t)l * 1024 * D, D, nb * 64, 1.0f, nullptr, scr, lane); continue; }
            r -= 2 * J_MKV;
            if (r < 2 * J_C1) { const int c = r / J_C1; r -= c * J_C1; const int nblk = 256 / 64, kb = r / nblk, nb = r % nblk;
                cvt_item(ap->in[I_CW1] + (size_t)c * 4096 * 256, 256, nb * 64, kb * 128, WSP(u16, WS_WC1) + (size_t)c * 256 * 4096, 4096, nb * 64, 1.0f, nullptr, scr, lane); continue; }
            r -= 2 * J_C1;
            { const int c = r / J_C2; r -= c * J_C2; const int nblk = 128 / 64, kb = r / nblk, nb = r % nblk;
                cvt_item(ap->in[I_CW2] + (size_t)c * 256 * 128, 128, nb * 64, kb * 128, WSP(u16, WS_WC2) + (size_t)c * 128 * 256, 256, nb * 64, 1.0f, nullptr, scr, lane); }
        }
        for (int it = wave * G + (int)blockIdx.x; it < 2 * MEM_LEN; it += NGW) { const int l = it >> 8, m = it & 255;
            const GAS f32x4* xr = (const GAS f32x4*)(ap->in[I_MEM] + (size_t)m * D) + lane; f32x4 v[8]; float ss = 0.f;
#pragma unroll
            for (int j = 0; j < 8; ++j) { v[j] = xr[64 * j]; ss += (v[j].x * v[j].x + v[j].y * v[j].y) + (v[j].z * v[j].z + v[j].w * v[j].w); }
            const float rr = rsqrtf(wave_sum(ss) * (1.0f / D) + EPS);
            GAS u32x2* o = (GAS u32x2*)(WSP(u16, WS_MEMN) + ((size_t)l * MEM_LEN + m) * D) + lane;
#pragma unroll
            for (int j = 0; j < 8; ++j) { const f32x4 g = ((const GAS f32x4*)(ap->in[I_MEMNORM] + (size_t)l * D))[lane + 64 * j]; const f32x4 w = v[j] * rr * g; u32x2 pk; pk.x = pkh(w.x, w.y); pk.y = pkh(w.z, w.w); o[64 * j] = pk; } }
        for (int e = blockIdx.x * 512 + tid; e < 8 * D; e += G * 512) { const int gi = e / D, k = e % D; WSP(float, WS_WGA)[gi * D + k] = ap->in[I_AWIN][(size_t)k * A_INW + 4608 + gi] * ap->in[I_NG][2 * D + k]; }
        for (int e = blockIdx.x * 512 + tid; e < 256 * D; e += G * 512) { const int rr = e / D, k = e % D;
            *(f16*)(WSP(u16, WS_WBIN) + (size_t)(2048 + rr) * D + k) = (f16)(rr < 36 ? ap->in[I_BWIN][(size_t)k * B_INW + 1536 + rr] * ap->in[I_NG][8 * D + k] : 0.f); }
        for (int it = (7 - wave) * G + (int)blockIdx.x; it < 512; it += NGW) { const int c = it >> 8, j = it & 255; float a = 0.f;
            for (int k = lane; k < 4096; k += 64) a += ap->in[I_CPOS][c * 4096 + k] * ap->in[I_CW1][((size_t)c * 4096 + k) * 256 + j];
            a = wave_sum(a); if (lane == 0) WSP(float, WS_CB1)[it] = a; }
        for (int e = blockIdx.x * 512 + tid; e < S * 64; e += G * 512) { const int t = e >> 6, i = e & 63;
            const float inv = exp2f(-(float)(2 * i) * (13.287712379549449f / 128.0f)); const float ang = (float)t * inv;
            const double k = rint((double)ang * 0.15915494309189535); const float rr = (float)((double)ang - k * 6.283185307179586);
            WSP(float, WS_ROPE)[e] = __cosf(rr); WSP(float, WS_ROPE)[S * 64 + e] = __sinf(rr); }
        thin_rows<0, false, true>(nullptr, 0.f, nullptr, ap->in[I_X], (u16*)(ap->out + (size_t)S * D / 2), WSP(float, WS_RINV), nullptr, nullptr, nullptr, gw, NGW, lane);
    }
    PH_END

    Ctx cx; cx.lds = lds; cx.ws0 = ws0; cx.G = G; cx.lo = lo; cx.hi = hi; cx.wave_id = wave_id; cx.bar = bar;
    ffn_stage<0>(cx, ph, probe_acc); ffn_stage<1>(cx, ph, probe_acc); ffn_stage<2>(cx, ph, probe_acc); ffn_stage<3>(cx, ph, probe_acc);
    if (PROBE_MASK != 0u && blockIdx.x == 0 && wave_id == 0 && lane_id_v() == 0) { const unsigned long long t0 = __builtin_amdgcn_s_memrealtime(); while (__builtin_amdgcn_s_memrealtime() - t0 < probe_acc * PROBE_MULT) __builtin_amdgcn_s_sleep(32); }
}
#undef PH_BEGIN
#undef PH_END


constexpr int N_PHASES = 1 + 4 * 2 + 1 + 1 + 2 * 2 + 3 + 2;

extern "C" void kernel_launch(void* const* d_in, const int* in_sizes, int n_in, void* d_out, int out_size, void* d_ws, size_t ws_size, hipStream_t stream) {
    static int grid = 0;
    if (grid == 0) {
        if (n_in != 19 || in_sizes[0] != S * D || out_size != S * D || ws_size < WS_END) { fprintf(stderr, "kernel_launch: unexpected shapes: n_in %d in0 %d out %d ws %zu (need %zu)\n", n_in, n_in > 0 ? in_sizes[0] : -1, out_size, ws_size, (size_t)WS_END); grid = -1; return; }
        int dev = 0, cus = 0, per_cu = 0;
        if (hipGetDevice(&dev) != hipSuccess || hipDeviceGetAttribute(&cus, hipDeviceAttributeMultiprocessorCount, dev) != hipSuccess) { grid = -1; return; }
        if (hipFuncSetAttribute((const void*)yoco_fwd, hipFuncAttributeMaxDynamicSharedMemorySize, LDS_BYTES) != hipSuccess) { fprintf(stderr, "kernel_launch: hipFuncSetAttribute failed\n"); grid = -1; return; }
        if (hipOccupancyMaxActiveBlocksPerMultiprocessor(&per_cu, (const void*)yoco_fwd, NWAVES * 64, LDS_BYTES) != hipSuccess || per_cu < 1) { fprintf(stderr, "kernel_launch: occupancy query reports %d\n", per_cu); (void)hipGetLastError(); grid = -1; return; }
        grid = cus;
    }
    if (grid < 0) return;
    (void)hipMemsetAsync((char*)d_ws + WS_CTL, 0, CTL_ZERO_BYTES, stream);
    Args a{};
    for (int i = 0; i < 19; ++i) a.in[i] = (const float*)d_in[i];
    a.out = (float*)d_out; a.ws = (unsigned char*)d_ws;
#if MK_PER_PHASE
    for (int p = 0; p < N_PHASES; ++p) { a.ph_lo = p; a.ph_hi = p + 1; a.li = p; hipLaunchKernelGGL(yoco_fwd, dim3(grid), dim3(NWAVES * 64), LDS_BYTES, stream, a); }
#else
    a.ph_lo = 0; a.ph_hi = N_PHASES; a.li = 0;
    hipLaunchKernelGGL(yoco_fwd, dim3(grid), dim3(NWAVES * 64), LDS_BYTES, stream, a);
#endif
}
```

```cpp
#include <hip/hip_runtime.h>
#include <cstdio>
#include <cstdint>
#include <type_traits>

#ifndef MK_PER_PHASE
#define MK_PER_PHASE 0
#endif

#ifndef PROBE_MASK
#define PROBE_MASK 0u
#endif
#ifndef PROBE_MULT
#define PROBE_MULT 4
#endif

#define LAS __attribute__((address_space(3)))
#define GAS __attribute__((address_space(1)))
typedef unsigned short u16;
typedef _Float16 f16;
typedef _Float16 h8 __attribute__((ext_vector_type(8)));
typedef _Float16 h4 __attribute__((ext_vector_type(4)));
typedef _Float16 h2 __attribute__((ext_vector_type(2)));
typedef float f32x4 __attribute__((ext_vector_type(4)));
typedef float f32x2 __attribute__((ext_vector_type(2)));
typedef unsigned u32x4 __attribute__((ext_vector_type(4)));
typedef unsigned u32x2 __attribute__((ext_vector_type(2)));

__device__ __forceinline__ int lane_id_v() { int l; asm volatile("v_mbcnt_lo_u32_b32 %0, -1, 0\n\tv_mbcnt_hi_u32_b32 %0, -1, %0" : "=v"(l)); return l; }
__device__ __forceinline__ unsigned pkh(float a, float b) { h2 v = __builtin_convertvector((f32x2){a, b}, h2); return __builtin_bit_cast(unsigned, v); }

namespace pg8 {
#define PG8_LAS __attribute__((address_space(3)))
constexpr int BM = 256, BK = 64, HALF = 128, HTB = HALF * BK * 2, STAGE_BYTES = 8 * HTB, NXCD = 8, WGM = 8;
__host__ __device__ __forceinline__ int lds_byte(int r, int c) { const int st = (r >> 4) * 2 + (c >> 5), rr = r & 15, cc = c & 31, ob = rr * 64 + cc * 2; return st * 1024 + (ob ^ (((ob >> 9) & 1) << 5)); }
__host__ __device__ __forceinline__ void stage_rc(int b, int& R, int& C) { const int st = b / 1024, sb = b % 1024, swz = sb ^ (((sb >> 9) & 1) << 5); R = (st >> 1) * 16 + swz / 64; C = (st & 1) * 32 + (swz % 64) / 2; }
__host__ __device__ __forceinline__ int perm32(int rho) { const int n = rho >> 4, i = rho & 15; return 8 * (i >> 2) + 4 * n + (i & 3); }

struct Unit { int pm, pn; };
struct Gemm { const u16* A; const u16* Bt; int M, N, K, lda, ldb; };

struct StaticOrder {
    int nM, nN, nwg, G, c, wgm;
    __host__ __device__ void init(int M, int N, int G_, int c_, int wgm_ = WGM) { nM = M / BM; nN = N / BM; nwg = nM * nN; G = G_; c = c_; wgm = wgm_; }
    __host__ __device__ bool next(int i, Unit& u) const {
        const long L = (long)i * G + c; if (L >= nwg) return false;
        int wgid = (int)L; { const int q = nwg / NXCD, r = nwg % NXCD, xcd = wgid % NXCD, off = wgid / NXCD; wgid = (xcd < r ? xcd * (q + 1) : r * (q + 1) + (xcd - r) * q) + off; }
        const int nig = wgm * nN, gid = wgid / nig, fm = gid * wgm, gsz = (nM - fm) < wgm ? (nM - fm) : wgm;
        u.pm = fm + ((wgid % nig) % gsz); u.pn = (wgid % nig) / gsz; return true;
    }
    __device__ __forceinline__ void a_ready(const Unit&) const {}
    __device__ __forceinline__ void done(const Unit&) const {}
};

__device__ __forceinline__ float rinv8(const float* rs, int row) { const f32x4 a = *(const f32x4*)(rs + (size_t)row * 8), b = *(const f32x4*)(rs + (size_t)row * 8 + 4);
    return __builtin_amdgcn_rsqf((((a[0] + a[1]) + (a[2] + a[3])) + ((b[0] + b[1]) + (b[2] + b[3]))) * (1.0f / 2048.0f) + 1e-6f); }
template <bool RS, bool C64 = false> struct EpiF32S {
    static constexpr bool PERM = false, AFTER_DRAIN = false;
    float* C; int ldc; const float* rs;
    __device__ __forceinline__ void operator()(const f32x4 (&acc)[2][2][4][2], const Unit& u, int wr, int wc, int fr, int fq) const {
        const int row0 = u.pm * BM + wr * 64 + fr, col0 = u.pn * BM + wc * 32 + 4 * fq;
#pragma unroll
        for (int ai = 0; ai < 2; ++ai)
#pragma unroll
            for (int m = 0; m < 4; ++m) { float* rowp = C + (size_t)(row0 + ai * HALF + m * 16) * ldc + col0; const float rsv = RS ? rinv8(rs, row0 + ai * HALF + m * 16) : 1.0f;
#pragma unroll
                for (int bj = 0; bj < 2; ++bj)
#pragma unroll
                    for (int n = 0; n < 2; ++n) if (!C64 || (bj == 0 && wc < 2)) *(f32x4*)(rowp + bj * HALF + n * 16) = RS ? acc[ai][bj][m][n] * rsv : acc[ai][bj][m][n]; }
    }
};
typedef EpiF32S<false> EpiF32;
__device__ __forceinline__ float gelu_tanh(float x) { const float z = 1.5957691216057308f * (x + 0.044715f * x * x * x); return x * __builtin_amdgcn_rcpf(1.0f + __builtin_amdgcn_exp2f(-1.4426950408889634f * z)); }
template <int ACT, bool RS = false> struct EpiF16 {
    static constexpr bool PERM = true, AFTER_DRAIN = false;
    u16* O; int ldc; const float* bias; const float* rs;
    __device__ __forceinline__ void operator()(const f32x4 (&acc)[2][2][4][2], const Unit& u, int wr, int wc, int fr, int fq) const {
        const int row0 = u.pm * BM + wr * 64 + fr, col0 = u.pn * BM + wc * 32 + 8 * fq;
#pragma unroll
        for (int ai = 0; ai < 2; ++ai)
#pragma unroll
            for (int m = 0; m < 4; ++m) { u16* rowp = O + (size_t)(row0 + ai * HALF + m * 16) * ldc + col0; const float rsv = RS ? rinv8(rs, row0 + ai * HALF + m * 16) : 1.0f;
#pragma unroll
                for (int bj = 0; bj < 2; ++bj) { f32x4 v0 = acc[ai][bj][m][0], v1 = acc[ai][bj][m][1];
                    if (RS) { v0 = v0 * rsv; v1 = v1 * rsv; }
                    if (ACT == 1) { const f32x4 b0 = *(const f32x4*)(bias + col0 + bj * HALF), b1 = *(const f32x4*)(bias + col0 + bj * HALF + 4); v0 = v0 + b0; v1 = v1 + b1;
#pragma unroll
                        for (int j = 0; j < 4; ++j) { v0[j] = gelu_tanh(v0[j]); v1[j] = gelu_tanh(v1[j]); } }
                    u32x4 w; w.x = pkh(v0[0], v0[1]); w.y = pkh(v0[2], v0[3]); w.z = pkh(v1[0], v1[1]); w.w = pkh(v1[2], v1[3]);
                    *(u32x4*)(rowp + bj * HALF) = w; } }
    }
};
struct EpiF16S {
    static constexpr bool PERM = true, AFTER_DRAIN = false;
    u16* O; int ldc; float cs;
    __device__ __forceinline__ void operator()(const f32x4 (&acc)[2][2][4][2], const Unit& u, int wr, int wc, int fr, int fq) const {
        const int row0 = u.pm * BM + wr * 64 + fr, col0 = u.pn * BM + wc * 32 + 8 * fq;
#pragma unroll
        for (int ai = 0; ai < 2; ++ai)
#pragma unroll
            for (int m = 0; m < 4; ++m) { u16* rowp = O + (size_t)(row0 + ai * HALF + m * 16) * ldc + col0;
#pragma unroll
                for (int bj = 0; bj < 2; ++bj) { const f32x4 v0 = acc[ai][bj][m][0] * cs, v1 = acc[ai][bj][m][1] * cs;
                    u32x4 w; w.x = pkh(v0[0], v0[1]); w.y = pkh(v0[2], v0[3]); w.z = pkh(v1[0], v1[1]); w.w = pkh(v1[2], v1[3]);
                    *(u32x4*)(rowp + bj * HALF) = w; } }
    }
};
struct EpiKV {
    static constexpr bool PERM = true, AFTER_DRAIN = false;
    u16* KV; int ldc; u16* KCS; int rows_pad; const float* rs;
    __device__ __forceinline__ void operator()(const f32x4 (&acc)[2][2][4][2], const Unit& u, int wr, int wc, int fr, int fq) const {
        const int row0 = u.pm * BM + wr * 64 + fr, col0 = u.pn * BM + wc * 32 + 8 * fq;
#pragma unroll
        for (int ai = 0; ai < 2; ++ai)
#pragma unroll
            for (int m = 0; m < 4; ++m) { const int row = row0 + ai * HALF + m * 16; const float rsv = rinv8(rs, row);
#pragma unroll
                for (int bj = 0; bj < 2; ++bj) { const f32x4 v0 = acc[ai][bj][m][0] * rsv, v1 = acc[ai][bj][m][1] * rsv;
                    u32x4 w; w.x = pkh(v0[0], v0[1]); w.y = pkh(v0[2], v0[3]); w.z = pkh(v1[0], v1[1]); w.w = pkh(v1[2], v1[3]);
                    u16* dst = (u.pn < 2) ? KCS + ((size_t)(u.pn * 2 + bj) * rows_pad + row) * 128 + wc * 32 + 8 * fq : KV + (size_t)row * ldc + col0 + bj * HALF;
                    *(u32x4*)dst = w; } }
    }
};
struct EpiSwiGLU {
    static constexpr bool PERM = true, AFTER_DRAIN = false;
    u16* H; int ldh; const float* rs;
    __device__ __forceinline__ void operator()(const f32x4 (&acc)[2][2][4][2], const Unit& u, int wr, int wc, int fr, int fq) const {
        const int row0 = u.pm * BM + wr * 64 + fr, col0 = u.pn * HALF + wc * 32 + 8 * fq;
#pragma unroll
        for (int ai = 0; ai < 2; ++ai)
#pragma unroll
            for (int m = 0; m < 4; ++m) { u16* rowp = H + (size_t)(row0 + ai * HALF + m * 16) * ldh + col0; float o[8]; const float rsv = rinv8(rs, row0 + ai * HALF + m * 16);
#pragma unroll
                for (int n = 0; n < 2; ++n)
#pragma unroll
                    for (int j = 0; j < 4; ++j) { const float g = acc[ai][0][m][n][j] * rsv, up = acc[ai][1][m][n][j] * rsv;
                        o[n * 4 + j] = g * __builtin_amdgcn_rcpf(1.0f + __builtin_amdgcn_exp2f(-1.4426950408889634f * g)) * up; }
                u32x4 w; w.x = pkh(o[0], o[1]); w.y = pkh(o[2], o[3]); w.z = pkh(o[4], o[5]); w.w = pkh(o[6], o[7]);
                *(u32x4*)rowp = w; }
    }
};

__device__ __forceinline__ float clamp448(float v) { return fminf(fmaxf(v, -448.0f), 448.0f); }
struct EpiSwiGLU8 {
    static constexpr bool PERM = true, AFTER_DRAIN = false;
    unsigned char* H8; int ldh; const float* rs; float cs = 1.0f;
    __device__ __forceinline__ void operator()(const f32x4 (&acc)[2][2][4][2], const Unit& u, int wr, int wc, int fr, int fq) const {
        const int row0 = u.pm * BM + wr * 64 + fr, col0 = u.pn * HALF + wc * 32 + 8 * fq;
#pragma unroll
        for (int ai = 0; ai < 2; ++ai)
#pragma unroll
            for (int m = 0; m < 4; ++m) { unsigned char* rowp = H8 + (size_t)(row0 + ai * HALF + m * 16) * ldh + col0; float o[8]; const float rsv = rinv8(rs, row0 + ai * HALF + m * 16) * cs;
#pragma unroll
                for (int n = 0; n < 2; ++n)
#pragma unroll
                    for (int j = 0; j < 4; ++j) { const float g = acc[ai][0][m][n][j] * rsv, up = acc[ai][1][m][n][j] * rsv;
                        o[n * 4 + j] = clamp448(8.0f * g * __builtin_amdgcn_rcpf(1.0f + __builtin_amdgcn_exp2f(-1.4426950408889634f * g)) * up); }
                int w0 = __builtin_amdgcn_cvt_pk_fp8_f32(o[0], o[1], 0, false); w0 = __builtin_amdgcn_cvt_pk_fp8_f32(o[2], o[3], w0, true);
                int w1 = __builtin_amdgcn_cvt_pk_fp8_f32(o[4], o[5], 0, false); w1 = __builtin_amdgcn_cvt_pk_fp8_f32(o[6], o[7], w1, true);
                u32x2 w; w.x = (unsigned)w0; w.y = (unsigned)w1; *(u32x2*)rowp = w; }
    }
};

__device__ __forceinline__ float qsum4(float x) { float a = x, b = x;
    asm volatile("s_nop 1\n\tv_permlane16_swap_b32 %0, %1\n\tv_add_f32 %0, %0, %1\n\tv_mov_b32 %1, %0\n\ts_nop 1\n\tv_permlane32_swap_b32 %0, %1\n\tv_add_f32 %0, %0, %1" : "+v"(a), "+v"(b)); return a; }
template <bool OUTF32, bool X8 = false> struct EpiResNorm {
    static constexpr bool PERM = true, AFTER_DRAIN = false;
    const u16* Xin; void* Xout; const float* gpost; float alpha; unsigned* slots; unsigned* cnt; float* rinvp; PG8_LAS unsigned char* tab; unsigned char* x8out = nullptr;
    __device__ __forceinline__ void operator()(const f32x4 (&acc)[2][2][4][2], const Unit& u, int wr, int wc, int fr, int fq) const {
        { int ln; asm volatile("v_mbcnt_lo_u32_b32 %0, -1, 0\n\tv_mbcnt_hi_u32_b32 %0, -1, %0" : "=v"(ln)); fr = ln & 15; fq = ln >> 4; int zs = 0; asm volatile("" : "+s"(zs)); wr += zs; wc += zs; }
        PG8_LAS float* P = (PG8_LAS float*)tab; PG8_LAS float* Sx = P + 1024;
        const int wid = wr * 4 + wc, lane = fq * 16 + fr, row = wid * 64 + lane;
#pragma unroll
        for (int ai = 0; ai < 2; ++ai)
#pragma unroll
            for (int m = 0; m < 4; ++m) { float q = 0.f;
#pragma unroll
                for (int bj = 0; bj < 2; ++bj)
#pragma unroll
                    for (int n = 0; n < 2; ++n) { const f32x4 v = acc[ai][bj][m][n]; q += (v[0] * v[0] + v[1] * v[1]) + (v[2] * v[2] + v[3] * v[3]); }
                q = qsum4(q);
                if (fq == 0) P[(ai * HALF + wr * 64 + m * 16 + fr) * 4 + wc] = q; }
        asm volatile("s_waitcnt lgkmcnt(0)" ::: "memory"); __builtin_amdgcn_s_barrier(); asm volatile("" ::: "memory");
        if (wid < 4) { const float t = (P[row * 4] + P[row * 4 + 1]) + (P[row * 4 + 2] + P[row * 4 + 3]);
            __hip_atomic_store(slots + (size_t)(u.pm * BM + row) * 8 + u.pn, __builtin_bit_cast(unsigned, t), __ATOMIC_RELAXED, __HIP_MEMORY_SCOPE_AGENT);
            asm volatile("s_waitcnt vmcnt(0)" ::: "memory");
            if (lane == 0) __hip_atomic_fetch_add(cnt + 8 * u.pm, 1u, __ATOMIC_RELAXED, __HIP_MEMORY_SCOPE_AGENT); }
        h8 xv[4][2]; f32x4 gv[2][2];
#pragma unroll
        for (int m = 0; m < 4; ++m)
#pragma unroll
            for (int bj = 0; bj < 2; ++bj) xv[m][bj] = *(const h8*)(Xin + (size_t)(u.pm * BM + wr * 64 + m * 16 + fr) * 2048 + (u.pn * BM + bj * HALF + wc * 32 + 8 * fq));
#pragma unroll
        for (int bj = 0; bj < 2; ++bj) { gv[bj][0] = *(const f32x4*)(gpost + u.pn * BM + bj * HALF + wc * 32 + 8 * fq); gv[bj][1] = *(const f32x4*)(gpost + u.pn * BM + bj * HALF + wc * 32 + 8 * fq + 4); }
        if (wid == 0) { unsigned sp = 0;
            while ((unsigned)__builtin_amdgcn_readfirstlane(__hip_atomic_load(cnt + 8 * u.pm, __ATOMIC_RELAXED, __HIP_MEMORY_SCOPE_AGENT)) < 32u) { __builtin_amdgcn_s_sleep(2); if (++sp > (1u << 19)) break; }
            __builtin_amdgcn_fence(__ATOMIC_ACQUIRE, "agent");
            asm volatile("s_waitcnt vmcnt(0)" ::: "memory"); }
        asm volatile("s_waitcnt lgkmcnt(0)" ::: "memory"); __builtin_amdgcn_s_barrier(); asm volatile("" ::: "memory");
        if (wid < 4) { const unsigned* sl = slots + (size_t)(u.pm * BM + row) * 8; float t = 0.f;
#pragma unroll
            for (int k = 0; k < 8; ++k) t += __builtin_bit_cast(float, __hip_atomic_load(sl + k, __ATOMIC_RELAXED, __HIP_MEMORY_SCOPE_AGENT));
            Sx[row] = alpha * __builtin_amdgcn_rsqf(t * (1.0f / 2048.0f) + 1e-6f); }
        asm volatile("s_waitcnt lgkmcnt(0)" ::: "memory"); __builtin_amdgcn_s_barrier(); asm volatile("" ::: "memory");
#pragma unroll
        for (int ai = 0; ai < 2; ++ai)
#pragma unroll
            for (int m = 0; m < 4; ++m) { const int r = ai * HALF + wr * 64 + m * 16 + fr; const float rs = Sx[r]; const size_t grow = (size_t)(u.pm * BM + r) * 2048; float qq = 0.f;
#pragma unroll
                for (int bj = 0; bj < 2; ++bj) { const int c0 = u.pn * BM + bj * HALF + wc * 32 + 8 * fq;
                    const h8 xq = xv[m][bj]; const f32x4 g0 = gv[bj][0], g1 = gv[bj][1];
                    if (ai == 0) xv[m][bj] = *(const h8*)(Xin + grow + (size_t)HALF * 2048 + c0);
                    f32x4 x0 = {(float)xq[0], (float)xq[1], (float)xq[2], (float)xq[3]}, x1 = {(float)xq[4], (float)xq[5], (float)xq[6], (float)xq[7]};
                    x0 = x0 + acc[ai][bj][m][0] * g0 * rs; x1 = x1 + acc[ai][bj][m][1] * g1 * rs;
                    qq += ((x0[0] * x0[0] + x0[1] * x0[1]) + (x0[2] * x0[2] + x0[3] * x0[3])) + ((x1[0] * x1[0] + x1[1] * x1[1]) + (x1[2] * x1[2] + x1[3] * x1[3]));
                    if constexpr (OUTF32) { float* o = (float*)Xout + grow + c0; *(f32x4*)o = x0; *(f32x4*)(o + 4) = x1; }
                    else { u32x4 w; w.x = pkh(x0[0], x0[1]); w.y = pkh(x0[2], x0[3]); w.z = pkh(x1[0], x1[1]); w.w = pkh(x1[2], x1[3]); *(u32x4*)((u16*)Xout + grow + c0) = w; }
                    if constexpr (X8) { int w0 = __builtin_amdgcn_cvt_pk_fp8_f32(clamp448(16.0f * x0[0]), clamp448(16.0f * x0[1]), 0, false); w0 = __builtin_amdgcn_cvt_pk_fp8_f32(clamp448(16.0f * x0[2]), clamp448(16.0f * x0[3]), w0, true);
                        int w1 = __builtin_amdgcn_cvt_pk_fp8_f32(clamp448(16.0f * x1[0]), clamp448(16.0f * x1[1]), 0, false); w1 = __builtin_amdgcn_cvt_pk_fp8_f32(clamp448(16.0f * x1[2]), clamp448(16.0f * x1[3]), w1, true);
                        u32x2 w8; w8.x = (unsigned)w0; w8.y = (unsigned)w1; *(u32x2*)(x8out + grow + c0) = w8; } }
                if constexpr (!OUTF32) { qq = qsum4(qq); if (fq == 0) P[r * 4 + wc] = qq; }
                asm volatile("" ::: "memory"); }
        if constexpr (!OUTF32) {
            asm volatile("s_waitcnt lgkmcnt(0)" ::: "memory"); __builtin_amdgcn_s_barrier(); asm volatile("" ::: "memory");
            if (wid < 4) rinvp[(size_t)(u.pm * BM + row) * 8 + u.pn] = (P[row * 4] + P[row * 4 + 1]) + (P[row * 4 + 2] + P[row * 4 + 3]); }
    }
};

typedef int pg8_i32x4 __attribute__((ext_vector_type(4)));
typedef int pg8_i32x8 __attribute__((ext_vector_type(8)));
__device__ __forceinline__ pg8_i32x8 cat88(h8 a, h8 b) { return __builtin_shufflevector(__builtin_bit_cast(pg8_i32x4, a), __builtin_bit_cast(pg8_i32x4, b), 0, 1, 2, 3, 4, 5, 6, 7); }
template <class Epi, class Sched, bool ALIGN_EPI, bool SP2, bool AMODE, bool FP8 = false>
__device__ __forceinline__ void gemm_phase(PG8_LAS unsigned char* lds, const Gemm g, const Sched& S, const Epi& E, const int tid) {
    const int wid = __builtin_amdgcn_readfirstlane(tid >> 6), lane = tid & 63, wr = wid >> 2, wc = wid & 3, fr = lane & 15, fq = lane >> 4;
    const int K = g.K, nt = K / BK;
    unsigned voffA[2], voffB[2];
#pragma unroll
    for (int i = 0; i < 2; ++i) { int R, C; stage_rc(tid * 16 + i * 8192, R, C); const int Rb = Epi::PERM ? ((R & ~31) + perm32(R & 31)) : R;
        voffA[i] = (unsigned)(R * g.lda + C) * 2u; voffB[i] = (unsigned)(Rb * g.ldb + C) * 2u; }
    const size_t kstep = (size_t)(BK * 2);
    const size_t hstepA = (size_t)HALF * g.lda * 2, hstepB = (size_t)HALF * g.ldb * 2;
    const size_t tstepA = 2 * hstepA, tstepB = 2 * hstepB;
    const unsigned ldsw = (unsigned)wid * 1024u;
    const int aoff = lds_byte(wr * 64 + fr, fq * 8), boff = lds_byte(wc * 32 + fr, fq * 8);
#define PG8_KOA(t) (AMODE ? ((size_t)((t) >> 1) * 3072u + (size_t)((t) & 1) * 128u) : (size_t)(t) * kstep)
#define PG8_SA(b, h) (((b) * 2 + (h)) * HTB)
#define PG8_SB(b, h) ((4 + (b) * 2 + (h)) * HTB)
#define PG8_STAGE(bufoff, gbase, voff) do { _Pragma("unroll") for (int _i = 0; _i < 2; ++_i) \
        __builtin_amdgcn_global_load_lds((const unsigned*)((const char*)(gbase) + (voff)[_i]), (PG8_LAS unsigned*)(lds + (bufoff) + ldsw + _i * 8192), 16, 0, 0); } while (0)
#define PG8_LDA(dst, b, h) do { _Pragma("unroll") for (int m = 0; m < 4; ++m) { if constexpr (FP8) dst##8[m] = cat88(*(const PG8_LAS h8*)(lds + PG8_SA(b, h) + aoff + m * 2048), *(const PG8_LAS h8*)(lds + PG8_SA(b, h) + aoff + m * 2048 + 1024)); \
        else { _Pragma("unroll") for (int k = 0; k < 2; ++k) dst[m][k] = *(const PG8_LAS h8*)(lds + PG8_SA(b, h) + aoff + m * 2048 + k * 1024); } } } while (0)
#define PG8_LDB(dst, b, h) do { _Pragma("unroll") for (int n = 0; n < 2; ++n) { if constexpr (FP8) dst##8[n] = cat88(*(const PG8_LAS h8*)(lds + PG8_SB(b, h) + boff + n * 2048), *(const PG8_LAS h8*)(lds + PG8_SB(b, h) + boff + n * 2048 + 1024)); \
        else { _Pragma("unroll") for (int k = 0; k < 2; ++k) dst[n][k] = *(const PG8_LAS h8*)(lds + PG8_SB(b, h) + boff + n * 2048 + k * 1024); } } } while (0)
#define PG8_MMA(ai, bj, At, Bt) do { __builtin_amdgcn_s_setprio(1); _Pragma("unroll") for (int m = 0; m < 4; ++m) _Pragma("unroll") for (int n = 0; n < 2; ++n) { \
        if constexpr (FP8) asm volatile("v_mfma_f32_16x16x128_f8f6f4 %0, %1, %2, %0" : "+v"(acc[ai][bj][m][n]) : "v"(Bt##8[n]), "v"(At##8[m]));   \
        else { _Pragma("unroll") for (int k = 0; k < 2; ++k) acc[ai][bj][m][n] = __builtin_amdgcn_mfma_f32_16x16x32_f16(Bt[n][k], At[m][k], acc[ai][bj][m][n], 0, 0, 0); } } __builtin_amdgcn_s_setprio(0); } while (0)
#define PG8_WAIT_V(n) asm volatile("s_waitcnt vmcnt(" #n ")" ::: "memory")
#define PG8_WAIT_L(n) asm volatile("s_waitcnt lgkmcnt(" #n ")" ::: "memory")
#define PG8_BAR __builtin_amdgcn_s_barrier()
#define PG8_SCHED __builtin_amdgcn_sched_barrier(0)
    Unit cur, nxt; int ui = 0;
    if (!S.next(0, cur)) return;
    f32x4 acc[2][2][4][2];
#pragma unroll
    for (int a = 0; a < 2; ++a)
#pragma unroll
        for (int b = 0; b < 2; ++b)
#pragma unroll
            for (int m = 0; m < 4; ++m)
#pragma unroll
                for (int n = 0; n < 2; ++n) acc[a][b][m][n] = (f32x4){0.f, 0.f, 0.f, 0.f};
    h8 At[4][2], B0[2][2], B1[2][2]; pg8_i32x8 At8[4], B08[2], B18[2];
    const char* cA = (const char*)g.A + (size_t)cur.pm * tstepA; const char* cB = (const char*)g.Bt + (size_t)cur.pn * tstepB;
    S.a_ready(cur);
    if constexpr (SP2) {
        PG8_STAGE(PG8_SB(0, 0), cB, voffB); PG8_STAGE(PG8_SB(0, 1), cB + hstepB, voffB); PG8_STAGE(PG8_SA(0, 0), cA, voffA); PG8_STAGE(PG8_SA(0, 1), cA + hstepA, voffA);
        if (wr == 1) PG8_BAR;
        PG8_WAIT_V(2); PG8_BAR;
        PG8_STAGE(PG8_SB(1, 0), cB + kstep, voffB); PG8_STAGE(PG8_SA(1, 0), cA + kstep, voffA); PG8_STAGE(PG8_SB(1, 1), cB + hstepB + kstep, voffB);
        PG8_WAIT_V(6); PG8_BAR;
    } else {
        PG8_STAGE(PG8_SB(0, 0), cB, voffB); PG8_STAGE(PG8_SA(0, 0), cA, voffA); PG8_STAGE(PG8_SB(0, 1), cB + hstepB, voffB); PG8_STAGE(PG8_SA(0, 1), cA + hstepA, voffA);
        if (wr == 1) PG8_BAR;
        PG8_WAIT_V(4); PG8_BAR;
        PG8_STAGE(PG8_SB(1, 0), cB + kstep, voffB); PG8_STAGE(PG8_SA(1, 0), cA + kstep, voffA); PG8_STAGE(PG8_SB(1, 1), cB + hstepB + kstep, voffB);
        PG8_WAIT_V(6); PG8_BAR;
    }
    for (;;) {
        const bool has_next = S.next(ui + 1, nxt);
        const char* nA = has_next ? (const char*)g.A + (size_t)nxt.pm * tstepA : cA; const char* nB = has_next ? (const char*)g.Bt + (size_t)nxt.pn * tstepB : cB;
        for (int t = 0; t < nt; t += 2) {
            const bool last = (t == nt - 2);
            const char* a1 = cA + PG8_KOA(t + 1);
            const char* a2 = last ? nA : cA + PG8_KOA(t + 2); const char* b2 = last ? nB : cB + (size_t)(t + 2) * kstep;
            const char* a3 = a2 + kstep; const char* b3 = b2 + kstep;
            if (last && has_next) S.a_ready(nxt);
            if constexpr (SP2) {
            PG8_LDB(B0, 0, 0); PG8_LDB(B1, 0, 1); PG8_SCHED; PG8_LDA(At, 0, 0); PG8_STAGE(PG8_SA(1, 1), a1 + hstepA, voffA);
            PG8_WAIT_V(8); PG8_WAIT_L(0); PG8_BAR; PG8_MMA(0, 0, At, B0); PG8_MMA(0, 1, At, B1); PG8_BAR; PG8_SCHED;
            PG8_LDA(At, 0, 1); PG8_STAGE(PG8_SB(0, 0), b2, voffB); PG8_STAGE(PG8_SB(0, 1), b2 + hstepB, voffB); PG8_STAGE(PG8_SA(0, 0), a2, voffA);
            PG8_WAIT_V(8); PG8_WAIT_L(0); PG8_BAR; PG8_MMA(1, 0, At, B0); PG8_MMA(1, 1, At, B1); PG8_BAR; PG8_SCHED;
            PG8_LDB(B0, 1, 0); PG8_LDB(B1, 1, 1); PG8_SCHED; PG8_LDA(At, 1, 0); PG8_STAGE(PG8_SA(0, 1), a2 + hstepA, voffA);
            PG8_WAIT_V(8); PG8_WAIT_L(0); PG8_BAR; PG8_MMA(0, 0, At, B0); PG8_MMA(0, 1, At, B1); PG8_BAR; PG8_SCHED;
            PG8_LDA(At, 1, 1); PG8_STAGE(PG8_SB(1, 0), b3, voffB); PG8_STAGE(PG8_SB(1, 1), b3 + hstepB, voffB); PG8_STAGE(PG8_SA(1, 0), a3, voffA);
            PG8_WAIT_V(8); PG8_WAIT_L(0); PG8_BAR; PG8_MMA(1, 0, At, B0); PG8_MMA(1, 1, At, B1); PG8_BAR; PG8_SCHED;
            } else {
            PG8_LDB(B0, 0, 0); PG8_SCHED; PG8_LDA(At, 0, 0); PG8_STAGE(PG8_SA(1, 1), a1 + hstepA, voffA);
            PG8_WAIT_L(8); PG8_BAR; PG8_WAIT_L(0); PG8_MMA(0, 0, At, B0); PG8_BAR; PG8_SCHED;
            PG8_LDB(B1, 0, 1); PG8_STAGE(PG8_SB(0, 0), b2, voffB);
            PG8_BAR; PG8_WAIT_L(0); PG8_MMA(0, 1, At, B1); PG8_BAR;
            PG8_LDA(At, 0, 1); PG8_STAGE(PG8_SA(0, 0), a2, voffA);
            PG8_BAR; PG8_WAIT_L(0); PG8_MMA(1, 0, At, B0); PG8_BAR; PG8_SCHED;
            PG8_STAGE(PG8_SB(0, 1), b2 + hstepB, voffB);
            PG8_WAIT_V(6); PG8_BAR; PG8_MMA(1, 1, At, B1); PG8_BAR;
            PG8_LDB(B0, 1, 0); PG8_SCHED; PG8_LDA(At, 1, 0); PG8_STAGE(PG8_SA(0, 1), a2 + hstepA, voffA);
            PG8_WAIT_L(8); PG8_BAR; PG8_WAIT_L(0); PG8_MMA(0, 0, At, B0); PG8_BAR; PG8_SCHED;
            PG8_LDB(B1, 1, 1); PG8_STAGE(PG8_SB(1, 0), b3, voffB);
            PG8_BAR; PG8_WAIT_L(0); PG8_MMA(0, 1, At, B1); PG8_BAR;
            PG8_LDA(At, 1, 1); PG8_STAGE(PG8_SA(1, 0), a3, voffA);
            PG8_BAR; PG8_WAIT_L(0); PG8_MMA(1, 0, At, B0); PG8_BAR; PG8_SCHED;
            PG8_STAGE(PG8_SB(1, 1), b3 + hstepB, voffB);
            PG8_WAIT_V(6); PG8_BAR; PG8_MMA(1, 1, At, B1); PG8_BAR;
            }
        }
        if constexpr (ALIGN_EPI) { if (wr == 0) PG8_BAR; }
        if constexpr (FP8) asm volatile("s_nop 15\n\ts_nop 15" ::: "memory");
        E(acc, cur, wr, wc, fr, fq); S.done(cur);
        if (!has_next) break;
#pragma unroll
        for (int a = 0; a < 2; ++a)
#pragma unroll
            for (int b = 0; b < 2; ++b)
#pragma unroll
                for (int m = 0; m < 4; ++m)
#pragma unroll
                    for (int n = 0; n < 2; ++n) acc[a][b][m][n] = (f32x4){0.f, 0.f, 0.f, 0.f};
        cur = nxt; cA = nA; cB = nB; ++ui;
        if constexpr (ALIGN_EPI) { if (wr == 1) PG8_BAR; }
    }
    PG8_WAIT_V(0);
    if constexpr (!ALIGN_EPI) { if (wr == 0) PG8_BAR; }
    PG8_BAR;
#undef PG8_KOA
#undef PG8_SA
#undef PG8_SB
#undef PG8_STAGE
#undef PG8_LDA
#undef PG8_LDB
#undef PG8_MMA
#undef PG8_WAIT_V
#undef PG8_WAIT_L
#undef PG8_BAR
#undef PG8_SCHED
}
}

constexpr int NWAVES = 8;
constexpr int S = 16384, D = 2048, FF = 5632;
constexpr int MEM_LEN = 256, MEM_W = 512;
constexpr int MAIN_W = 1536;
constexpr int ML_H = 4, ML_DQK = 192, ML_DV = 384, ML_L = 64, ML_NC = S / ML_L;
constexpr int A_INW = 5128, A_N = 5120;
constexpr int B_INW = 2084, B_N = 2048;
constexpr int KVW = 1536;
constexpr int NCMP = 1023;
constexpr float EPS = 1e-6f;

constexpr size_t MiB = 1u << 20;
constexpr size_t WS_CTL = 0, CTL_ZERO_BYTES = 64 * 1024;
constexpr size_t WS_MEMN  = 1 * MiB;
constexpr size_t WS_MEMKV = 3 * MiB;
constexpr size_t WS_GA    = 4 * MiB;
constexpr size_t WS_RINV  = 5 * MiB;
constexpr size_t WS_SLOT  = 6 * MiB;
constexpr size_t WS_WGA   = 8 * MiB;
constexpr size_t WS_CB1   = 8 * MiB + 512 * 1024;
constexpr size_t WS_B63   = 8 * MiB + 520 * 1024;
constexpr size_t WS_MLOC  = 8 * MiB + 524 * 1024;
constexpr size_t WS_MST   = 8 * MiB + 528 * 1024;
constexpr size_t WS_DN    = 9 * MiB;
constexpr size_t WS_KVC   = 10 * MiB;
constexpr size_t WS_CMPH  = 11 * MiB;
constexpr size_t WS_ROPE  = 13 * MiB;
constexpr size_t WS_SEL   = 21 * MiB;
constexpr size_t WS_W     = 24 * MiB;
constexpr size_t WS_WGU   = WS_W;
constexpr size_t WS_WD    = WS_WGU + 176 * MiB;
constexpr size_t WS_WAIN  = WS_WD + 88 * MiB;
constexpr size_t WS_WOUT  = WS_WAIN + 20 * MiB;
constexpr size_t WS_WKV   = WS_WOUT + 16 * MiB;
constexpr size_t WS_WBIN  = WS_WKV + 6 * MiB;
constexpr size_t WS_WMKV  = WS_WBIN + 10 * MiB;
constexpr size_t WS_WC1   = WS_WMKV + 8 * MiB;
constexpr size_t WS_WC2   = WS_WC1 + 4 * MiB;
constexpr size_t WS_XN    = WS_WC2 + 1 * MiB;
constexpr size_t WS_SCR   = WS_XN + 64 * MiB;
constexpr size_t WS_H     = WS_SCR;
constexpr size_t WS_Y     = WS_SCR + 176 * MiB;
constexpr size_t WS_PG    = WS_SCR + 240 * MiB;
constexpr size_t WS_X16B  = WS_SCR + 240 * MiB;
constexpr size_t WS_PART  = WS_SCR + 240 * MiB;
constexpr size_t WS_KCS   = WS_SCR + 272 * MiB;
constexpr size_t WS_CT    = WS_SCR;
constexpr size_t WS_AOUT  = WS_SCR + 144 * MiB;
constexpr size_t WS_XKV   = WS_SCR;
constexpr size_t WS_BOUT  = WS_SCR;
constexpr size_t WS_KST   = WS_SCR + 72 * MiB;
constexpr size_t WS_VST   = WS_SCR + 76 * MiB;
constexpr size_t WS_KWT   = WS_SCR + 80 * MiB;
constexpr size_t WS_VWT   = WS_SCR + 88 * MiB;
constexpr size_t WS_KVRAW = WS_SCR + 304 * MiB;
constexpr size_t WS_END   = WS_KVRAW + 48 * MiB + 128 * 1024;
constexpr int CW_TMO = 0;
constexpr int CW_BAR = 4096;
constexpr int CW_RN = 12288;
constexpr int CW_SLC = 8192;

constexpr int LDSCTL_OFF = 0, LDSCTL_BYTES = 512, MISC_OFF = 320;
constexpr int RING_OFF = 512, RING_BYTES = 146944;
constexpr int LDS_BYTES = 147456;
constexpr int WAVE_LDS = 18368;

typedef GAS unsigned gu32;
#define RLX_AGENT __ATOMIC_RELAXED, __HIP_MEMORY_SCOPE_AGENT
#define LDS_WAIT() asm volatile("s_waitcnt lgkmcnt(0)" ::: "memory")
#define VM_WAIT() asm volatile("s_waitcnt vmcnt(0)" ::: "memory")

#define XB_TMO      128
#define XB_XCNT(j)  (256  + 64 * (j))
#define XB_XSUB(j)  (1280 + 64 * (j))
#define XB_XGEN(j)  (2304 + 64 * (j))
#define XB_TOP      3328
#define XB_TOPGEN   3392
#define XCD_BAR_WORDS 3456
#define XB_SPIN_CAP (1u << 18)

__device__ __forceinline__ unsigned xb_ld(unsigned* p)              { return __hip_atomic_load(p, __ATOMIC_RELAXED, __HIP_MEMORY_SCOPE_AGENT); }
__device__ __forceinline__ unsigned xb_add(unsigned* p, unsigned v) { return __hip_atomic_fetch_add(p, v, __ATOMIC_RELAXED, __HIP_MEMORY_SCOPE_AGENT); }
__device__ __forceinline__ unsigned xb_xcc_id() { return (unsigned)__builtin_amdgcn_s_getreg((3 << 11) | 20) & 0xFu; }
#define XB_SPIN(cond, bar) do { unsigned _sp = 0; while (cond) { __builtin_amdgcn_s_sleep(1); \
    if ((++_sp & 255u) == 0u) { if (xb_ld(&(bar)[XB_TMO])) break; if (_sp > XB_SPIN_CAP) { atomicAdd(&(bar)[XB_TMO], 1u); break; } } } } while (0)

struct XcdBarrier { unsigned* bar; unsigned x; volatile LAS unsigned* st; };

__device__ __forceinline__ XcdBarrier xcd_barrier_post(unsigned* bar, volatile LAS unsigned* st, const int tid) {
    XcdBarrier b; b.bar = bar; b.x = xb_xcc_id(); b.st = st;
    if (tid == 0) (void)xb_add(&bar[XB_XCNT(b.x)], 1u);
    return b;
}
__device__ __forceinline__ void xcd_barrier_complete(unsigned* bar, unsigned x, unsigned& nloc, unsigned& nx) {
    const unsigned G = gridDim.x * gridDim.y * gridDim.z;
    unsigned sum, cnt, mine, sp = 0u;
    for (;;) {
        sum = 0u; cnt = 0u; mine = 0u;
#pragma unroll
        for (unsigned j = 0; j < 16; ++j) { const unsigned c = xb_ld(&bar[XB_XCNT(j)]); sum += c; cnt += (c > 0u) ? 1u : 0u; mine = (j == x) ? c : mine; }
        if (sum == G) break;
        __builtin_amdgcn_s_sleep(1);
        if ((++sp & 255u) == 0u) { if (xb_ld(&bar[XB_TMO])) break; if (sp > XB_SPIN_CAP) { atomicAdd(&bar[XB_TMO], 1u); break; } }
    }
    nloc = mine > 0u ? mine : 1u; nx = cnt > 0u ? cnt : 1u;
}
__device__ __forceinline__ void xcd_barrier(const XcdBarrier& b, const int tid) {
    asm volatile("s_waitcnt vmcnt(0)" ::: "memory");
    __syncthreads();
    if (tid == 0) {
        unsigned* bar = b.bar;
        __builtin_amdgcn_s_waitcnt(0);
        unsigned nloc = b.st[0], nx = b.st[1];
        if (nloc == 0u) { xcd_barrier_complete(bar, b.x, nloc, nx); b.st[0] = nloc; b.st[1] = nx; }
        const unsigned old = xb_add(&bar[XB_XSUB(b.x)], 1u);
        const unsigned gen = old / nloc;
        if (old + 1u == (gen + 1u) * nloc) {
            __builtin_amdgcn_fence(__ATOMIC_RELEASE, "agent");
            asm volatile("s_waitcnt vmcnt(0)" ::: "memory");
            const unsigned og = xb_add(&bar[XB_TOP], 1u);
            const unsigned tg = og / nx;
            if (og + 1u == (tg + 1u) * nx) xb_add(&bar[XB_TOPGEN], 1u);
            else XB_SPIN(xb_ld(&bar[XB_TOPGEN]) == tg, bar);
            __builtin_amdgcn_fence(__ATOMIC_ACQUIRE, "agent");
            xb_add(&bar[XB_XGEN(b.x)], 1u);
            asm volatile("s_waitcnt vmcnt(0)" ::: "memory");
        } else {
            XB_SPIN(xb_ld(&bar[XB_XGEN(b.x)]) == gen, bar);
            __builtin_amdgcn_fence(__ATOMIC_ACQUIRE, "agent");
            asm volatile("s_waitcnt vmcnt(0)" ::: "memory");
        }
    }
    __syncthreads();
}

__device__ __forceinline__ float wave_sum(float v) {
#pragma unroll
    for (int o = 1; o < 64; o <<= 1) v += __shfl_xor(v, o);
    return v;
}
__device__ __forceinline__ float wave_max(float v) {
#pragma unroll
    for (int o = 1; o < 64; o <<= 1) v = fmaxf(v, __shfl_xor(v, o));
    return v;
}
__device__ __forceinline__ float wave_scan_add(float v, int lane) {
#pragma unroll
    for (int o = 1; o < 64; o <<= 1) { const float y = __shfl_up(v, o); if (lane >= o) v += y; }
    return v;
}
__device__ __forceinline__ float wave_scan_max(float v, int lane) {
#pragma unroll
    for (int o = 1; o < 64; o <<= 1) { const float y = __shfl_up(v, o); if (lane >= o) v = fmaxf(v, y); }
    return v;
}
__device__ __forceinline__ float sigmoidf_(float x) { return 1.0f / (1.0f + __expf(-x)); }
__device__ __forceinline__ float log_sigmoidf_(float x) { return fminf(x, 0.f) - log1pf(__expf(-fabsf(x))); }

__device__ __forceinline__ void cvt_item(const float* W, int ldw, int col0, int k0, u16* WT, int Kdst, int drow0, float scale, const float* gk, LAS float* scr_, int lane, bool f8 = false) {
    LAS unsigned* scr = (LAS unsigned*)scr_;
    const float* src = W + (size_t)k0 * ldw + col0; const unsigned so = (unsigned)((lane >> 4) * 2 * ldw + (lane & 15) * 4);
#pragma unroll
    for (int h = 0; h < 2; ++h) { f32x4 v[8][2];
#pragma unroll
        for (int j = 0; j < 8; ++j)
#pragma unroll
            for (int e = 0; e < 2; ++e) { v[j][e] = __builtin_nontemporal_load((const f32x4*)(src + (so + (unsigned)((8 * (h * 8 + j) + e) * ldw))));     v[j][e] = v[j][e] * (gk ? scale * gk[k0 + 8 * (h * 8 + j) + 2 * (lane >> 4) + e] : scale); }
#pragma unroll
        for (int j = 0; j < 8; ++j) { LAS unsigned* d = scr + (4 * (h * 8 + j) + (lane >> 4)) * 65 + (lane & 15) * 4;
            d[0] = pkh(v[j][0].x, v[j][1].x); d[1] = pkh(v[j][0].y, v[j][1].y); d[2] = pkh(v[j][0].z, v[j][1].z); d[3] = pkh(v[j][0].w, v[j][1].w); } }
    LDS_WAIT(); asm volatile("" ::: "memory");
    const int c = lane & 15;
#pragma unroll
    for (int j = 0; j < 16; ++j) { const int n = (lane >> 4) + 4 * j; const LAS unsigned* s = scr + (4 * c) * 65 + n;
        u32x4 o; o.x = s[0 * 65]; o.y = s[1 * 65]; o.z = s[2 * 65]; o.w = s[3 * 65];
        if (f8) { const unsigned a0 = s[0 * 65], a1 = s[1 * 65], a2 = s[2 * 65], a3 = s[3 * 65];
            const h2 p0 = __builtin_bit_cast(h2, a0), p1 = __builtin_bit_cast(h2, a1), p2 = __builtin_bit_cast(h2, a2), p3 = __builtin_bit_cast(h2, a3);
            int w0 = __builtin_amdgcn_cvt_pk_fp8_f32(pg8::clamp448((float)p0[0]), pg8::clamp448((float)p0[1]), 0, false); w0 = __builtin_amdgcn_cvt_pk_fp8_f32(pg8::clamp448((float)p1[0]), pg8::clamp448((float)p1[1]), w0, true);
            int w1 = __builtin_amdgcn_cvt_pk_fp8_f32(pg8::clamp448((float)p2[0]), pg8::clamp448((float)p2[1]), 0, false); w1 = __builtin_amdgcn_cvt_pk_fp8_f32(pg8::clamp448((float)p3[0]), pg8::clamp448((float)p3[1]), w1, true);
            u32x2 w8; w8.x = (unsigned)w0; w8.y = (unsigned)w1; *(GAS u32x2*)((unsigned char*)WT + (size_t)(drow0 + n) * Kdst + k0 + 8 * c) = w8; }
        else *(GAS u32x4*)(WT + (size_t)(drow0 + n) * Kdst + k0 + 8 * c) = o; }
    LDS_WAIT(); asm volatile("" ::: "memory");
}

template <int NG, bool XI16, bool XO16>
__device__ __forceinline__ void thin_rows(const u16* Y, float alpha, const float* gpost, const void* Xin, void* Xout, float* RINV,
                                          const LAS float* wg, const float* gbias, float* gates, int gw, int NGW, int lane) {
    u32x2 xh_c[8], xh_n[8]; f32x4 xf_c[8], xf_n[8]; u32x2 yr_c[8], yr_n[8];
#define THIN_LOAD(xh_, xf_, yr_, row_) do { \
        if constexpr (XI16) { const GAS u32x2* p_ = (const GAS u32x2*)((const u16*)Xin + (size_t)(row_) * D) + lane; _Pragma("unroll") for (int j = 0; j < 8; ++j) xh_[j] = p_[64 * j]; } \
        else { const GAS f32x4* p_ = (const GAS f32x4*)((const float*)Xin + (size_t)(row_) * D) + lane; _Pragma("unroll") for (int j = 0; j < 8; ++j) xf_[j] = p_[64 * j]; } \
        if (Y) { const GAS u32x2* q_ = (const GAS u32x2*)(Y + (size_t)(row_) * D) + lane; _Pragma("unroll") for (int j = 0; j < 8; ++j) yr_[j] = q_[64 * j]; } } while (0)
    int row = gw;
    if (row < S) THIN_LOAD(xh_c, xf_c, yr_c, row);
    for (; row < S; row += NGW) {
        const int nrow = row + NGW;
        if (nrow < S) THIN_LOAD(xh_n, xf_n, yr_n, nrow);
        f32x4 x[8];
#pragma unroll
        for (int j = 0; j < 8; ++j) { if constexpr (XI16) x[j] = __builtin_convertvector(__builtin_bit_cast(h4, xh_c[j]), f32x4); else x[j] = xf_c[j]; }
        if (Y) {
            f32x4 y[8]; float ss = 0.f;
#pragma unroll
            for (int j = 0; j < 8; ++j) { y[j] = __builtin_convertvector(__builtin_bit_cast(h4, yr_c[j]), f32x4); ss += (y[j].x * y[j].x + y[j].y * y[j].y) + (y[j].z * y[j].z + y[j].w * y[j].w); }
            const float r = alpha * rsqrtf(wave_sum(ss) * (1.0f / D) + EPS);
#pragma unroll
            for (int j = 0; j < 8; ++j) { const f32x4 g = ((const GAS f32x4*)gpost)[lane + 64 * j]; x[j] = x[j] + y[j] * g * r; }
        }
        if (Xout) {
            if constexpr (XO16) { GAS u32x2* xo = (GAS u32x2*)((u16*)Xout + (size_t)row * D) + lane;
#pragma unroll
                for (int j = 0; j < 8; ++j) { u32x2 w; w.x = pkh(x[j].x, x[j].y); w.y = pkh(x[j].z, x[j].w); xo[64 * j] = w; } }
            else { GAS f32x4* xo = (GAS f32x4*)((float*)Xout + (size_t)row * D) + lane;
#pragma unroll
                for (int j = 0; j < 8; ++j) xo[64 * j] = x[j]; } }
        if (RINV) {
            float ss = 0.f;
#pragma unroll
            for (int j = 0; j < 8; ++j) ss += (x[j].x * x[j].x + x[j].y * x[j].y) + (x[j].z * x[j].z + x[j].w * x[j].w);
            const float sst = wave_sum(ss); const float r = rsqrtf(sst * (1.0f / D) + EPS);
            if (lane < 8) RINV[(size_t)row * 8 + lane] = lane == 0 ? sst : 0.f;
            if constexpr (NG == 8) {
                float a[8];
#pragma unroll
                for (int gi = 0; gi < 8; ++gi) { const LAS f32x4* wr = (const LAS f32x4*)(wg + gi * D) + lane; float acc = 0.f;
#pragma unroll
                    for (int j = 0; j < 8; ++j) { const f32x4 w = wr[64 * j]; acc += (x[j].x * w.x + x[j].y * w.y) + (x[j].z * w.z + x[j].w * w.w); }
                    a[gi] = acc; asm volatile("" ::: "memory"); }
                float b4[4], b2[2], b1;
                { const bool hi = (lane & 32) != 0;
#pragma unroll
                  for (int i = 0; i < 4; ++i) { const float send = hi ? a[i] : a[i + 4], keep = hi ? a[i + 4] : a[i]; b4[i] = keep + __shfl_xor(send, 32); } }
                { const bool hi = (lane & 16) != 0;
#pragma unroll
                  for (int i = 0; i < 2; ++i) { const float send = hi ? b4[i] : b4[i + 2], keep = hi ? b4[i + 2] : b4[i]; b2[i] = keep + __shfl_xor(send, 16); } }
                { const bool hi = (lane & 8) != 0; const float send = hi ? b2[0] : b2[1], keep = hi ? b2[1] : b2[0]; b1 = keep + __shfl_xor(send, 8); }
                b1 += __shfl_xor(b1, 4); b1 += __shfl_xor(b1, 2); b1 += __shfl_xor(b1, 1);
                if ((lane & 7) == 0) { const int gi = lane >> 3; gates[(size_t)row * 8 + gi] = b1 * r + gbias[gi]; }
            }
        }
#pragma unroll
        for (int j = 0; j < 8; ++j) { if constexpr (XI16) xh_c[j] = xh_n[j]; else xf_c[j] = xf_n[j]; yr_c[j] = yr_n[j]; }
    }
#undef THIN_LOAD
}

__device__ __forceinline__ float quad_max(float x) { float a = x, b = x;
    asm("s_nop 1\n\tv_permlane16_swap_b32 %0, %1\n\tv_max_f32 %0, %0, %1\n\tv_mov_b32 %1, %0\n\ts_nop 1\n\tv_permlane32_swap_b32 %0, %1\n\tv_max_f32 %0, %0, %1" : "+v"(a), "+v"(b)); return a; }
__device__ __forceinline__ float quad_sum(float x) { float a = x, b = x;
    asm volatile("s_nop 1\n\tv_permlane16_swap_b32 %0, %1\n\tv_add_f32 %0, %0, %1\n\tv_mov_b32 %1, %0\n\ts_nop 1\n\tv_permlane32_swap_b32 %0, %1\n\tv_add_f32 %0, %0, %1" : "+v"(a), "+v"(b)); return a; }

__device__ __forceinline__ f32x4 mma16(h8 a, h8 b, f32x4 c) { return __builtin_amdgcn_mfma_f32_16x16x32_f16(a, b, c, 0, 0, 0); }
__device__ __forceinline__ h8 cat44(h4 a, h4 b) { return __builtin_shufflevector(a, b, 0, 1, 2, 3, 4, 5, 6, 7); }
__device__ __forceinline__ h4 cvt4(f32x4 v) { return __builtin_convertvector(v, h4); }
__device__ __forceinline__ h8 cvt8(f32x4 a, f32x4 b) { return cat44(cvt4(a), cvt4(b)); }
typedef long i64_t;
__device__ __forceinline__ i64_t pk8_fp8(f32x4 a, f32x4 b) { int lo = 0, hi = 0;
    lo = __builtin_amdgcn_cvt_pk_fp8_f32(a[0], a[1], lo, false); lo = __builtin_amdgcn_cvt_pk_fp8_f32(a[2], a[3], lo, true);
    hi = __builtin_amdgcn_cvt_pk_fp8_f32(b[0], b[1], hi, false); hi = __builtin_amdgcn_cvt_pk_fp8_f32(b[2], b[3], hi, true);
    return (i64_t)(((unsigned long long)(unsigned)hi << 32) | (unsigned)lo); }
__device__ __forceinline__ f32x4 mma8(i64_t a, i64_t b, f32x4 c) { return __builtin_amdgcn_mfma_f32_16x16x32_fp8_fp8(a, b, c, 0, 0, 0); }
typedef long i64x2_ __attribute__((ext_vector_type(2)));
typedef long i64x4_ __attribute__((ext_vector_type(4)));
typedef int i32x8_ __attribute__((ext_vector_type(8)));
__device__ __forceinline__ f32x4 mma8k128(i64x2_ a01, i64x2_ a23, i64_t b0, i64_t b1, i64_t b2, i64_t b3, f32x4 c) {
    const i64x4_ A = __builtin_shufflevector(a01, a23, 0, 1, 2, 3); const i64x4_ B = {b0, b1, b2, b3};
    return __builtin_amdgcn_mfma_scale_f32_16x16x128_f8f6f4(__builtin_bit_cast(i32x8_, A), __builtin_bit_cast(i32x8_, B), c, 0, 0, 0, 0, 0, 0); }

__device__ __forceinline__ void mem_attn_mfma(const u16* Q, int ldq, int qoff, const u16* MKV, u16* HEADS, LAS unsigned char* ring, int tid, int G) {
    const int lane = tid & 63, wave = __builtin_amdgcn_readfirstlane(tid >> 6), fr = lane & 15, fq = lane >> 4;
    const int hd = blockIdx.x & 3, rank = blockIdx.x >> 2, nbh = (G - hd + 3) >> 2;
    LAS f16* Ks = (LAS f16*)ring;
    LAS f16* Vt = (LAS f16*)(ring + 69632);
    __syncthreads();
    for (int e = tid; e < 4096; e += 512) { const int key = e & 255, cc = e >> 8;
        *(LAS h8*)(Ks + key * 136 + cc * 8) = *(const h8*)(MKV + (size_t)key * 1024 + hd * 128 + cc * 8);
        const h8 vv = *(const h8*)(MKV + (size_t)key * 1024 + 512 + hd * 128 + cc * 8);
#pragma unroll
        for (int j = 0; j < 8; ++j) Vt[(cc * 8 + j) * 264 + key] = vv[j]; }
    __syncthreads();
    const float sc = 0.08838834764831845f * 1.4426950408889634f;
    for (int tile = rank * 8 + wave; tile < S / 16; tile += nbh * 8) {
        const int t0 = tile * 16;
        h8 qf[4];
#pragma unroll
        for (int ks = 0; ks < 4; ++ks) qf[ks] = *(const h8*)(Q + (size_t)(t0 + fr) * ldq + qoff + hd * 128 + ks * 32 + fq * 8);
        f32x4 st[16]; float m = -3.0e38f;
#pragma unroll
        for (int kt = 0; kt < 16; ++kt) { f32x4 a = {0.f, 0.f, 0.f, 0.f};
#pragma unroll
            for (int ks = 0; ks < 4; ++ks) a = mma16(*(const LAS h8*)(Ks + (kt * 16 + fr) * 136 + ks * 32 + fq * 8), qf[ks], a);
            st[kt] = a; m = fmaxf(m, fmaxf(fmaxf(a[0], a[1]), fmaxf(a[2], a[3]))); asm volatile("" ::: "memory"); }
        m = quad_max(m);
        float l = 0.f; h8 pf[8];
#pragma unroll
        for (int kb = 0; kb < 8; ++kb) { f32x4 p0, p1;
#pragma unroll
            for (int r = 0; r < 4; ++r) { p0[r] = __builtin_amdgcn_exp2f((st[2 * kb][r] - m) * sc); p1[r] = __builtin_amdgcn_exp2f((st[2 * kb + 1][r] - m) * sc); }
            l += (p0[0] + p0[1]) + (p0[2] + p0[3]) + (p1[0] + p1[1]) + (p1[2] + p1[3]); pf[kb] = cvt8(p0, p1); }
        l = quad_sum(l);
        const float il = 1.0f / l;
#pragma unroll
        for (int dt = 0; dt < 8; ++dt) { f32x4 o = {0.f, 0.f, 0.f, 0.f};
#pragma unroll
            for (int kb = 0; kb < 8; ++kb) { const LAS f16* vp = Vt + (dt * 16 + fr) * 264 + kb * 32 + 4 * fq;
                o = mma16(cat44(*(const LAS h4*)vp, *(const LAS h4*)(vp + 16)), pf[kb], o); }
            *(h4*)(HEADS + (size_t)(t0 + fr) * D + MAIN_W + hd * 128 + dt * 16 + 4 * fq) = cvt4(o * il); asm volatile("" ::: "memory"); }
    }
    __syncthreads();
}

#define NSA_NEG (-1.0e30f)
constexpr int NSA_NH = 3;
__device__ __forceinline__ float nsa_gate(const float* PG, int t, int col, const float* BGB) {
    const float* p = PG + (size_t)t * 256 + col; return sigmoidf_(((p[0] + p[(size_t)S * 256]) + (p[(size_t)2 * S * 256] + p[(size_t)3 * S * 256])) + BGB[col]); }
__device__ __forceinline__ void nsa_tile(const int t0, const int g, const u16* BOUT, const unsigned char* KWT, const u16* KC, const unsigned char* VCT, const unsigned char* VWT,
                                         const float* PG, const float* BGB, const float* ROPE, u16* XN, int* SEL, LAS float* psl, const int lane) {
    const int fr = lane & 15, fq = lane >> 4;
    const float sc2 = 0.08838834764831845f * 1.4426950408889634f;
    const int cur = t0 >> 6;
    const int nvmax = t0 >> 4;
    const int nvl = (t0 >> 4) - 1 + (fr == 15 ? 1 : 0);
    const int nsteps = (nvmax + 31) >> 5;
    const int t = t0 + fr;
#pragma unroll
    for (int kt = 0; kt < 64; ++kt) psl[kt * 64 + lane] = 0.f;
    for (int hb = 0; hb < 6 / NSA_NH; ++hb) {
        const int hh0 = g * 6 + hb * NSA_NH;
        f32x4 o[NSA_NH][8];
#pragma unroll
        for (int j = 0; j < NSA_NH; ++j)
#pragma unroll
            for (int dt = 0; dt < 8; ++dt) o[j][dt] = (f32x4){0.f, 0.f, 0.f, 0.f};
        h8 qf[NSA_NH][4]; i64_t qb[NSA_NH][4];
        typedef i64_t i64x2 __attribute__((ext_vector_type(2)));
        { const int ln = lane_id_v(), fr_ = ln & 15, fq_ = ln >> 4;
          const float* cp = ROPE + (size_t)(t0 + fr_) * 64 + fq_ * 8; const float* sp = cp + (size_t)S * 64; const u16* qrow = BOUT + (size_t)(t0 + fr_) * B_N + fq_ * 8;
#pragma unroll
          for (int ks = 0; ks < 2; ++ks) { const f32x4 c0 = *(const f32x4*)(cp + ks * 32), c1 = *(const f32x4*)(cp + ks * 32 + 4), s0 = *(const f32x4*)(sp + ks * 32), s1 = *(const f32x4*)(sp + ks * 32 + 4);
#pragma unroll
              for (int j = 0; j < NSA_NH; ++j) { const h8 qa = *(const h8*)(qrow + (hh0 + j) * 128 + ks * 32), qb_ = *(const h8*)(qrow + (hh0 + j) * 128 + (ks + 2) * 32);
                  f32x4 a0, a1, b0, b1;
#pragma unroll
                  for (int e = 0; e < 8; ++e) { const float c = e < 4 ? c0[e & 3] : c1[e & 3], s = e < 4 ? s0[e & 3] : s1[e & 3]; const float x1 = (float)qa[e], x2 = (float)qb_[e]; const float r1 = x1 * c - x2 * s, r2 = x2 * c + x1 * s;
                      if (e < 4) { a0[e] = r1; b0[e] = r2; } else { a1[e - 4] = r1; b1[e - 4] = r2; } }
                  qb[j][ks] = pk8_fp8(a0, a1); qb[j][ks + 2] = pk8_fp8(b0, b1); } } }
        float m[NSA_NH], l[NSA_NH];
#pragma unroll
        for (int j = 0; j < NSA_NH; ++j) { m[j] = NSA_NEG; l[j] = 0.f; }
        const int klo = (t0 - 511 > 0 ? t0 - 511 : 0) & ~31;
        for (int kp = klo; kp <= t0 + 15; kp += 32) {
            const bool inner = (kp + 31 <= t0) && (kp >= t0 - 496);
            i64x2 vf[4], kf[4];
            { const int ln = lane_id_v(); const unsigned char* vp_ = VWT + (((size_t)g * 512 + (kp >> 5)) * 4 * 64 + ln) * 16; const unsigned char* kp_ = KWT + (((size_t)g * 1024 + (kp >> 4)) * 2 * 64 + ln) * 16;
#pragma unroll
              for (int i = 0; i < 4; ++i) { vf[i] = *(const i64x2*)(vp_ + i * 1024); kf[i] = *(const i64x2*)(kp_ + i * 1024); } }
            f32x4 p[NSA_NH][2];
#pragma unroll
            for (int k2 = 0; k2 < 2; ++k2) {
                const int k0 = kp + k2 * 16 + 4 * fq;
#pragma unroll
                for (int j = 0; j < NSA_NH; ++j) { f32x4 s = {0.f, 0.f, 0.f, 0.f};
                    s = mma8k128(kf[k2 * 2], kf[k2 * 2 + 1], qb[j][0], qb[j][1], qb[j][2], qb[j][3], s);
                    if (!inner) {
#pragma unroll
                        for (int r = 0; r < 4; ++r) s[r] = (k0 + r <= t && k0 + r > t - 512) ? s[r] : NSA_NEG; }
                    p[j][k2] = s; } }
            i64_t pf[NSA_NH];
#pragma unroll
            for (int j = 0; j < NSA_NH; ++j) { float bm = NSA_NEG;
#pragma unroll
                for (int k2 = 0; k2 < 2; ++k2)
#pragma unroll
                    for (int r = 0; r < 4; ++r) bm = fmaxf(bm, p[j][k2][r]);
                bm = quad_max(bm) * sc2;
                const float mn = fmaxf(m[j], bm), mn8 = mn - 8.0f; float ps = 0.f;
                if (__ballot(mn > m[j]) != 0ull) {
                    const float corr = __builtin_amdgcn_exp2f(m[j] - mn); l[j] *= corr;
#pragma unroll
                    for (int dt = 0; dt < 8; ++dt) o[j][dt] = o[j][dt] * corr; }
                m[j] = mn;
                if (inner) {
#pragma unroll
                    for (int k2 = 0; k2 < 2; ++k2)
#pragma unroll
                        for (int r = 0; r < 4; ++r) { const float pv = __builtin_amdgcn_exp2f(__builtin_fmaf(p[j][k2][r], sc2, -mn8)); p[j][k2][r] = pv; ps += pv; } }
                else {
#pragma unroll
                    for (int k2 = 0; k2 < 2; ++k2)
#pragma unroll
                        for (int r = 0; r < 4; ++r) { const float pv = (p[j][k2][r] > -1.0e29f) ? __builtin_amdgcn_exp2f(__builtin_fmaf(p[j][k2][r], sc2, -mn8)) : 0.f; p[j][k2][r] = pv; ps += pv; } }
                l[j] += ps; pf[j] = pk8_fp8(p[j][0], p[j][1]); }
#pragma unroll
            for (int dt = 0; dt < 8; ++dt)
#pragma unroll
                for (int j = 0; j < NSA_NH; ++j) o[j][dt] = mma8(vf[dt >> 1][dt & 1], pf[j], o[j][dt]);
        }
#pragma unroll
        for (int j = 0; j < NSA_NH; ++j) { const float lt = quad_sum(l[j]);
            const float gwv = 256.0f * nsa_gate(PG, t, (hh0 + j) * 3 + 2, BGB) / lt;
#pragma unroll
            for (int dt = 0; dt < 8; ++dt) o[j][dt] = o[j][dt] * gwv; }
#pragma unroll
        for (int j = 0; j < NSA_NH; ++j)
#pragma unroll
            for (int ks = 0; ks < 4; ++ks) qf[j][ks] = *(const h8*)(BOUT + (size_t)(t0 + (lane_id_v() & 15)) * B_N + (hh0 + j) * 128 + ks * 32 + (lane_id_v() >> 4) * 8);
#pragma unroll
        for (int j = 0; j < NSA_NH; ++j) { m[j] = NSA_NEG; l[j] = 0.f; }
        for (int st = 0; st < nsteps * 2; st += 2) {
            h8 kf[2][4]; const int lnA = lane_id_v();
#pragma unroll
            for (int u = 0; u < 2; ++u)
#pragma unroll
                for (int ks = 0; ks < 4; ++ks) kf[u][ks] = *(const h8*)(KC + ((((size_t)g * 64 + st + u) * 4 + ks) * 64 + lnA) * 8);
            const bool innerA = ((st + 1) * 16 + 15 < (t0 >> 4) - 1);
#pragma unroll
            for (int u = 0; u < 2; ++u) { const int n0 = (st + u) * 16 + 4 * fq;
#pragma unroll
                for (int j = 0; j < NSA_NH; ++j) { f32x4 s = {0.f, 0.f, 0.f, 0.f};
#pragma unroll
                    for (int ks = 0; ks < 4; ++ks) s = mma16(kf[u][ks], qf[j][ks], s);
                    float bm = NSA_NEG, ps = 0.f;
                    if (innerA) {
#pragma unroll
                        for (int r = 0; r < 4; ++r) { s[r] = s[r] * sc2; bm = fmaxf(bm, s[r]); }
                        const float mn = fmaxf(m[j], bm);
#pragma unroll
                        for (int r = 0; r < 4; ++r) ps += __builtin_amdgcn_exp2f(s[r] - mn);
                        l[j] = l[j] * __builtin_amdgcn_exp2f(m[j] - mn) + ps; m[j] = mn; }
                    else {
#pragma unroll
                        for (int r = 0; r < 4; ++r) { s[r] = (n0 + r < nvl) ? s[r] * sc2 : NSA_NEG; bm = fmaxf(bm, s[r]); }
                        const float mn = fmaxf(m[j], bm);
#pragma unroll
                        for (int r = 0; r < 4; ++r) ps += (n0 + r < nvl) ? __builtin_amdgcn_exp2f(s[r] - mn) : 0.f;
                        l[j] = l[j] * __builtin_amdgcn_exp2f(m[j] - mn) + ps; m[j] = mn; } } }
        }
        float il[NSA_NH], gcv[NSA_NH];
#pragma unroll
        for (int j = 0; j < NSA_NH; ++j) { const float mt = quad_max(m[j]);
            const float lt = quad_sum(l[j] * __builtin_amdgcn_exp2f(m[j] - mt));
            m[j] = mt; il[j] = lt > 0.f ? 1.0f / lt : 0.f; gcv[j] = nsa_gate(PG, t, (hh0 + j) * 3 + 0, BGB); }
        float rot_prev = 0.f; float g256[NSA_NH];
#pragma unroll
        for (int j = 0; j < NSA_NH; ++j) g256[j] = gcv[j] * 256.0f;
        for (int st = 0; st < nsteps; ++st) {
            const bool innerB = (st * 32 + 31 < (t0 >> 4) - 1);
            const int lnB = lane_id_v();
            int pk[NSA_NH][2];
#pragma unroll
            for (int k2 = 0; k2 < 2; ++k2) { h8 kf[4];
#pragma unroll
                for (int ks = 0; ks < 4; ++ks) kf[ks] = *(const h8*)(KC + ((((size_t)g * 64 + st * 2 + k2) * 4 + ks) * 64 + lnB) * 8);
                const int n0 = st * 32 + k2 * 16 + 4 * fq; f32x4 ps = {0.f, 0.f, 0.f, 0.f};
#pragma unroll
                for (int j = 0; j < NSA_NH; ++j) { f32x4 sv = {0.f, 0.f, 0.f, 0.f};
#pragma unroll
                    for (int ks = 0; ks < 4; ++ks) sv = mma16(kf[ks], qf[j][ks], sv);
                    if (innerB) {
#pragma unroll
                        for (int r = 0; r < 4; ++r) sv[r] = __builtin_amdgcn_exp2f(sv[r] * sc2 - m[j]) * il[j]; }
                    else {
#pragma unroll
                        for (int r = 0; r < 4; ++r) sv[r] = (n0 + r < nvl) ? __builtin_amdgcn_exp2f(sv[r] * sc2 - m[j]) * il[j] : 0.f; }
                    ps = ps + sv; const f32x4 sg = sv * g256[j];
                    int w = __builtin_amdgcn_cvt_pk_fp8_f32(sg[0], sg[1], 0, false); pk[j][k2] = __builtin_amdgcn_cvt_pk_fp8_f32(sg[2], sg[3], w, true); }
                const float rot = __shfl(ps[3], (lane + 48) & 63);
                const float prev = (fq == 0) ? rot_prev : rot; rot_prev = rot;
                const int kt = st * 2 + k2;
                psl[kt * 64 + lane] += 2.f * (ps[0] + ps[1] + ps[2]) + ps[3] + prev;
            }
            i64x2 vf[4];
#pragma unroll
            for (int i = 0; i < 4; ++i) vf[i] = *(const i64x2*)(VCT + ((((size_t)g * 32 + st) * 4 + i) * 64 + lnB) * 16);
#pragma unroll
            for (int dt = 0; dt < 8; ++dt)
#pragma unroll
                for (int j = 0; j < NSA_NH; ++j) o[j][dt] = mma8(vf[dt >> 1][dt & 1], (i64_t)(((unsigned long long)(unsigned)pk[j][1] << 32) | (unsigned)pk[j][0]), o[j][dt]);
        }
#pragma unroll
        for (int j = 0; j < NSA_NH; ++j)
#pragma unroll
            for (int dt = 0; dt < 8; ++dt) *(h4*)(XN + (size_t)(t0 + (lane_id_v() & 15)) * D + (hh0 + j) * 128 + dt * 16 + 4 * (lane_id_v() >> 4)) = cvt4(o[j][dt] * (1.0f / 256.0f));
        asm volatile("" ::: "memory");
    }
    LDS_WAIT();
    int* selp = SEL + ((size_t)t * 2 + g) * 16;
    if (cur <= 15) { int z = 0; asm volatile("" : "+v"(z));
        if (fq == 0) {
#pragma unroll
            for (int b = 0; b < 16; ++b) selp[b] = z + b; } }
    else {
        float v[64];
#pragma unroll
        for (int kt = 0; kt < 64; ++kt) { const int jb = 4 * kt + fq; v[kt] = (jb >= 1 && jb <= cur - 2) ? psl[kt * 64 + lane] : -1.f; }
        if (fq == 0) { selp[0] = 0; selp[1] = cur - 1; selp[2] = cur; }
        for (int r = 0; r < 13; ++r) { float bv = -3.f; int bi = 0;
#pragma unroll
            for (int kt = 0; kt < 64; ++kt) if (v[kt] > bv) { bv = v[kt]; bi = 4 * kt + fq; }
#pragma unroll
            for (int off = 16; off < 64; off <<= 1) { const float ov = __shfl_xor(bv, off); const int oi = __shfl_xor(bi, off); if (ov > bv || (ov == bv && oi < bi)) { bv = ov; bi = oi; } }
            if (fq == 0) selp[3 + r] = bi;
#pragma unroll
            for (int kt = 0; kt < 64; ++kt) v[kt] = (4 * kt + fq == bi) ? -2.f : v[kt]; }
    }
}

__device__ __forceinline__ void nsa_slc_token(const int t, const int g, const u16* BOUT, const unsigned char* KST, const unsigned char* VST, const float* PG, const float* BGB, const float* ROPE, u16* XN, const int* SEL, const int lane) {
    const int fr = lane & 15, fq = lane >> 4;
    const unsigned l16 = (unsigned)lane * 16u;
    const float sc2 = 0.08838834764831845f * 1.4426950408889634f;
    const int cur = t >> 6, nsel = cur <= 15 ? cur + 1 : 16;
    const int myblk = (SEL + (size_t)t * 32 + g * 16)[fr];
    const unsigned char* ksg = KST + (size_t)g * 1024 * 2048; const unsigned char* vsg = VST + (size_t)g * 256 * 8192;
    const int frc = fr < 6 ? fr : 0;
    i64_t qb[4];
    { const u16* qrow = BOUT + (size_t)t * B_N + g * 768; const float* crow = ROPE + (size_t)t * 64; h8 q[4];
#pragma unroll
      for (int ks = 0; ks < 4; ++ks) { q[ks] = *(const h8*)(qrow + (unsigned)(frc * 128 + ks * 32 + fq * 8)); if (fr >= 6) q[ks] = (h8){0, 0, 0, 0, 0, 0, 0, 0}; }
#pragma unroll
      for (int ks = 0; ks < 2; ++ks) { const unsigned co = (unsigned)(ks * 32 + fq * 8);
          const f32x4 c0 = *(const f32x4*)(crow + co), c1 = *(const f32x4*)(crow + co + 4), s0 = *(const f32x4*)(crow + S * 64 + co), s1 = *(const f32x4*)(crow + S * 64 + co + 4);
          f32x4 a0, a1, b0, b1;
#pragma unroll
          for (int e = 0; e < 8; ++e) { const float c = e < 4 ? c0[e & 3] : c1[e & 3], sn = e < 4 ? s0[e & 3] : s1[e & 3]; const float x1 = (float)q[ks][e], x2 = (float)q[ks + 2][e]; const float r1 = x1 * c - x2 * sn, r2 = x2 * c + x1 * sn;
              if (e < 4) { a0[e] = r1; b0[e] = r2; } else { a1[e - 4] = r1; b1[e - 4] = r2; } }
          qb[ks] = pk8_fp8(a0, a1); qb[ks + 2] = pk8_fp8(b0, b1); } }
    float m = NSA_NEG, l = 0.f; f32x4 o[8];
#pragma unroll
    for (int dt = 0; dt < 8; ++dt) o[dt] = (f32x4){0.f, 0.f, 0.f, 0.f};
    typedef i64_t i64x2 __attribute__((ext_vector_type(2)));
    i64x2 kf[8];
    { const unsigned char* kb0 = ksg + (size_t)__builtin_amdgcn_readlane(myblk, 0) * 8192;
#pragma unroll
      for (int i = 0; i < 8; ++i) kf[i] = *(const i64x2*)(kb0 + (l16 + i * 1024u)); }
    for (int b = 0; b < nsel; ++b) {
        const int blk = __builtin_amdgcn_readlane(myblk, b); const int kbase = blk * 64;
        i64x2 vf[8];
        { const unsigned char* vb = vsg + (size_t)blk * 8192;
#pragma unroll
          for (int i = 0; i < 8; ++i) vf[i] = *(const i64x2*)(vb + (l16 + i * 1024u)); }
        const bool full = (kbase + 63 <= t);
        f32x4 s[4]; float bm = NSA_NEG;
#pragma unroll
        for (int kt = 0; kt < 4; ++kt) { f32x4 a = {0.f, 0.f, 0.f, 0.f};
            a = mma8k128(kf[kt * 2], kf[kt * 2 + 1], qb[0], qb[1], qb[2], qb[3], a);
            if (full) {
#pragma unroll
                for (int r = 0; r < 4; ++r) bm = fmaxf(bm, a[r]); }
            else {
#pragma unroll
                for (int r = 0; r < 4; ++r) { a[r] = (kbase + kt * 16 + 4 * fq + r <= t) ? a[r] : NSA_NEG; bm = fmaxf(bm, a[r]); } }
            s[kt] = a; }
        if (b + 1 < nsel) { const unsigned char* kb1 = ksg + (size_t)__builtin_amdgcn_readlane(myblk, b + 1) * 8192;
#pragma unroll
            for (int i = 0; i < 8; ++i) kf[i] = *(const i64x2*)(kb1 + (l16 + i * 1024u)); }
        bm = quad_max(bm) * sc2;
        const float mn = fmaxf(m, bm); float ps = 0.f;
        if (__ballot(mn > m) != 0ull) {
            const float corr = __builtin_amdgcn_exp2f(m - mn); l *= corr;
#pragma unroll
            for (int dt = 0; dt < 8; ++dt) o[dt] = o[dt] * corr; }
        m = mn;
        const float mn8 = mn - 8.0f;
        if (full) {
#pragma unroll
            for (int kt = 0; kt < 4; ++kt)
#pragma unroll
                for (int r = 0; r < 4; ++r) { const float pv = __builtin_amdgcn_exp2f(__builtin_fmaf(s[kt][r], sc2, -mn8)); s[kt][r] = pv; ps += pv; } }
        else {
#pragma unroll
            for (int kt = 0; kt < 4; ++kt)
#pragma unroll
                for (int r = 0; r < 4; ++r) { const float pv = (s[kt][r] > -1.0e29f) ? __builtin_amdgcn_exp2f(__builtin_fmaf(s[kt][r], sc2, -mn8)) : 0.f; s[kt][r] = pv; ps += pv; } }
        l += ps;
        const i64_t pf0 = pk8_fp8(s[0], s[1]), pf1 = pk8_fp8(s[2], s[3]);
#pragma unroll
        for (int dt = 0; dt < 8; ++dt) { f32x4 a = o[dt];
            a = mma8(vf[dt][0], pf0, a);
            a = mma8(vf[dt][1], pf1, a);
            o[dt] = a; }
    }
    l = quad_sum(l);
    if (fr < 6) { const float gs = nsa_gate(PG, t, (g * 6 + fr) * 3 + 1, BGB) / l; u16* xrow = XN + (size_t)t * D + g * 768;
#pragma unroll
        for (int dt = 0; dt < 8; ++dt) { h4* op = (h4*)(xrow + (unsigned)(fr * 128 + dt * 16 + 4 * fq));
            const f32x4 old = __builtin_convertvector(*op, f32x4); *op = cvt4(old + o[dt] * gs); } }
}

struct Args { const float* in[19]; float* out; unsigned char* ws; int ph_lo, ph_hi, li, pad; };
typedef const Args __attribute__((address_space(4))) CArgs;
#define I_X 0
#define I_MEM 1
#define I_NG 2
#define I_WG 3
#define I_WU 4
#define I_WDN 5
#define I_MEMNORM 6
#define I_MEMWKV 7
#define I_WOUT 8
#define I_AWIN 9
#define I_AGB 10
#define I_AHN 11
#define I_KVN 12
#define I_WKV 13
#define I_CPOS 14
#define I_CW1 15
#define I_CW2 16
#define I_BWIN 17
#define I_BGB 18
#define WSP(T, off) ((T*)(ws + (off)))


struct Ctx { LAS unsigned char* lds; unsigned char* ws0; int G, lo, hi, wave_id; XcdBarrier bar; };
#define PH_BEGIN if (lo <= ph && ph < hi) { \
        const unsigned long long _pt0 = (PROBE_MASK != 0u) ? __builtin_amdgcn_s_memrealtime() : 0ull; \
        int tid = wave_id * 64 + lane_id_v(); \
        const int lane = tid & 63, wave = __builtin_amdgcn_readfirstlane(tid >> 6); \
        const int gw = (int)blockIdx.x * NWAVES + wave, NGW = G * NWAVES; \
        CArgs* ap = (CArgs*)__builtin_amdgcn_kernarg_segment_ptr(); asm volatile("" : "+s"(ap)); \
        unsigned char* ws = ap->ws; (void)lane; (void)gw; (void)NGW; (void)ws;
#define PH_END   if (ph + 1 < hi) { const int tid_e = wave_id * 64 + lane_id_v(); if (MK_PER_PHASE) { if (tid_e == 0) __hip_atomic_store((gu32*)(ws0 + WS_CTL) + CW_TMO, 0xBADBA0u, RLX_AGENT); } else xcd_barrier(bar, tid_e); } \
        if ((PROBE_MASK >> ph) & 1u) probe_acc += __builtin_amdgcn_s_memrealtime() - _pt0; } ++ph;


template <int F> __device__ __forceinline__ void ffn_stage(const Ctx& cx, int& ph, unsigned long long& probe_acc) {
    LAS unsigned char* const lds = cx.lds; unsigned char* const ws0 = cx.ws0; const int G = cx.G, lo = cx.lo, hi = cx.hi, wave_id = cx.wave_id; const XcdBarrier bar = cx.bar;
        constexpr int f = F; constexpr int layer = F >> 1;
        PH_BEGIN
        {
            if constexpr (F == 2) {
                const int b = blockIdx.x, idx = (b >> 2) & 3, sp = (b >> 4) & 7, c = idx >> 1, gg = idx & 1;
                pg8::Gemm g3{WSP(u16, WS_KCS) + (size_t)idx * (S + 32) * 128 + sp * 512, WSP(u16, WS_WC1) + (size_t)c * 256 * 4096 + sp * 512, 1024, 256, 512, 16 * 128, 4096}; pg8::StaticOrder S3; S3.init(1024, 256, G, b < 128 ? (b & 3) : 1 << 20);
                pg8::EpiF32 E3{WSP(float, WS_PART) + (size_t)(sp * 4 + idx) * 1024 * 256, 256};
                pg8::gemm_phase<pg8::EpiF32, pg8::StaticOrder, true, true, false>(lds + RING_OFF, g3, S3, E3, tid);
            }
            pg8::Gemm g{F == 3 ? WSP(u16, WS_X16B) : (const u16*)(ap->out + (size_t)S * D / 2), WSP(u16, WS_WGU) + (size_t)f * 2 * FF * D, S, 2 * FF, D, D, D}; pg8::StaticOrder So; So.init(S, 2 * FF, G, (int)blockIdx.x, 4);
            if constexpr (F == 0) { pg8::EpiSwiGLU E{WSP(u16, WS_H), FF, WSP(float, WS_RINV)};
                pg8::gemm_phase<pg8::EpiSwiGLU, pg8::StaticOrder, true, true, false>(lds + RING_OFF, g, So, E, tid); }
            else if constexpr (F >= 1) {
                pg8::Gemm g8{(const u16*)(WSP(unsigned char, WS_H) + (size_t)100 * MiB), WSP(u16, WS_WGU) + (size_t)f * 2 * FF * D, S, 2 * FF, D / 2, D / 2, D / 2};
                pg8::EpiSwiGLU8 E{WSP(unsigned char, WS_H), FF, WSP(float, WS_RINV), 1.0f / 8192.0f};
                pg8::gemm_phase<pg8::EpiSwiGLU8, pg8::StaticOrder, true, true, false, true>(lds + RING_OFF, g8, So, E, tid); }
            else { pg8::EpiSwiGLU8 E{WSP(unsigned char, WS_H), FF, WSP(float, WS_RINV)};
                pg8::gemm_phase<pg8::EpiSwiGLU8, pg8::StaticOrder, true, true, false>(lds + RING_OFF, g, So, E, tid); }
            if constexpr (F == 0) {
                const int b = blockIdx.x, l = (b >> 4) & 1, sp = (b >> 2) & 3;
                pg8::Gemm g2{WSP(u16, WS_MEMN) + (size_t)l * MEM_LEN * D + sp * 512, WSP(u16, WS_WMKV) + (size_t)l * 1024 * D + sp * 512, 256, 1024, 512, D, D}; pg8::StaticOrder S2; S2.init(256, 1024, G, b < 32 ? (b & 3) : 1 << 20);
                pg8::EpiF32 E2{WSP(float, WS_PART) + (size_t)(sp * 2 + l) * MEM_LEN * 1024, 1024};
                pg8::gemm_phase<pg8::EpiF32, pg8::StaticOrder, true, true, false>(lds + RING_OFF, g2, S2, E2, tid);
            }
        }
        PH_END
        PH_BEGIN
        {
            pg8::StaticOrder So; So.init(S, D, G, (int)blockIdx.x, 4);
            if constexpr (F == 0) {
                pg8::Gemm g{WSP(u16, WS_H), WSP(u16, WS_WD), S, D, FF, FF, FF};
                pg8::EpiF16<0> E{WSP(u16, WS_Y), D, nullptr, nullptr};
                pg8::gemm_phase<pg8::EpiF16<0>, pg8::StaticOrder, true, true, false>(lds + RING_OFF, g, So, E, tid); }
            if constexpr (F == 0) {} else {
                const float* gpost = ap->in[I_NG] + (size_t)(layer * 6 + ((f & 1) ? 5 : 1)) * D; u16* X = (u16*)(ap->out + (size_t)S * D / 2);
                pg8::Gemm g{WSP(u16, WS_H), WSP(u16, WS_WD) + (size_t)f * D * FF, S, D, FF / 2, FF / 2, FF / 2};
                pg8::EpiResNorm<F == 3, F == 1> E{F == 3 ? WSP(u16, WS_X16B) : X, F == 3 ? (void*)ap->out : (void*)X, gpost, 0.5f, WSP(unsigned, WS_SLOT), WSP(unsigned, WS_CTL) + CW_RN + (F - 1) * 512, WSP(float, WS_RINV), lds + RING_OFF + 131072,
                                                  F == 1 ? WSP(unsigned char, WS_H) + (size_t)100 * MiB : nullptr};
                pg8::gemm_phase<pg8::EpiResNorm<F == 3, F == 1>, pg8::StaticOrder, true, true, false, true>(lds + RING_OFF, g, So, E, tid); }
            if constexpr (F == 0) {
                const f32x4* pm = (const f32x4*)WSP(float, WS_PART);
                for (int e = blockIdx.x * 512 + tid; e < 2 * MEM_LEN * 1024 / 4; e += G * 512) { const f32x4 v = (pm[e] + pm[e + 131072]) + (pm[e + 2 * 131072] + pm[e + 3 * 131072]);
                    u32x2 w; w.x = pkh(v.x, v.y); w.y = pkh(v.z, v.w); ((u32x2*)WSP(u16, WS_MEMKV))[e] = w; }
            }
            if constexpr (F == 2) {
                const f32x4* pc = (const f32x4*)WSP(float, WS_PART);
                for (int e = blockIdx.x * 512 + tid; e < 4 * 1024 * 256 / 4; e += G * 512) { f32x4 v = pc[e];
#pragma unroll
                    for (int sp = 1; sp < 8; ++sp) v = v + pc[e + sp * 262144];
                    const int idx = e >> 16, k4 = (e & 63) * 4; const f32x4 bb = *(const f32x4*)(WSP(float, WS_CB1) + (idx >> 1) * 256 + k4); v = v + bb;
                    u32x2 w; w.x = pkh(pg8::gelu_tanh(v.x), pg8::gelu_tanh(v.y)); w.y = pkh(pg8::gelu_tanh(v.z), pg8::gelu_tanh(v.w)); ((u32x2*)WSP(u16, WS_CMPH))[e] = w; }
            }
        }
        PH_END
        if constexpr (F == 0) {
        PH_BEGIN
        {
            const float* gl = ap->in[I_NG] + (size_t)layer * 6 * D;
            const float* gpost = gl + (size_t)1 * D;
            u16* X = (u16*)(ap->out + (size_t)S * D / 2); const u16* Y = WSP(u16, WS_Y);
            if constexpr (F == 0) {
            LAS float* wgl = (LAS float*)(lds + RING_OFF);
            for (int e = tid; e < 8 * D / 4; e += 512) ((LAS f32x4*)wgl)[e] = ((const f32x4*)WSP(float, WS_WGA))[e];
            __syncthreads();
            thin_rows<8, true, true>(Y, 0.5f, gpost, X, X, WSP(float, WS_RINV), wgl, ap->in[I_AGB], WSP(float, WS_GA), gw, NGW, lane); }
            else if constexpr (F == 3) thin_rows<0, true, false>(Y, 0.5f, ap->in[I_NG] + (size_t)(layer * 6 + 5) * D, WSP(u16, WS_X16B), ap->out, nullptr, nullptr, nullptr, nullptr, gw, NGW, lane);
            else thin_rows<0, true, true>(Y, 0.5f, ap->in[I_NG] + (size_t)(layer * 6 + ((f & 1) ? 5 : 1)) * D, X, X, WSP(float, WS_RINV), nullptr, nullptr, nullptr, gw, NGW, lane);
        }
        PH_END
        }

        if constexpr (F == 1) {
            PH_BEGIN
            {
                pg8::Gemm g{(const u16*)(ap->out + (size_t)S * D / 2), WSP(u16, WS_WKV), S, KVW, D, D, D}; pg8::StaticOrder So; So.init(S, KVW, G, (int)blockIdx.x);
                pg8::EpiKV E{WSP(u16, WS_KVRAW), KVW, WSP(u16, WS_KCS), S + 32, WSP(float, WS_RINV)};
                pg8::gemm_phase<pg8::EpiKV, pg8::StaticOrder, true, true, false>(lds + RING_OFF, g, So, E, tid);
                for (int e = blockIdx.x * 512 + tid; e < 4 * 32 * 128 / 2; e += G * 512) WSP(unsigned, WS_KCS)[((size_t)(e >> 11) * (S + 32) + S) * 64 + (e & 2047)] = 0u;
            }
            PH_END
        }
        if constexpr (F == 0 || F == 2) {
            constexpr bool isA = (F == 0);
            PH_BEGIN
            {
                const int ldq = isA ? A_N : B_N;
                pg8::Gemm g{(const u16*)(ap->out + (size_t)S * D / 2), isA ? WSP(u16, WS_WAIN) : WSP(u16, WS_WBIN), S, ldq, D, D, D}; pg8::StaticOrder So; So.init(S, ldq, G, (int)blockIdx.x);
                pg8::EpiF16<0, true> E{isA ? WSP(u16, WS_AOUT) : WSP(u16, WS_BOUT), ldq, nullptr, WSP(float, WS_RINV)};
                pg8::gemm_phase<pg8::EpiF16<0, true>, pg8::StaticOrder, true, true, false>(lds + RING_OFF, g, So, E, tid);
                if constexpr (!isA) {
                    const int b = blockIdx.x, sp = b & 3;
                    pg8::Gemm gg{(const u16*)(ap->out + (size_t)S * D / 2) + sp * 512, WSP(u16, WS_WBIN) + (size_t)2048 * D + sp * 512, S, 256, 512, D, D}; pg8::StaticOrder Sg; Sg.init(S, 256, G, b < 256 ? (b >> 2) : 1 << 20);
                    pg8::EpiF32S<true, true> Eg{WSP(float, WS_PG) + (size_t)sp * S * 256, 256, WSP(float, WS_RINV)};
                    pg8::gemm_phase<pg8::EpiF32S<true, true>, pg8::StaticOrder, true, true, false>(lds + RING_OFF, gg, Sg, Eg, tid);
                }
                if constexpr (!isA) {
                {
                    const int fr = lane & 15, fq = lane >> 4;
                    for (int item = (int)blockIdx.x; item < 4 * 64; item += G) { const int idx = item >> 6, nt = item & 63, c = idx >> 1, gg = idx & 1;
                        h8 hb[8];
#pragma unroll
                        for (int ks = 0; ks < 8; ++ks) hb[ks] = *(const h8*)(WSP(u16, WS_CMPH) + ((size_t)idx * 1024 + nt * 16 + fr) * 256 + ks * 32 + fq * 8);
                        { const int dt = wave; f32x4 acc = {0.f, 0.f, 0.f, 0.f};
#pragma unroll
                            for (int ks = 0; ks < 8; ++ks) acc = mma16(*(const h8*)(WSP(u16, WS_WC2) + ((size_t)c * 128 + dt * 16 + fr) * 256 + ks * 32 + fq * 8), hb[ks], acc);
                            if (c == 0) *(h4*)(WSP(u16, WS_KVC) + ((((size_t)gg * 64 + nt) * 4 + (dt >> 1)) * 64 + (2 * (dt & 1) + (fq >> 1)) * 16 + fr) * 8 + 4 * (fq & 1)) = cvt4(acc);
                            else {
#pragma unroll
                                for (int r = 0; r < 4; ++r) WSP(unsigned char, WS_KVC)[(size_t)2 * 1024 * 128 * 2 + ((((size_t)gg * 32 + (nt >> 1)) * 4 + (dt >> 1)) * 64 + (fr >> 2) * 16 + 4 * fq + r) * 16 + (dt & 1) * 8 + (fr & 3) + 4 * (nt & 1)] =
                                    (unsigned char)(__builtin_amdgcn_cvt_pk_fp8_f32(acc[r], acc[r], 0, false) & 0xff); }
                            asm volatile("" ::: "memory"); } }
                }
                    const u16* KVRAW = WSP(u16, WS_KVRAW); const float* ROPE = WSP(float, WS_ROPE);
                    for (int e = blockIdx.x * 512 + tid; e < 2 * 2 * 1024 * 64; e += G * 512) {
                        const int ln = e & 63, kt = (e >> 6) & 1023, gg = (e >> 16) & 1, wh = e >> 17, fr_ = ln & 15, fq_ = ln >> 4, key = kt * 16 + fr_;
                        const u16* src = KVRAW + (size_t)key * KVW + (wh ? 1024 : 512) + gg * 128 + fq_ * 8; const float* cp = ROPE + (size_t)key * 64 + fq_ * 8; const float* sp = cp + (size_t)S * 64;
                        i64_t fr8[4];
#pragma unroll
                        for (int ks = 0; ks < 2; ++ks) { const h8 x1 = *(const h8*)(src + ks * 32), x2 = *(const h8*)(src + ks * 32 + 64); f32x4 a0, a1, b0, b1;
#pragma unroll
                            for (int j = 0; j < 8; ++j) { const float c = cp[ks * 32 + j], sn = sp[ks * 32 + j], v1 = (float)x1[j], v2 = (float)x2[j]; const float r1 = v1 * c - v2 * sn, r2 = v2 * c + v1 * sn;
                                if (j < 4) { a0[j] = r1; b0[j] = r2; } else { a1[j - 4] = r1; b1[j - 4] = r2; } }
                            fr8[ks] = pk8_fp8(a0, a1); fr8[ks + 2] = pk8_fp8(b0, b1); }
                        i64_t* dst = (i64_t*)((wh ? WSP(unsigned char, WS_KWT) : WSP(unsigned char, WS_KST)) + ((((size_t)gg * 1024 + kt) * 2) * 64 + ln) * 16);
                        dst[0] = fr8[0]; dst[1] = fr8[1]; dst[128] = fr8[2]; dst[129] = fr8[3]; }
                    for (int e = blockIdx.x * 512 + tid; e < 2 * 512 * 4 * 64; e += G * 512) {
                        const int ln = e & 63, dp = (e >> 6) & 3, kb = (e >> 8) & 511, gg = e >> 17, fr_ = ln & 15, fq_ = ln >> 4; i64_t o2[2];
#pragma unroll
                        for (int h2_ = 0; h2_ < 2; ++h2_) { const int d = (2 * dp + h2_) * 16 + fr_; const u16* src = KVRAW + (size_t)(kb * 32 + 4 * fq_) * KVW + 1280 + gg * 128 + d; f32x4 a, b2;
#pragma unroll
                            for (int j = 0; j < 4; ++j) { a[j] = (float)*(const f16*)(src + (size_t)j * KVW); b2[j] = (float)*(const f16*)(src + (size_t)(16 + j) * KVW); }
                            o2[h2_] = pk8_fp8(a, b2); }
                        i64_t* dst = (i64_t*)(WSP(unsigned char, WS_VWT) + ((((size_t)gg * 512 + kb) * 4 + dp) * 64 + ln) * 16); dst[0] = o2[0]; dst[1] = o2[1]; }
                    for (int e = blockIdx.x * 512 + tid; e < 2 * 256 * 8 * 64; e += G * 512) {
                        const int ln = e & 63, dt = (e >> 6) & 7, blk = (e >> 9) & 255, gg = e >> 17, fr_ = ln & 15, fq_ = ln >> 4, d = dt * 16 + fr_;
                        const u16* src = KVRAW + (size_t)(blk * 64 + 4 * fq_) * KVW + 768 + gg * 128 + d; i64_t o2[2];
#pragma unroll
                        for (int kb = 0; kb < 2; ++kb) { f32x4 a, b2;
#pragma unroll
                            for (int j = 0; j < 4; ++j) { a[j] = (float)*(const f16*)(src + (size_t)(kb * 32 + j) * KVW); b2[j] = (float)*(const f16*)(src + (size_t)(kb * 32 + 16 + j) * KVW); }
                            o2[kb] = pk8_fp8(a, b2); }
                        i64_t* dst = (i64_t*)(WSP(unsigned char, WS_VST) + ((((size_t)gg * 256 + blk) * 8 + dt) * 64 + ln) * 16); dst[0] = o2[0]; dst[1] = o2[1]; }
                }
            }
            PH_END
            if constexpr (isA) {
                PH_BEGIN
                {
                    const u16* AOUT = WSP(u16, WS_AOUT); const float* GA = WSP(float, WS_GA); u16* CT = WSP(u16, WS_CT);
                    mem_attn_mfma(AOUT, A_N, 4608, WSP(u16, WS_MEMKV), WSP(u16, WS_XN), lds + RING_OFF, tid, G);
                    const int fr = lane & 15, fq = lane >> 4;
                    LAS f16* KT = (LAS f16*)(lds + RING_OFF);
                    LAS f16* VT = (LAS f16*)(lds + RING_OFF + 27648);
                    LAS float* fv = (LAS float*)(lds + RING_OFF + 27648 + 55296);
                    h8 pk_[3], pv_[6];
#define ML_LOC_LOAD(u_) do { const int h_ = (u_) >> 8, t0_ = ((u_) & 255) * ML_L; const int tid_ = wave * 64 + lane_id_v();     \
                        _Pragma("unroll") for (int i = 0; i < 3; ++i) { const int e = tid_ + i * 512, s_ = e & 63, cc = e >> 6; pk_[i] = *(const h8*)(AOUT + (size_t)(t0_ + s_) * A_N + 768 + h_ * 192 + cc * 8); } \
                        _Pragma("unroll") for (int i = 0; i < 6; ++i) { const int e = tid_ + i * 512, s_ = e & 63, cc = e >> 6; pv_[i] = *(const h8*)(AOUT + (size_t)(t0_ + s_) * A_N + 1536 + h_ * 384 + cc * 8); } } while (0)
                    if ((int)blockIdx.x < ML_H * ML_NC) ML_LOC_LOAD((int)blockIdx.x);
                    for (int u = blockIdx.x; u < ML_H * ML_NC; u += G) {
                        const int h = u >> 8, c = u & 255, t0 = c * ML_L;
                        __syncthreads();
                        if (tid < 64) { const int t = t0 + tid;
                            const float b = wave_scan_add(log_sigmoidf_(GA[(size_t)t * 8 + 4 + h]), tid), ic = GA[(size_t)t * 8 + h];
                            const float b63 = __shfl(b, 63), gsv = b63 - b + ic, ml = wave_max(gsv);
                            fv[128 + tid] = __expf(gsv - ml);
                            if (tid == 0) { WSP(float, WS_B63)[u] = b63; WSP(float, WS_MLOC)[u] = ml; } }
                        __syncthreads();
#pragma unroll
                        for (int i = 0; i < 3; ++i) { const int e = tid + i * 512, s = e & 63, cc = e >> 6; const float wsc = fv[128 + s]; const h8 kv = pk_[i];
#pragma unroll
                            for (int j = 0; j < 8; ++j) KT[(cc * 8 + j) * 72 + s] = (f16)((float)kv[j] * wsc); }
#pragma unroll
                        for (int i = 0; i < 6; ++i) { const int e = tid + i * 512, s = e & 63, cc = e >> 6; const h8 vv = pv_[i];
#pragma unroll
                            for (int j = 0; j < 8; ++j) VT[(cc * 8 + j) * 72 + s] = vv[j]; }
                        if (u + G < ML_H * ML_NC) ML_LOC_LOAD(u + G);
                        __syncthreads();
                        h8 bf[3][2];
#pragma unroll
                        for (int vi = 0; vi < 3; ++vi)
#pragma unroll
                            for (int ks = 0; ks < 2; ++ks) bf[vi][ks] = *(const LAS h8*)(VT + ((wave * 3 + vi) * 16 + fr) * 72 + ks * 32 + fq * 8);
                        u16* ctu = CT + (size_t)u * ML_DV * ML_DQK;
#pragma unroll 2
                        for (int di = 0; di < 12; ++di) {
                            const h8 a0 = *(const LAS h8*)(KT + (di * 16 + fr) * 72 + fq * 8), a1 = *(const LAS h8*)(KT + (di * 16 + fr) * 72 + 32 + fq * 8);
#pragma unroll
                            for (int vi = 0; vi < 3; ++vi) { f32x4 acc = {0.f, 0.f, 0.f, 0.f}; acc = mma16(a0, bf[vi][0], acc); acc = mma16(a1, bf[vi][1], acc);
                                *(h4*)(ctu + ((size_t)((wave * 3 + vi) * 6 + (di >> 1)) * 64 + (2 * (di & 1) + (fq >> 1)) * 16 + fr) * 8 + 4 * (fq & 1)) = cvt4(acc); } }
                        if (tid < ML_DQK) { float a = 0.f; for (int s = 0; s < 64; ++s) a += (float)KT[tid * 72 + s]; WSP(float, WS_DN)[(size_t)u * ML_DQK + tid] = a; }
                    }
                }
                PH_END
                PH_BEGIN
                {
                    const float* B63 = WSP(float, WS_B63); const float* MLOC = WSP(float, WS_MLOC);
                    LAS float* dec = (LAS float*)(lds + RING_OFF); LAS float* scl = dec + 256;
                    constexpr int PER_HEAD = ML_DV * ML_DQK / 4;
                    const int per_wg = (ML_H * PER_HEAD) / G, wg_per_head = PER_HEAD / per_wg;
                    const int h = (int)blockIdx.x / wg_per_head, sub = (int)blockIdx.x % wg_per_head;
                    if (tid < 64) {
                        float bb[4], mm[4], A = -3.0e38f, B = 0.f;
#pragma unroll
                        for (int j = 0; j < 4; ++j) { bb[j] = B63[h * 256 + 4 * tid + j]; mm[j] = MLOC[h * 256 + 4 * tid + j]; A = fmaxf(mm[j], bb[j] + A); B += bb[j]; }
#pragma unroll
                        for (int o = 1; o < 64; o <<= 1) { const float Ae = __shfl_up(A, o), Be = __shfl_up(B, o); if (tid >= o) { A = fmaxf(A, B + Ae); B += Be; } }
                        float Ax = __shfl_up(A, 1), Bx = __shfl_up(B, 1); if (tid == 0) { Ax = -3.0e38f; Bx = 0.f; }
                        float m = fmaxf(Ax, Bx);
#pragma unroll
                        for (int j = 0; j < 4; ++j) { const float mn = fmaxf(mm[j], bb[j] + m); dec[4 * tid + j] = __expf(bb[j] + m - mn); scl[4 * tid + j] = __expf(mm[j] - mn);
                            if (sub == 0) WSP(float, WS_MST)[h * 256 + 4 * tid + j] = m; m = mn; } }
                    __syncthreads();
                    if (tid < per_wg) {
                        u32x2* p = WSP(u32x2, WS_CT) + (size_t)h * ML_NC * PER_HEAD + sub * per_wg + tid;
                        f32x4 cs = {0.f, 0.f, 0.f, 0.f};
                        for (int c = 0; c < ML_NC; c += 32) { u32x2 dv[32];
#pragma unroll
                            for (int j = 0; j < 32; ++j) dv[j] = p[(size_t)(c + j) * PER_HEAD];
#pragma unroll
                            for (int j = 0; j < 32; ++j) { const f32x4 d4 = __builtin_convertvector(__builtin_bit_cast(h4, dv[j]), f32x4); u32x2 w; w.x = pkh(cs.x, cs.y); w.y = pkh(cs.z, cs.w); p[(size_t)(c + j) * PER_HEAD] = w;
                                cs = cs * dec[c + j] + d4 * scl[c + j]; } } }
                    else if (sub == 0 && tid >= 320 && tid < 320 + ML_DQK) { float n = 0.f; float* q = WSP(float, WS_DN) + (size_t)h * 256 * ML_DQK + (tid - 320);
                        for (int c = 0; c < ML_NC; c += 16) { float dv[16];
#pragma unroll
                            for (int j = 0; j < 16; ++j) dv[j] = q[(size_t)(c + j) * ML_DQK];
#pragma unroll
                            for (int j = 0; j < 16; ++j) { q[(size_t)(c + j) * ML_DQK] = n; n = dec[c + j] * n + scl[c + j] * dv[j]; } } }
                }
                PH_END
                PH_BEGIN
                {
                    const u16* AOUT = WSP(u16, WS_AOUT); const float* GA = WSP(float, WS_GA); u16* XN = WSP(u16, WS_XN);
                    const int fr = lane & 15, fq = lane >> 4;
                    LAS f16* Qs = (LAS f16*)(lds + RING_OFF);
                    LAS f16* Ks = (LAS f16*)(lds + RING_OFF + 25600);
                    LAS f16* VT = (LAS f16*)(lds + RING_OFF + 51200);
                    LAS f16* Sm = (LAS f16*)(lds + RING_OFF + 106496);
                    LAS float* fv = (LAS float*)(lds + RING_OFF + 115712);
                    h8 rq[3], rk[3], rv[6];
#define ML_OUT_LOAD(u_) do { const int h_ = (u_) >> 8, t0_ = ((u_) & 255) * ML_L; const int tid_ = wave * 64 + lane_id_v();     \
                        _Pragma("unroll") for (int i = 0; i < 3; ++i) { const int e = tid_ + i * 512, s_ = e / 24, cc = e % 24; \
                            rq[i] = *(const h8*)(AOUT + (size_t)(t0_ + s_) * A_N + h_ * 192 + cc * 8); rk[i] = *(const h8*)(AOUT + (size_t)(t0_ + s_) * A_N + 768 + h_ * 192 + cc * 8); } \
                        _Pragma("unroll") for (int i = 0; i < 6; ++i) { const int e = tid_ + i * 512, s_ = e & 63, cc = e >> 6; \
                            rv[i] = *(const h8*)(AOUT + (size_t)(t0_ + s_) * A_N + 1536 + h_ * 384 + cc * 8); } } while (0)
                    if ((int)blockIdx.x < ML_H * ML_NC) ML_OUT_LOAD((int)blockIdx.x);
                    for (int u = blockIdx.x; u < ML_H * ML_NC; u += G) {
                        const int h = u >> 8, c = u & 255, t0 = c * ML_L;
                        const u16* ctp = WSP(u16, WS_CT) + (size_t)u * ML_DV * ML_DQK;
                        h8 aCall[3][6];
#pragma unroll
                        for (int vi = 0; vi < 3; ++vi)
#pragma unroll
                            for (int ks = 0; ks < 6; ++ks) aCall[vi][ks] = *(const h8*)(ctp + ((size_t)((wave * 3 + vi) * 6 + ks) * 64 + lane) * 8);
                        __syncthreads();
                        if (tid < 64) { const int t = t0 + tid; const float mc = WSP(float, WS_MST)[u];
                            const float b = wave_scan_add(log_sigmoidf_(GA[(size_t)t * 8 + 4 + h]), tid), a = GA[(size_t)t * 8 + h] - b;
                            const float mx = fmaxf(wave_scan_max(a, tid), mc);
                            fv[tid] = b; fv[64 + tid] = a; fv[128 + tid] = mx; fv[192 + tid] = __expf(mc - mx); fv[320 + tid] = 0.f; }
#pragma unroll
                        for (int i = 0; i < 3; ++i) { const int e = tid + i * 512, s = e / 24, cc = e % 24;
                            *(LAS h8*)(Qs + s * 200 + cc * 8) = rq[i]; *(LAS h8*)(Ks + s * 200 + cc * 8) = rk[i]; }
#pragma unroll
                        for (int i = 0; i < 6; ++i) { const int e = tid + i * 512, s = e & 63, cc = e >> 6; const h8 vv = rv[i];
#pragma unroll
                            for (int j = 0; j < 8; ++j) VT[(cc * 8 + j) * 72 + s] = vv[j]; }
                        if (u + G < ML_H * ML_NC) ML_OUT_LOAD(u + G);
                        __syncthreads();
#pragma unroll
                        for (int q2 = 0; q2 < 2; ++q2) { const int tl = wave * 2 + q2, si = tl >> 2, tj = tl & 3; f32x4 acc = {0.f, 0.f, 0.f, 0.f};
#pragma unroll
                            for (int ks = 0; ks < 6; ++ks) acc = mma16(*(const LAS h8*)(Ks + (si * 16 + fr) * 200 + ks * 32 + fq * 8), *(const LAS h8*)(Qs + (tj * 16 + fr) * 200 + ks * 32 + fq * 8), acc);
                            const int t = tj * 16 + fr; const float mxt = fv[128 + t];
#pragma unroll
                            for (int r = 0; r < 4; ++r) { const int sx = si * 16 + 4 * fq + r; acc[r] = (sx <= t) ? acc[r] * __expf(fv[64 + sx] - mxt) : 0.f; }
                            *(LAS h4*)(Sm + t * 72 + si * 16 + 4 * fq) = cvt4(acc); }
                        __syncthreads();
                        { const int t = tid >> 3, part = tid & 7; float den = 0.f, qn = 0.f; const float* np = WSP(float, WS_DN) + (size_t)u * ML_DQK;
#pragma unroll
                            for (int s8 = 0; s8 < 8; ++s8) den += (float)Sm[t * 72 + part * 8 + s8];
                            for (int d = part * 24; d < part * 24 + 24; ++d) qn += (float)Qs[t * 200 + d] * np[d];
                            den += fv[192 + t] * qn;
                            den += __shfl_xor(den, 1); den += __shfl_xor(den, 2); den += __shfl_xor(den, 4);
                            if (part == 0) { const float mvec = fv[t] + fv[128 + t]; fv[256 + t] = fmaxf(fabsf(den), __expf(-mvec)); } }
                        __syncthreads();
                        h4 hv[3][4]; float ssq[4] = {0.f, 0.f, 0.f, 0.f};
#pragma unroll
                        for (int vi = 0; vi < 3; ++vi) { const int vt = wave * 3 + vi; h8 aV[2]; const h8 (&aC)[6] = aCall[vi];
#pragma unroll
                            for (int ks = 0; ks < 2; ++ks) aV[ks] = *(const LAS h8*)(VT + (vt * 16 + fr) * 72 + ks * 32 + fq * 8);
#pragma unroll
                            for (int tj = 0; tj < 4; ++tj) { const int tt = tj * 16 + fr; f32x4 a1 = {0.f, 0.f, 0.f, 0.f}, a2 = {0.f, 0.f, 0.f, 0.f};
#pragma unroll
                                for (int ks = 0; ks < 2; ++ks) a1 = mma16(aV[ks], *(const LAS h8*)(Sm + tt * 72 + ks * 32 + fq * 8), a1);
#pragma unroll
                                for (int ks = 0; ks < 6; ++ks) a2 = mma16(aC[ks], *(const LAS h8*)(Qs + tt * 200 + ks * 32 + fq * 8), a2);
                                const f32x4 hx = (a1 + a2 * fv[192 + tt]) * (1.0f / fv[256 + tt]); hv[vi][tj] = cvt4(hx); ssq[tj] += (hx[0] * hx[0] + hx[1] * hx[1]) + (hx[2] * hx[2] + hx[3] * hx[3]); }
                            asm volatile("" ::: "memory"); }
#pragma unroll
                        for (int tj = 0; tj < 4; ++tj) { const float q = quad_sum(ssq[tj]); if (fq == 0) fv[384 + wave * 64 + tj * 16 + fr] = q; }
                        h4 ogv[4][3];
#pragma unroll
                        for (int tj = 0; tj < 4; ++tj)
#pragma unroll
                            for (int vi = 0; vi < 3; ++vi) ogv[tj][vi] = *(const h4*)(AOUT + (size_t)(t0 + tj * 16 + (lane_id_v() & 15)) * A_N + 3072 + h * ML_DV + (wave * 3 + vi) * 16 + 4 * (lane_id_v() >> 4));
                        __syncthreads();
                        if (tid < 64) { float q = 0.f;
#pragma unroll
                            for (int w8 = 0; w8 < 8; ++w8) q += fv[384 + w8 * 64 + tid];
                            fv[320 + tid] = q; }
                        __syncthreads();
#pragma unroll
                        for (int tj = 0; tj < 4; ++tj) { const int tt = tj * 16 + fr; const float rn = rsqrtf(fv[320 + tt] * (1.0f / ML_DV) + EPS);
#pragma unroll
                            for (int vi = 0; vi < 3; ++vi) { const int v0 = (wave * 3 + vi) * 16 + 4 * fq;
                                const h4 og = ogv[tj][vi]; const f32x4 hn = *(const f32x4*)(ap->in[I_AHN] + h * ML_DV + v0); f32x4 o;
#pragma unroll
                                for (int r = 0; r < 4; ++r) o[r] = (float)hv[vi][tj][r] * rn * hn[r] * sigmoidf_((float)og[r]);
                                *(h4*)(XN + (size_t)(t0 + tt) * D + h * ML_DV + v0) = cvt4(o); }
                            asm volatile("" ::: "memory"); }
                    }
                }
                PH_END
            } else {
                PH_BEGIN
                {
                    const u16* BOUT = WSP(u16, WS_BOUT); u16* XN = WSP(u16, WS_XN);
                    mem_attn_mfma(BOUT, B_N, 1536, WSP(u16, WS_MEMKV) + (size_t)MEM_LEN * 1024, XN, lds + RING_OFF, tid, G);
                    LAS float* psl = (LAS float*)(lds + RING_OFF + wave * WAVE_LDS);
                    const int wrank = wave < 4 ? wave : 11 - wave;
                    for (int item = wrank * G + (int)blockIdx.x; item < (S / 16) * 2; item += NGW)
                        nsa_tile((S / 16 - 1 - (item >> 1)) * 16, item & 1, BOUT, WSP(unsigned char, WS_KWT), WSP(u16, WS_KVC), WSP(unsigned char, WS_KVC) + (size_t)2 * 1024 * 128 * 2, WSP(unsigned char, WS_VWT),
                                 WSP(float, WS_PG), ap->in[I_BGB], WSP(float, WS_ROPE), XN, WSP(int, WS_SEL), psl, lane_id_v());
                }
                PH_END
                PH_BEGIN
                {
                    const int g = blockIdx.x & 1;
                    const int strm = (int)((blockIdx.x >> 1) + wave) & 7;
                    gu32* ctr = (gu32*)(ws + WS_CTL) + CW_SLC + (g * 8 + strm) * 64;
                    int n = 0; if (lane == 0) n = (int)__hip_atomic_fetch_add(ctr, 1u, RLX_AGENT); n = __builtin_amdgcn_readfirstlane(n);
                    while (n < S / 8) {
                        int nn = 0; if (lane == 0) nn = (int)__hip_atomic_fetch_add(ctr, 1u, RLX_AGENT);
                        nsa_slc_token(n * 8 + strm, g, WSP(u16, WS_BOUT), WSP(unsigned char, WS_KST), WSP(unsigned char, WS_VST), WSP(float, WS_PG), ap->in[I_BGB], WSP(float, WS_ROPE), WSP(u16, WS_XN), WSP(int, WS_SEL), lane_id_v());
                        n = __builtin_amdgcn_readfirstlane(nn); }
                }
                PH_END
            }
            PH_BEGIN
            {
                pg8::Gemm g{WSP(u16, WS_XN), WSP(u16, WS_WOUT) + (size_t)layer * D * D, S, D, D, D, D}; pg8::StaticOrder So; So.init(S, D, G, (int)blockIdx.x, 4);
                u16* X = (u16*)(ap->out + (size_t)S * D / 2);
                pg8::EpiResNorm<false, true> E{X, isA ? (void*)X : (void*)WSP(u16, WS_X16B), ap->in[I_NG] + (size_t)(layer * 6 + 3) * D, 1.0f, WSP(unsigned, WS_SLOT), WSP(unsigned, WS_CTL) + CW_RN + (isA ? 3 : 4) * 512, WSP(float, WS_RINV), lds + RING_OFF + 131072,
                                               WSP(unsigned char, WS_H) + (size_t)100 * MiB};
                pg8::gemm_phase<pg8::EpiResNorm<false, true>, pg8::StaticOrder, true, true, false>(lds + RING_OFF, g, So, E, tid);
            }
            PH_END
        }

}

__global__ void __launch_bounds__(NWAVES * 64, 2) yoco_fwd(Args args) {
    extern __shared__ __attribute__((aligned(16))) unsigned char lds_raw[];
    LAS unsigned char* lds = (LAS unsigned char*)lds_raw;
    const int G = gridDim.x;
    { volatile LAS unsigned* MISC0 = (volatile LAS unsigned*)(lds + LDSCTL_OFF);
      for (int u = threadIdx.x; u < LDSCTL_BYTES / 4; u += NWAVES * 64) MISC0[u] = 0u; }
    __syncthreads();
    const int wave_id = __builtin_amdgcn_readfirstlane((int)threadIdx.x >> 6);
    XcdBarrier bar; bar.bar = (unsigned*)(args.ws + WS_CTL) + CW_BAR; bar.x = 0; bar.st = nullptr;
    if (!MK_PER_PHASE) bar = xcd_barrier_post((unsigned*)(args.ws + WS_CTL) + CW_BAR, (volatile LAS unsigned*)(lds + MISC_OFF) + 8, wave_id * 64 + lane_id_v());

    const int lo = args.ph_lo, hi = args.ph_hi; unsigned char* const ws0 = args.ws;
    int ph = 0; unsigned long long probe_acc = 0ull;
    PH_BEGIN
    {
        LAS float* scr = (LAS float*)(lds + RING_OFF + wave * WAVE_LDS);
        constexpr int J_FF = 1408;
        constexpr int J_AIN = 16 * 80, J_WOUT = 512, J_WKVI = 16 * 24, J_BIN = 512, J_MKV = 256, J_C1 = 128, J_C2 = 4;
        constexpr int NIT = 12 * J_FF + J_AIN + 2 * J_WOUT + J_WKVI + J_BIN + 2 * J_MKV + 2 * J_C1 + 2 * J_C2;
        for (int it = gw; it < NIT; it += NGW) {
            int r = it;
            if (r < 12 * J_FF) { const int job = r / J_FF, idx = job / 3, kind = job % 3; r -= job * J_FF;
                if (kind < 2) { const int nblk = FF / 64, kb = r / nblk, nb = r % nblk, n0 = nb * 64;
                    cvt_item(ap->in[kind == 0 ? I_WG : I_WU] + (size_t)idx * D * FF, FF, n0, kb * 128, WSP(u16, WS_WGU) + (size_t)idx * 2 * FF * D, D, 256 * (n0 >> 7) + (n0 & 127) + (kind ? 128 : 0), idx >= 1 ? 512.0f : 1.0f, ap->in[I_NG] + (size_t)((idx >> 1) * 6 + (idx & 1) * 4) * D, scr, lane, idx >= 1); }
                else { const int nblk = D / 64, kb = r / nblk, nb = r % nblk;
                    cvt_item(ap->in[I_WDN] + (size_t)idx * FF * D, D, nb * 64, kb * 128, WSP(u16, WS_WD) + (size_t)idx * D * FF, FF, nb * 64, idx > 0 ? 512.0f : 1.0f, nullptr, scr, lane, idx > 0); }
                continue; }
            r -= 12 * J_FF;
            if (r < J_AIN) { const int nblk = A_N / 64, kb = r / nblk, nb = r % nblk, n0 = nb * 64;
                cvt_item(ap->in[I_AWIN], A_INW, n0 < 4608 ? n0 : n0 + 8, kb * 128, WSP(u16, WS_WAIN), D, n0, (n0 >= 768 && n0 < 1536) ? 0.07216878364870322f : 1.0f, ap->in[I_NG] + (size_t)2 * D, scr, lane); continue; }
            r -= J_AIN;
            if (r < 2 * J_WOUT) { const int l = r / J_WOUT; r -= l * J_WOUT; const int nblk = D / 64, kb = r / nblk, nb = r % nblk;
                cvt_item(ap->in[I_WOUT] + (size_t)l * D * D, D, nb * 64, kb * 128, WSP(u16, WS_WOUT) + (size_t)l * D * D, D, nb * 64, 1.0f, nullptr, scr, lane); continue; }
            r -= 2 * J_WOUT;
            if (r < J_WKVI) { const int nblk = KVW / 64, kb = r / nblk, nb = r % nblk;
                cvt_item(ap->in[I_WKV], KVW, nb * 64, kb * 128, WSP(u16, WS_WKV), D, nb * 64, 1.0f, ap->in[I_KVN], scr, lane); continue; }
            r -= J_WKVI;
            if (r < J_BIN) { const int nblk = 2048 / 64, kb = r / nblk, nb = r % nblk, n0 = nb * 64;
                cvt_item(ap->in[I_BWIN], B_INW, n0 < 1536 ? n0 : n0 + 36, kb * 128, WSP(u16, WS_WBIN), D, n0, 1.0f, ap->in[I_NG] + (size_t)8 * D, scr, lane); continue; }
            r -= J_BIN;
            if (r < 2 * J_MKV) { const int l = r / J_MKV; r -= l * J_MKV; const int nblk = 1024 / 64, kb = r / nblk, nb = r % nblk;
                cvt_item(ap->in[I_MEMWKV] + (size_t)l * D * 1024, 1024, nb * 64, kb * 128, WSP(u16, WS_WMKV) + (size_t)l * 1024 * D, D, nb * 64, 1.0f, nullptr, scr, lane); continue; }
            r -= 2 * J_MKV;
            if (r < 2 * J_C1) { const int c = r / J_C1; r -= c * J_C1; const int nblk = 256 / 64, kb = r / nblk, nb = r % nblk;
                cvt_item(ap->in[I_CW1] + (size_t)c * 4096 * 256, 256, nb * 64, kb * 128, WSP(u16, WS_WC1) + (size_t)c * 256 * 4096, 4096, nb * 64, 1.0f, nullptr, scr, lane); continue; }
            r -= 2 * J_C1;
            { const int c = r / J_C2; r -= c * J_C2; const int nblk = 128 / 64, kb = r / nblk, nb = r % nblk;
                cvt_item(ap->in[I_CW2] + (size_t)c * 256 * 128, 128, nb * 64, kb * 128, WSP(u16, WS_WC2) + (size_t)c * 128 * 256, 256, nb * 64, 1.0f, nullptr, scr, lane); }
        }
        for (int it = wave * G + (int)blockIdx.x; it < 2 * MEM_LEN; it += NGW) { const int l = it >> 8, m = it & 255;
            const GAS f32x4* xr = (const GAS f32x4*)(ap->in[I_MEM] + (size_t)m * D) + lane; f32x4 v[8]; float ss = 0.f;
#pragma unroll
            for (int j = 0; j < 8; ++j) { v[j] = xr[64 * j]; ss += (v[j].x * v[j].x + v[j].y * v[j].y) + (v[j].z * v[j].z + v[j].w * v[j].w); }
            const float rr = rsqrtf(wave_sum(ss) * (1.0f / D) + EPS);
            GAS u32x2* o = (GAS u32x2*)(WSP(u16, WS_MEMN) + ((size_t)l * MEM_LEN + m) * D) + lane;
#pragma unroll
            for (int j = 0; j < 8; ++j) { const f32x4 g = ((const GAS f32x4*)(ap->in[I_MEMNORM] + (size_t)l * D))[lane + 64 * j]; const f32x4 w = v[j] * rr * g; u32x2 pk; pk.x = pkh(w.x, w.y); pk.y = pkh(w.z, w.w); o[64 * j] = pk; } }
        for (int e = blockIdx.x * 512 + tid; e < 8 * D; e += G * 512) { const int gi = e / D, k = e % D; WSP(float, WS_WGA)[gi * D + k] = ap->in[I_AWIN][(size_t)k * A_INW + 4608 + gi] * ap->in[I_NG][2 * D + k]; }
        for (int e = blockIdx.x * 512 + tid; e < 256 * D; e += G * 512) { const int rr = e / D, k = e % D;
            *(f16*)(WSP(u16, WS_WBIN) + (size_t)(2048 + rr) * D + k) = (f16)(rr < 36 ? ap->in[I_BWIN][(size_t)k * B_INW + 1536 + rr] * ap->in[I_NG][8 * D + k] : 0.f); }
        for (int it = (7 - wave) * G + (int)blockIdx.x; it < 512; it += NGW) { const int c = it >> 8, j = it & 255; float a = 0.f;
            for (int k = lane; k < 4096; k += 64) a += ap->in[I_CPOS][c * 4096 + k] * ap->in[I_CW1][((size_t)c * 4096 + k) * 256 + j];
            a = wave_sum(a); if (lane == 0) WSP(float, WS_CB1)[it] = a; }
        for (int e = blockIdx.x * 512 + tid; e < S * 64; e += G * 512) { const int t = e >> 6, i = e & 63;
            const float inv = exp2f(-(float)(2 * i) * (13.287712379549449f / 128.0f)); const float ang = (float)t * inv;
            const double k = rint((double)ang * 0.15915494309189535); const float rr = (float)((double)ang - k * 6.283185307179586);
            WSP(float, WS_ROPE)[e] = __cosf(rr); WSP(float, WS_ROPE)[S * 64 + e] = __sinf(rr); }
        thin_rows<0, false, true>(nullptr, 0.f, nullptr, ap->in[I_X], (u16*)(ap->out + (size_t)S * D / 2), WSP(float, WS_RINV), nullptr, nullptr, nullptr, gw, NGW, lane);
    }
    PH_END

    Ctx cx; cx.lds = lds; cx.ws0 = ws0; cx.G = G; cx.lo = lo; cx.hi = hi; cx.wave_id = wave_id; cx.bar = bar;
    ffn_stage<0>(cx, ph, probe_acc); ffn_stage<1>(cx, ph, probe_acc); ffn_stage<2>(cx, ph, probe_acc); ffn_stage<3>(cx, ph, probe_acc);
    if (PROBE_MASK != 0u && blockIdx.x == 0 && wave_id == 0 && lane_id_v() == 0) { const unsigned long long t0 = __builtin_amdgcn_s_memrealtime(); while (__builtin_amdgcn_s_memrealtime() - t0 < probe_acc * PROBE_MULT) __builtin_amdgcn_s_sleep(32); }
}
#undef PH_BEGIN
#undef PH_END


constexpr int N_PHASES = 1 + 4 * 2 + 1 + 1 + 2 * 2 + 3 + 2;

extern "C" void kernel_launch(void* const* d_in, const int* in_sizes, int n_in, void* d_out, int out_size, void* d_ws, size_t ws_size, hipStream_t stream) {
    static int grid = 0;
    if (grid == 0) {
        if (n_in != 19 || in_sizes[0] != S * D || out_size != S * D || ws_size < WS_END) { fprintf(stderr, "kernel_launch: unexpected shapes: n_in %d in0 %d out %d ws %zu (need %zu)\n", n_in, n_in > 0 ? in_sizes[0] : -1, out_size, ws_size, (size_t)WS_END); grid = -1; return; }
        int dev = 0, cus = 0, per_cu = 0;
        if (hipGetDevice(&dev) != hipSuccess || hipDeviceGetAttribute(&cus, hipDeviceAttributeMultiprocessorCount, dev) != hipSuccess) { grid = -1; return; }
        if (hipFuncSetAttribute((const void*)yoco_fwd, hipFuncAttributeMaxDynamicSharedMemorySize, LDS_BYTES) != hipSuccess) { fprintf(stderr, "kernel_launch: hipFuncSetAttribute failed\n"); grid = -1; return; }
        if (hipOccupancyMaxActiveBlocksPerMultiprocessor(&per_cu, (const void*)yoco_fwd, NWAVES * 64, LDS_BYTES) != hipSuccess || per_cu < 1) { fprintf(stderr, "kernel_launch: occupancy query reports %d\n", per_cu); (void)hipGetLastError(); grid = -1; return; }
        grid = cus;
    }
    if (grid < 0) return;
    (void)hipMemsetAsync((char*)d_ws + WS_CTL, 0, CTL_ZERO_BYTES, stream);
    Args a{};
    for (int i = 0; i < 19; ++i) a.in[i] = (const float*)d_in[i];
    a.out = (float*)d_out; a.ws = (unsigned char*)d_ws;
#if MK_PER_PHASE
    for (int p = 0; p < N_PHASES; ++p) { a.ph_lo = p; a.ph_hi = p + 1; a.li = p; hipLaunchKernelGGL(yoco_fwd, dim3(grid), dim3(NWAVES * 64), LDS_BYTES, stream, a); }
#else
    a.ph_lo = 0; a.ph_hi = N_PHASES; a.li = 0;
    hipLaunchKernelGGL(yoco_fwd, dim3(grid), dim3(NWAVES * 64), LDS_BYTES, stream, a);
#endif
}
```
